# Optimizing an MI355X kernel written in HIP

```python
import math
import jax
import jax.numpy as jnp
from jax import lax
import numpy as np

D_MODEL = 1024
BATCH = 4
SEQ = 4096
DEPTH = 2

N_BRANCH = 4
BRANCH_W = 512

SSD_D_INNER = 512
SSD_HEAD_DIM = 64
SSD_HEADS = SSD_D_INNER // SSD_HEAD_DIM
SSD_GROUPS = 2
SSD_HPG = SSD_HEADS // SSD_GROUPS
SSD_STATE = 64
SSD_CONV = 4
SSD_CHUNK = 128
SSD_CONV_CH = SSD_D_INNER + 2 * SSD_GROUPS * SSD_STATE

DIL_PAIRS = ((128, 1), (512, 4), (2048, 16))
DIL_HPG = 4
DIL_HEAD_DIM = 128
DIL_HEADS = DIL_HPG * len(DIL_PAIRS)
DIL_BLOCK = 128

DIFF_HEADS = 4
DIFF_HEAD_DIM = 64
DIFF_QBLOCK = 128

HG_HEADS = 8
HG_KEY_DIM = 64
HG_VAL_DIM = BRANCH_W // HG_HEADS
HG_CHUNK = 64

N_EXPERTS = 64
N_EXPERT_GROUPS = 8
EXPERTS_PER_GROUP = N_EXPERTS // N_EXPERT_GROUPS
TOP_K = 2
D_EXPERT = 256
MOE_BLOCK = 128

NORM_EPS = 1e-6
MASK_VALUE = -1e30

IN_WIDTHS = (
    SSD_D_INNER,
    SSD_CONV_CH,
    SSD_HEADS,
    DIL_HEADS * DIL_HEAD_DIM,
    DIL_HEADS * DIL_HEAD_DIM,
    DIL_HEADS * DIL_HEAD_DIM,
    2 * DIFF_HEADS * DIFF_HEAD_DIM,
    2 * DIFF_HEADS * DIFF_HEAD_DIM,
    DIFF_HEADS * 2 * DIFF_HEAD_DIM,
    HG_HEADS * HG_KEY_DIM,
    HG_HEADS * HG_KEY_DIM,
    HG_HEADS * HG_VAL_DIM,
    HG_HEADS * HG_VAL_DIM,
    N_BRANCH * D_MODEL,
)
IN_OFFSETS = tuple(sum(IN_WIDTHS[:i + 1]) for i in range(len(IN_WIDTHS) - 1))
D_IN = sum(IN_WIDTHS)

kernel_name = "hybrid_gated_ssd_dilated_diff_hgrn2_moe"


def rms_norm(x, w):
    xf = x.astype(jnp.float32)
    y = xf * lax.rsqrt(jnp.mean(xf * xf, axis=-1, keepdims=True) + NORM_EPS)
    return (y * w.astype(jnp.float32)).astype(x.dtype)


def modulate(h, shift, scale):
    return h * (1.0 + scale[:, None, :]) + shift[:, None, :]


def causal_depthwise_conv(x, w, b):
    k = w.shape[0]
    y = lax.conv_general_dilated(x, w[:, None, :], window_strides=(1,), padding=[(k - 1, 0)],
                                 dimension_numbers=("NWC", "WIO", "NWC"),
                                 feature_group_count=x.shape[-1])
    return y + b


def segsum(x):
    t = x.shape[-1]
    cs = jnp.cumsum(x, axis=-1)
    diff = cs[..., :, None] - cs[..., None, :]
    mask = jnp.tril(jnp.ones((t, t), dtype=bool))
    return jnp.where(mask, diff, MASK_VALUE)


def ssd_chunked(xh, dt, a, bm, cm):
    b, s, g, e, p = xh.shape
    n = bm.shape[-1]
    nc = s // SSD_CHUNK
    x = (xh * dt[..., None]).reshape(b, nc, SSD_CHUNK, g, e, p)
    adt = (dt * a).reshape(b, nc, SSD_CHUNK, g, e).transpose(0, 3, 4, 1, 2)
    bm = bm.reshape(b, nc, SSD_CHUNK, g, n)
    cm = cm.reshape(b, nc, SSD_CHUNK, g, n)
    a_cs = jnp.cumsum(adt, axis=-1)
    lmat = jnp.exp(segsum(adt))
    cb = jnp.einsum("bclgn,bcsgn->bgcls", cm, bm)
    y_diag = jnp.einsum("bgecls,bcsgep->bclgep", cb[:, :, None] * lmat, x)
    decay_states = jnp.exp(a_cs[..., -1:] - a_cs)
    states = jnp.einsum("bclgn,bgecl,bclgep->bcgepn", bm, decay_states, x)
    states = jnp.concatenate([jnp.zeros_like(states[:, :1]), states], axis=1)
    chunk_tot = jnp.pad(a_cs[..., -1], ((0, 0), (0, 0), (0, 0), (1, 0)))
    decay_chunk = jnp.exp(segsum(chunk_tot))
    states = jnp.einsum("bgezc,bcgepn->bzgepn", decay_chunk, states)[:, :-1]
    y_off = jnp.einsum("bclgn,bcgepn,bgecl->bclgep", cm, states, jnp.exp(a_cs))
    return (y_diag + y_off).reshape(b, s, g, e, p)


def banded_causal_attention(q, k, v, max_dist):
    n, l, h, dh = q.shape
    blk = DIL_BLOCK
    nb = -(-l // blk)
    lp = nb * blk
    pad_end = lp - l
    qb = jnp.pad(q, ((0, 0), (0, pad_end), (0, 0), (0, 0))).reshape(n, nb, blk, h, dh)

    def key_blocks(t):
        tp = jnp.pad(t, ((0, 0), (blk, pad_end), (0, 0), (0, 0))).reshape(n, nb + 1, blk, h, dh)
        return jnp.concatenate([tp[:, :-1], tp[:, 1:]], axis=2)

    kb = key_blocks(k)
    vb = key_blocks(v)
    q_idx = jnp.arange(nb)[:, None] * blk + jnp.arange(blk)[None, :]
    k_idx = jnp.arange(nb)[:, None] * blk - blk + jnp.arange(2 * blk)[None, :]
    dist = q_idx[:, :, None] - k_idx[:, None, :]
    valid = (dist >= 0) & (dist <= max_dist) & (k_idx[:, None, :] >= 0)
    sc = jnp.einsum("nbqhd,nbkhd->nbhqk", qb, kb).astype(jnp.float32) * (dh ** -0.5)
    sc = jnp.where(valid[None, :, None], sc, MASK_VALUE)
    m = jnp.max(sc, axis=-1, keepdims=True)
    pr = jnp.exp(sc - m)
    denom = jnp.sum(pr, axis=-1, keepdims=True)
    o = jnp.einsum("nbhqk,nbkhd->nbqhd", pr / denom, vb.astype(jnp.float32))
    lse = (m + jnp.log(denom))[..., 0]
    o = o.reshape(n, lp, h, dh)[:, :l]
    lse = lse.transpose(0, 1, 3, 2).reshape(n, lp, h)[:, :l]
    return o, lse


def dilated_attention(q, k, v):
    b, s, _, dh = q.shape
    outs, lses = [], []
    for g, (window, dil) in enumerate(DIL_PAIRS):
        hs = slice(g * DIL_HPG, (g + 1) * DIL_HPG)
        sub_len = s // dil

        def to_sub(t):
            return t.reshape(b, sub_len, dil, DIL_HPG, dh).transpose(0, 2, 1, 3, 4).reshape(b * dil, sub_len, DIL_HPG, dh)

        o, lse = banded_causal_attention(to_sub(q[:, :, hs]), to_sub(k[:, :, hs]), to_sub(v[:, :, hs]), window // dil)
        outs.append(o.reshape(b, dil, sub_len, DIL_HPG, dh).transpose(0, 2, 1, 3, 4).reshape(b, s, DIL_HPG, dh))
        lses.append(lse.reshape(b, dil, sub_len, DIL_HPG).transpose(0, 2, 1, 3).reshape(b, s, DIL_HPG))
    wts = jax.nn.softmax(jnp.stack(lses, axis=0), axis=0)
    return jnp.sum(wts[..., None] * jnp.stack(outs, axis=0), axis=0)


def differential_attention(q, k, v, lam, lam_init, subln_w):
    b, s, h2, dh = q.shape
    h = h2 // 2
    nblk = s // DIFF_QBLOCK
    qb = q.reshape(b, nblk, DIFF_QBLOCK, h2, dh).transpose(1, 0, 2, 3, 4)
    k_pos = jnp.arange(s)
    vf = v.astype(jnp.float32)
    scale = dh ** -0.5

    def one_block(args):
        q_blk, blk = args
        sc = jnp.einsum("bqhd,bkhd->bhqk", q_blk, k).astype(jnp.float32) * scale
        q_pos = blk * DIFF_QBLOCK + jnp.arange(DIFF_QBLOCK)
        causal = k_pos[None, :] <= q_pos[:, None]
        pr = jax.nn.softmax(jnp.where(causal, sc, MASK_VALUE), axis=-1).reshape(b, h, 2, DIFF_QBLOCK, s)
        attn = pr[:, :, 0] - lam * pr[:, :, 1]
        return jnp.einsum("bhqk,bkhe->bqhe", attn, vf)

    o = lax.map(one_block, (qb, jnp.arange(nblk)))
    o = o.transpose(1, 0, 2, 3, 4).reshape(b, s, h, 2 * dh)
    return rms_norm(o, subln_w) * (1.0 - lam_init)


def hgrn2_chunked(q, k, v, log_f):
    b, s, h, dk = q.shape
    dv = v.shape[-1]
    nc = s // HG_CHUNK

    def chunks(t):
        return t.reshape(b, nc, HG_CHUNK, h, t.shape[-1]).transpose(1, 0, 3, 2, 4)

    causal = jnp.tril(jnp.ones((HG_CHUNK, HG_CHUNK), dtype=bool))

    def step(state, inp):
        qi, ki, vi, gi = inp
        gcum = jnp.cumsum(gi, axis=2)
        o_inter = jnp.einsum("bhik,bhkv->bhiv", qi * jnp.exp(gcum), state)
        rel = gcum[:, :, :, None, :] - gcum[:, :, None, :, :]
        decay = jnp.exp(jnp.where(causal[:, :, None], rel, MASK_VALUE))
        attn = jnp.einsum("bhik,bhjk,bhijk->bhij", qi, ki, decay)
        o_intra = jnp.einsum("bhij,bhjv->bhiv", attn, vi)
        g_last = gcum[:, :, -1:]
        new_state = jnp.exp(g_last[:, :, 0])[..., None] * state + jnp.einsum("bhjk,bhjv->bhkv", ki * jnp.exp(g_last - gcum), vi)
        return new_state, o_inter + o_intra

    state0 = jnp.zeros((b, h, dk, dv), jnp.float32)
    _, o = lax.scan(step, state0, (chunks(q), chunks(k), chunks(v), chunks(log_f)))
    return o.transpose(1, 0, 3, 2, 4).reshape(b, s, h, dv)


def token_mixer(h, layer, w_in, conv_w, conv_b, dt_bias, a_log, d_skip, ssd_norm_w, diff_lambda,
                diff_subln_w, lower_bound, hgrn_norm_w, w_merge, w_out):
    b, s, d = h.shape
    f32 = jnp.float32
    (z, xbc, dt_raw, q_b, k_b, v_b, q_c, k_c, v_c, q_d, f_d, i_d, g_d, gate_logits) = jnp.split(h @ w_in, IN_OFFSETS, axis=-1)

    xbc = jax.nn.silu(causal_depthwise_conv(xbc, conv_w, conv_b))
    xs, bm, cm = jnp.split(xbc, (SSD_D_INNER, SSD_D_INNER + SSD_GROUPS * SSD_STATE), axis=-1)
    dt = jax.nn.softplus(dt_raw.astype(f32) + dt_bias.astype(f32))
    a = -jnp.exp(a_log.astype(f32))
    xh = xs.astype(f32).reshape(b, s, SSD_GROUPS, SSD_HPG, SSD_HEAD_DIM)
    y = ssd_chunked(xh, dt.reshape(b, s, SSD_GROUPS, SSD_HPG), a.reshape(SSD_GROUPS, SSD_HPG),
                    bm.astype(f32).reshape(b, s, SSD_GROUPS, SSD_STATE), cm.astype(f32).reshape(b, s, SSD_GROUPS, SSD_STATE))
    y = y + d_skip.astype(f32).reshape(SSD_GROUPS, SSD_HPG)[..., None] * xh
    y = y.reshape(b, s, SSD_D_INNER).astype(h.dtype)
    o_a = rms_norm(y * jax.nn.silu(z), ssd_norm_w)

    dil_shape = (b, s, DIL_HEADS, DIL_HEAD_DIM)
    o_b = dilated_attention(q_b.reshape(dil_shape), k_b.reshape(dil_shape), v_b.reshape(dil_shape))
    o_b = o_b.reshape(b, s, BRANCH_W).astype(h.dtype)

    lam_q1, lam_k1, lam_q2, lam_k2 = diff_lambda.astype(f32)
    lam_init = 0.8 - 0.6 * math.exp(-0.3 * layer)
    lam = jnp.exp(jnp.sum(lam_q1 * lam_k1)) - jnp.exp(jnp.sum(lam_q2 * lam_k2)) + lam_init
    qk_shape = (b, s, 2 * DIFF_HEADS, DIFF_HEAD_DIM)
    o_c = differential_attention(q_c.reshape(qk_shape), k_c.reshape(qk_shape),
                                 v_c.reshape(b, s, DIFF_HEADS, 2 * DIFF_HEAD_DIM), lam, lam_init, diff_subln_w)
    o_c = o_c.reshape(b, s, BRANCH_W).astype(h.dtype)

    lb = lower_bound.reshape(HG_HEADS, HG_KEY_DIM)
    f_logit = f_d.astype(f32).reshape(b, s, HG_HEADS, HG_KEY_DIM)
    f_gate = lb + (1.0 - lb) * jax.nn.sigmoid(f_logit)
    log_f = jnp.log(f_gate)
    k_in = 1.0 - f_gate
    q_hg = jax.nn.silu(q_d.astype(f32).reshape(b, s, HG_HEADS, HG_KEY_DIM))
    v_hg = i_d.astype(f32).reshape(b, s, HG_HEADS, HG_VAL_DIM)
    o = hgrn2_chunked(q_hg, k_in, v_hg, log_f)
    o_d = rms_norm(o, hgrn_norm_w) * jax.nn.silu(g_d.astype(f32).reshape(b, s, HG_HEADS, HG_VAL_DIM))
    o_d = o_d.reshape(b, s, BRANCH_W).astype(h.dtype)

    branches = jnp.stack([o_a, o_b, o_c, o_d], axis=2)
    proj = jnp.einsum("bsnw,nwd->bsnd", branches, w_merge)
    gates = jax.nn.sigmoid(gate_logits.reshape(b, s, N_BRANCH, d))
    return jnp.sum(gates * proj, axis=2) @ w_out


def moe_ffn(h, w_router, router_bias, w_gate, w_up, w_down):
    b, s, d = h.shape
    n_tok = b * s
    t = h.reshape(n_tok, d)
    scores = jax.nn.sigmoid((t @ w_router).astype(jnp.float32))
    sel = scores + router_bias.astype(jnp.float32)
    group_score = jnp.sum(lax.top_k(sel.reshape(n_tok, N_EXPERT_GROUPS, EXPERTS_PER_GROUP), 2)[0], axis=-1)
    best_group = jnp.argmax(group_score, axis=-1)
    in_group = (jnp.arange(N_EXPERTS) // EXPERTS_PER_GROUP)[None, :] == best_group[:, None]
    _, idx = lax.top_k(jnp.where(in_group, sel, MASK_VALUE), TOP_K)
    wts = jnp.take_along_axis(scores, idx, axis=-1)
    wts = wts / jnp.sum(wts, axis=-1, keepdims=True)

    flat_e = idx.reshape(-1).astype(jnp.int32)
    flat_tok = jnp.repeat(jnp.arange(n_tok, dtype=jnp.int32), TOP_K)
    flat_w = wts.reshape(-1)
    order = jnp.argsort(flat_e)
    e_s, tok_s, w_s = flat_e[order], flat_tok[order], flat_w[order]
    counts = jnp.bincount(flat_e, length=N_EXPERTS)
    padded = ((counts + MOE_BLOCK - 1) // MOE_BLOCK) * MOE_BLOCK
    start = jnp.cumsum(counts) - counts
    pend = jnp.cumsum(padded)
    pstart = pend - padded
    dest = pstart[e_s] + (jnp.arange(n_tok * TOP_K) - start[e_s])
    n_rows = n_tok * TOP_K + N_EXPERTS * MOE_BLOCK
    n_blocks = n_rows // MOE_BLOCK
    row_tok = jnp.zeros((n_rows,), jnp.int32).at[dest].set(tok_s)
    row_w = jnp.zeros((n_rows,), jnp.float32).at[dest].set(w_s)
    blk_start = jnp.arange(n_blocks) * MOE_BLOCK
    blk_e = jnp.minimum(jnp.sum(pend[None, :] <= blk_start[:, None], axis=1), N_EXPERTS - 1)
    xs = t[row_tok].reshape(n_blocks, MOE_BLOCK, d)

    def expert_block(args):
        xb, e = args
        hid = jax.nn.silu(xb @ w_gate[e]) * (xb @ w_up[e])
        return hid @ w_down[e]

    ys = lax.map(expert_block, (xs, blk_e)).reshape(n_rows, d)
    out = jnp.zeros((n_tok, d), h.dtype).at[row_tok].add(ys * row_w[:, None].astype(h.dtype))
    return out.reshape(b, s, d)


def setup_inputs(seed: int = 0) -> dict:
    key = jax.random.key(seed)
    ks = jax.random.split(key, 26)
    f32 = jnp.float32

    def nrm(k, shape, scale):
        return jax.random.normal(k, shape, f32) * scale

    dt0 = jnp.exp(jax.random.uniform(ks[9], (DEPTH, SSD_HEADS), f32) * (math.log(0.1) - math.log(1e-3)) + math.log(1e-3))
    return {
        "x": nrm(ks[0], (BATCH, SEQ, D_MODEL), 1.0),
        "c": nrm(ks[1], (BATCH, D_MODEL), 1.0),
        "w_ada": nrm(ks[2], (DEPTH, D_MODEL, 6 * D_MODEL), 0.5 * D_MODEL ** -0.5),
        "b_ada": nrm(ks[3], (DEPTH, 6 * D_MODEL), 0.01),
        "norm_mix_w": 1.0 + nrm(ks[4], (DEPTH, D_MODEL), 0.02),
        "norm_ffn_w": 1.0 + nrm(ks[5], (DEPTH, D_MODEL), 0.02),
        "w_in": nrm(ks[6], (DEPTH, D_MODEL, D_IN), D_MODEL ** -0.5),
        "conv_w": nrm(ks[7], (DEPTH, SSD_CONV, SSD_CONV_CH), SSD_CONV ** -0.5),
        "conv_b": nrm(ks[8], (DEPTH, SSD_CONV_CH), 0.01),
        "ssd_dt_bias": dt0 + jnp.log(-jnp.expm1(-dt0)),
        "ssd_a_log": jnp.log(jax.random.uniform(ks[10], (DEPTH, SSD_HEADS), f32, 1.0, 16.0)),
        "ssd_d": 1.0 + nrm(ks[11], (DEPTH, SSD_HEADS), 0.1),
        "ssd_norm_w": 1.0 + nrm(ks[12], (DEPTH, SSD_D_INNER), 0.02),
        "diff_lambda": nrm(ks[13], (DEPTH, 4, DIFF_HEAD_DIM), 0.1),
        "diff_subln_w": 1.0 + nrm(ks[14], (DEPTH, 2 * DIFF_HEAD_DIM), 0.02),
        "hgrn_lb_logits": nrm(ks[15], (DEPTH, HG_HEADS * HG_KEY_DIM), 1.0),
        "hgrn_norm_w": 1.0 + nrm(ks[16], (DEPTH, HG_VAL_DIM), 0.02),
        "w_merge": nrm(ks[17], (DEPTH, N_BRANCH, BRANCH_W, D_MODEL), BRANCH_W ** -0.5),
        "w_out": nrm(ks[18], (DEPTH, D_MODEL, D_MODEL), D_MODEL ** -0.5),
        "w_router": nrm(ks[19], (D_MODEL, N_EXPERTS), D_MODEL ** -0.5),
        "router_bias": nrm(ks[20], (N_EXPERTS,), 0.01),
        "w_expert_gate": nrm(ks[21], (DEPTH, N_EXPERTS, D_MODEL, D_EXPERT), D_MODEL ** -0.5),
        "w_expert_up": nrm(ks[22], (DEPTH, N_EXPERTS, D_MODEL, D_EXPERT), D_MODEL ** -0.5),
        "w_expert_down": nrm(ks[23], (DEPTH, N_EXPERTS, D_EXPERT, D_MODEL), D_EXPERT ** -0.5),
        "final_norm_w": 1.0 + nrm(ks[24], (D_MODEL,), 0.02),
    }


def reference(x, c, w_ada, b_ada, norm_mix_w, norm_ffn_w, w_in, conv_w, conv_b, ssd_dt_bias, ssd_a_log,
              ssd_d, ssd_norm_w, diff_lambda, diff_subln_w, hgrn_lb_logits, hgrn_norm_w, w_merge, w_out,
              w_router, router_bias, w_expert_gate, w_expert_up, w_expert_down, final_norm_w):
    lb_p = jax.nn.softmax(hgrn_lb_logits.astype(jnp.float32), axis=0)
    lower_bounds = jnp.cumsum(lb_p, axis=0) - lb_p[0]
    c_act = jax.nn.silu(c)
    for l in range(DEPTH):
        mod = c_act @ w_ada[l] + b_ada[l]
        sh1, sc1, g1, sh2, sc2, g2 = jnp.split(mod, 6, axis=-1)
        h = modulate(rms_norm(x, norm_mix_w[l]), sh1, sc1)
        mix = token_mixer(h, l, w_in[l], conv_w[l], conv_b[l], ssd_dt_bias[l], ssd_a_log[l], ssd_d[l],
                          ssd_norm_w[l], diff_lambda[l], diff_subln_w[l], lower_bounds[l], hgrn_norm_w[l],
                          w_merge[l], w_out[l])
        x = x + g1[:, None, :] * mix
        h = modulate(rms_norm(x, norm_ffn_w[l]), sh2, sc2)
        x = x + g2[:, None, :] * moe_ffn(h, w_router, router_bias, w_expert_gate[l], w_expert_up[l], w_expert_down[l])
    return rms_norm(x, final_norm_w)
```

```cpp
#include <hip/hip_runtime.h>
#include <hip/hip_bf16.h>
#include <cstdio>
#include <cstdint>
namespace pg8 {
#define PG8_LAS __attribute__((address_space(3)))
typedef unsigned short bf16_t;
typedef short bf16x8 __attribute__((ext_vector_type(8)));
typedef float f32x4 __attribute__((ext_vector_type(4)));
typedef unsigned u32x4 __attribute__((ext_vector_type(4)));
constexpr int BM = 256, BK = 64, HALF = 128, HTB = HALF * BK * 2  , STAGE_BYTES = 8 * HTB, NXCD = 8, WGM = 8;

__host__ __device__ __forceinline__ int lds_byte(int r, int c) { const int st = (r >> 4) * 2 + (c >> 5), rr = r & 15, cc = c & 31, ob = rr * 64 + cc * 2; return st * 1024 + (ob ^ (((ob >> 9) & 1) << 5)); }
__host__ __device__ __forceinline__ void stage_rc(int b, int& R, int& C) { const int st = b / 1024, sb = b % 1024, swz = sb ^ (((sb >> 9) & 1) << 5); R = (st >> 1) * 16 + swz / 64; C = (st & 1) * 32 + (swz % 64) / 2; }
__host__ __device__ __forceinline__ int perm32(int rho) { const int n = rho >> 4, i = rho & 15; return 8 * (i >> 2) + 4 * n + (i & 3); }

struct Unit { int pm, pn; };
struct Gemm { const bf16_t* A; const bf16_t* Bt; int M, N, K; };

struct StaticOrder {
    int nM, nN, nwg, G, c;
    __host__ __device__ void init(int M, int N, int G_, int c_) { nM = M / BM; nN = N / BM; nwg = nM * nN; G = G_; c = c_; }
    __host__ __device__ bool next(int i, Unit& u) const {
        const long L = (long)i * G + c; if (L >= nwg) return false;
        int wgid = (int)L; { const int q = nwg / NXCD, r = nwg % NXCD, xcd = wgid % NXCD, off = wgid / NXCD; wgid = (xcd < r ? xcd * (q + 1) : r * (q + 1) + (xcd - r) * q) + off; }
        const int nig = WGM * nN, gid = wgid / nig, fm = gid * WGM, gsz = (nM - fm) < WGM ? (nM - fm) : WGM;
        u.pm = fm + ((wgid % nig) % gsz); u.pn = (wgid % nig) / gsz; return true;
    }
    __device__ __forceinline__ void a_ready(const Unit&) const {}
    __device__ __forceinline__ void done(const Unit&) const {}
};
__device__ __forceinline__ unsigned cvt_pk_bf16(float lo, float hi) { unsigned r; asm volatile("v_cvt_pk_bf16_f32 %0, %1, %2" : "=v"(r) : "v"(lo), "v"(hi)); return r; }
template <int ACT  > struct EpiBf16 {
    static constexpr bool PERM = true, AFTER_DRAIN = false;
    bf16_t* O; int ldc; const float* bias; int split_cols; size_t split_stride;
    __device__ __forceinline__ void operator()(const f32x4 (&acc)[2][2][4][2], const Unit& u, int wr, int wc, int fr, int fq) const {
        const int row0 = u.pm * BM + wr * 64 + fr; int colt = u.pn * BM; bf16_t* base = O;
        if (split_cols) { const int t = colt / split_cols; base += (size_t)t * split_stride; colt -= t * split_cols; }
        const int col0 = colt + wc * 32 + 8 * fq, bcol0 = u.pn * BM + wc * 32 + 8 * fq;
        f32x4 bv[2][2];
#pragma unroll
        for (int bj = 0; bj < 2; ++bj)
#pragma unroll
            for (int n = 0; n < 2; ++n) bv[bj][n] = bias ? *(const f32x4*)(bias + bcol0 + bj * HALF + 4 * n) : (f32x4){0.f, 0.f, 0.f, 0.f};
#pragma unroll
        for (int ai = 0; ai < 2; ++ai)
#pragma unroll
            for (int m = 0; m < 4; ++m) { bf16_t* rowp = base + (size_t)(row0 + ai * HALF + m * 16) * ldc + col0;
#pragma unroll
                for (int bj = 0; bj < 2; ++bj) { f32x4 v0 = acc[ai][bj][m][0] + bv[bj][0], v1 = acc[ai][bj][m][1] + bv[bj][1];
                    u32x4 w; w.x = cvt_pk_bf16(v0[0], v0[1]); w.y = cvt_pk_bf16(v0[2], v0[3]); w.z = cvt_pk_bf16(v1[0], v1[1]); w.w = cvt_pk_bf16(v1[2], v1[3]);
                    *(u32x4*)(rowp + bj * HALF) = w; } }
    }
};

template <class Epi, class Sched, bool STAMP = false>
__device__ __forceinline__ void gemm_phase(PG8_LAS unsigned char* lds, const Gemm g, const Sched& S, const Epi& E, unsigned long long* stamps) {
    int tid_ = threadIdx.x; asm volatile("" : "+v"(tid_));
    const int tid = tid_, wid = __builtin_amdgcn_readfirstlane(tid >> 6), lane = tid & 63, wr = wid >> 2, wc = wid & 3, fr = lane & 15, fq = lane >> 4;
    const int K = g.K, nt = K / BK;
    int ts_lo = 0, ts_hi = 0, nts = 0; const unsigned long long rt_entry = STAMP ? (unsigned long long)wall_clock64() : 0ull;
#define PG8_STAMP() do { if (STAMP && wid == 0 && nts < 64) { const unsigned long long _c = (unsigned long long)clock64(); \
        ts_lo = (lane == nts) ? (int)(unsigned)_c : ts_lo; ts_hi = (lane == nts) ? (int)(unsigned)(_c >> 32) : ts_hi; ++nts; } } while (0)
    PG8_STAMP();
    unsigned voffA[2], voffB[2];
#pragma unroll
    for (int i = 0; i < 2; ++i) { int R, C; stage_rc(tid * 16 + i * 8192, R, C); const int Rb = Epi::PERM ? ((R & ~31) + perm32(R & 31)) : R;
        voffA[i] = (unsigned)(R * K + C) * 2u; voffB[i] = (unsigned)(Rb * K + C) * 2u; }
    const size_t kstep = (size_t)(BK * 2);
    const size_t hstep = (size_t)HALF * K * 2;
    const size_t tstep = 2 * hstep;
    const unsigned ldsw = (unsigned)wid * 1024u;
    const int aoff = lds_byte(wr * 64 + fr, fq * 8), boff = lds_byte(wc * 32 + fr, fq * 8);
#define PG8_SA(b, h) (((b) * 2 + (h)) * HTB)
#define PG8_SB(b, h) ((4 + (b) * 2 + (h)) * HTB)
#define PG8_STAGE(bufoff, gbase, voff) do { _Pragma("unroll") for (int _i = 0; _i < 2; ++_i) \
        __builtin_amdgcn_global_load_lds((const unsigned*)((const char*)(gbase) + (voff)[_i]), (PG8_LAS unsigned*)(lds + (bufoff) + ldsw + _i * 8192), 16, 0, 0); } while (0)
#define PG8_LDA(dst, b, h) do { _Pragma("unroll") for (int m = 0; m < 4; ++m) _Pragma("unroll") for (int k = 0; k < 2; ++k) dst[m][k] = *(const PG8_LAS bf16x8*)(lds + PG8_SA(b, h) + aoff + m * 2048 + k * 1024); } while (0)
#define PG8_LDB(dst, b, h) do { _Pragma("unroll") for (int n = 0; n < 2; ++n) _Pragma("unroll") for (int k = 0; k < 2; ++k) dst[n][k] = *(const PG8_LAS bf16x8*)(lds + PG8_SB(b, h) + boff + n * 2048 + k * 1024); } while (0)
#define PG8_MMA(ai, bj, At, Bt) do { __builtin_amdgcn_s_setprio(1); _Pragma("unroll") for (int m = 0; m < 4; ++m) _Pragma("unroll") for (int n = 0; n < 2; ++n) _Pragma("unroll") for (int k = 0; k < 2; ++k) \
        acc[ai][bj][m][n] = __builtin_amdgcn_mfma_f32_16x16x32_bf16(Bt[n][k], At[m][k], acc[ai][bj][m][n], 0, 0, 0); __builtin_amdgcn_s_setprio(0); } while (0)
#define PG8_WAIT_V(n) asm volatile("s_waitcnt vmcnt(" #n ")" ::: "memory")
#define PG8_WAIT_L(n) asm volatile("s_waitcnt lgkmcnt(" #n ")" ::: "memory")
#define PG8_BAR __builtin_amdgcn_s_barrier()
#define PG8_SCHED __builtin_amdgcn_sched_barrier(0)
    Unit cur, nxt; int ui = 0;
    if (!S.next(0, cur)) return;
    f32x4 acc[2][2][4][2];
#pragma unroll
    for (int a = 0; a < 2; ++a)
#pragma unroll
        for (int b = 0; b < 2; ++b)
#pragma unroll
            for (int m = 0; m < 4; ++m)
#pragma unroll
                for (int n = 0; n < 2; ++n) acc[a][b][m][n] = (f32x4){0.f, 0.f, 0.f, 0.f};
    bf16x8 At[4][2], B0[2][2], B1[2][2];
    const char* cA = (const char*)g.A + (size_t)cur.pm * tstep; const char* cB = (const char*)g.Bt + (size_t)cur.pn * tstep;
    S.a_ready(cur);
    PG8_STAGE(PG8_SB(0, 0), cB, voffB); PG8_STAGE(PG8_SA(0, 0), cA, voffA); PG8_STAGE(PG8_SB(0, 1), cB + hstep, voffB); PG8_STAGE(PG8_SA(0, 1), cA + hstep, voffA);
    if (wr == 1) PG8_BAR;
    PG8_WAIT_V(4); PG8_BAR;
    PG8_STAGE(PG8_SB(1, 0), cB + kstep, voffB); PG8_STAGE(PG8_SA(1, 0), cA + kstep, voffA); PG8_STAGE(PG8_SB(1, 1), cB + hstep + kstep, voffB);
    PG8_WAIT_V(6); PG8_BAR;
    PG8_STAMP();
    for (;;) {
        const bool has_next = S.next(ui + 1, nxt);
        const char* nA = has_next ? (const char*)g.A + (size_t)nxt.pm * tstep : cA; const char* nB = has_next ? (const char*)g.Bt + (size_t)nxt.pn * tstep : cB;
        for (int t = 0; t < nt; t += 2) {
            const bool last = (t == nt - 2);
            const char* a1 = cA + (size_t)(t + 1) * kstep;
            const char* a2 = last ? nA : cA + (size_t)(t + 2) * kstep; const char* b2 = last ? nB : cB + (size_t)(t + 2) * kstep;
            const char* a3 = a2 + kstep; const char* b3 = b2 + kstep;
            if (last && has_next) S.a_ready(nxt);
            PG8_LDB(B0, 0, 0); PG8_SCHED; PG8_LDA(At, 0, 0); PG8_STAGE(PG8_SA(1, 1), a1 + hstep, voffA);
            PG8_WAIT_L(8); PG8_BAR; PG8_WAIT_L(0); PG8_MMA(0, 0, At, B0); PG8_BAR; PG8_SCHED;
            PG8_LDB(B1, 0, 1); PG8_STAGE(PG8_SB(0, 0), b2, voffB);
            PG8_BAR; PG8_WAIT_L(0); PG8_MMA(0, 1, At, B1); PG8_BAR;
            PG8_LDA(At, 0, 1); PG8_STAGE(PG8_SA(0, 0), a2, voffA);
            PG8_BAR; PG8_WAIT_L(0); PG8_MMA(1, 0, At, B0); PG8_BAR; PG8_SCHED;
            PG8_STAGE(PG8_SB(0, 1), b2 + hstep, voffB);
            PG8_WAIT_V(6); PG8_BAR; PG8_MMA(1, 1, At, B1); PG8_BAR;
            PG8_LDB(B0, 1, 0); PG8_SCHED; PG8_LDA(At, 1, 0); PG8_STAGE(PG8_SA(0, 1), a2 + hstep, voffA);
            PG8_WAIT_L(8); PG8_BAR; PG8_WAIT_L(0); PG8_MMA(0, 0, At, B0); PG8_BAR; PG8_SCHED;
            PG8_LDB(B1, 1, 1); PG8_STAGE(PG8_SB(1, 0), b3, voffB);
            PG8_BAR; PG8_WAIT_L(0); PG8_MMA(0, 1, At, B1); PG8_BAR;
            PG8_LDA(At, 1, 1); PG8_STAGE(PG8_SA(1, 0), a3, voffA);
            PG8_BAR; PG8_WAIT_L(0); PG8_MMA(1, 0, At, B0); PG8_BAR; PG8_SCHED;
            PG8_STAGE(PG8_SB(1, 1), b3 + hstep, voffB);
            PG8_WAIT_V(6); PG8_BAR; PG8_MMA(1, 1, At, B1); PG8_BAR;
        }
        PG8_STAMP();
        if constexpr (!Epi::AFTER_DRAIN) { E(acc, cur, wr, wc, fr, fq); S.done(cur); }
        PG8_STAMP();
        if (!has_next) break;
#pragma unroll
        for (int a = 0; a < 2; ++a)
#pragma unroll
            for (int b = 0; b < 2; ++b)
#pragma unroll
                for (int m = 0; m < 4; ++m)
#pragma unroll
                    for (int n = 0; n < 2; ++n) acc[a][b][m][n] = (f32x4){0.f, 0.f, 0.f, 0.f};
        cur = nxt; cA = nA; cB = nB; ++ui;
    }
    PG8_WAIT_V(0);
    if (wr == 0) PG8_BAR;
    PG8_BAR;
    if constexpr (Epi::AFTER_DRAIN) { E.fused(acc, cur, wr, wc, fr, fq, lds, wid, lane); S.done(cur); }
    PG8_STAMP();
    if (STAMP && wid == 0) { stamps[lane] = lane < nts ? (((unsigned long long)(unsigned)ts_hi << 32) | (unsigned)ts_lo) : 0ull;
        if (lane == 62) stamps[62] = rt_entry; if (lane == 63) stamps[63] = (unsigned long long)wall_clock64(); }
#undef PG8_STAMP
#undef PG8_SA
#undef PG8_SB
#undef PG8_STAGE
#undef PG8_LDA
#undef PG8_LDB
#undef PG8_MMA
#undef PG8_WAIT_V
#undef PG8_WAIT_L
#undef PG8_BAR
#undef PG8_SCHED
}
}

namespace attn_body {
using bf16=__hip_bfloat16;
using bf16x8=__attribute__((ext_vector_type(8)))short;
using s16x4=__attribute__((ext_vector_type(4)))short;
using f32x16=__attribute__((ext_vector_type(16)))float;
using u32x4=__attribute__((ext_vector_type(4)))unsigned;
constexpr int D=64;
constexpr int NW=8,QBLK=32,QB=QBLK*NW,KVBLK=64;
__device__ __forceinline__ int crow(int r,int hi){return (r&3)+8*(r>>2)+4*hi;}
#define SBAR() __builtin_amdgcn_sched_barrier(0)
__device__ __forceinline__ void cmask(f32x16&p0,f32x16&p1,int jb,int qrel,int hi){
  const float NEG=-INFINITY; int kb=64*jb+4*hi;
  #pragma unroll
  for(int r=0;r<16;++r){int kv=kb+(r&3)+8*(r>>2); if(kv>qrel)p0[r]=NEG; if(kv+32>qrel)p1[r]=NEG;}
}

constexpr int NSLOT=3, SLOTB=8192;
constexpr int LDS_K=0, LDS_V=NSLOT*SLOTB, LDS_WS=2*NSLOT*SLOTB, LDS_OST=LDS_WS+NW*64*4, LDS_BYTES=LDS_OST+NW*4096;
constexpr float C2=0.125f*1.4426950408889634f;
__device__ __forceinline__ void glds16(const void*gsrc,unsigned lds_dst){unsigned keep;
  asm volatile("s_mov_b32 %0, m0\n\ts_mov_b32 m0, %2\n\ts_nop 0\n\tglobal_load_lds_dwordx4 %1, off\n\ts_mov_b32 m0, %0":"=&s"(keep):"v"(gsrc),"s"(lds_dst):"memory");}
__device__ __forceinline__ float max3f(float a,float b,float c){float r;asm("v_max3_f32 %0, %1, %2, %3":"=v"(r):"v"(a),"v"(b),"v"(c));return r;}
__device__ __forceinline__ float max2f(float a,float b){float r;asm("v_max_f32_e32 %0, %1, %2":"=v"(r):"v"(a),"v"(b));return r;}
__device__ __forceinline__ float fadd_s(float a,float b){float r;asm("v_add_f32_e32 %0, %1, %2":"=v"(r):"v"(a),"v"(b));return r;}
__device__ __forceinline__ float fsub_s(float a,float b){float r;asm("v_sub_f32_e32 %0, %1, %2":"=v"(r):"v"(a),"v"(b));return r;}
typedef float f32x2_t __attribute__((ext_vector_type(2))); typedef __bf16 bf16x2_t __attribute__((ext_vector_type(2)));
__device__ __forceinline__ unsigned cvtpk_s(float lo,float hi){f32x2_t v={lo,hi};bf16x2_t b=__builtin_convertvector(v,bf16x2_t);return __builtin_bit_cast(unsigned,b);}
#define WAIT_BAR(N) asm volatile("s_waitcnt vmcnt(" #N ") lgkmcnt(0)\n\ts_barrier":::"memory")

__device__ __forceinline__ void qkt(f32x16&p0,f32x16&p1,const char*Kslot,const bf16x8*qr,const f32x16&negm,int r32,int hi){
  const char*kb=Kslot+hi*1024+r32*16;
  #pragma unroll
  for(int d0=0;d0<4;++d0){
    const bf16x8 b0=*reinterpret_cast<const bf16x8*>(kb+d0*2048);
    const bf16x8 b1=*reinterpret_cast<const bf16x8*>(kb+d0*2048+512);
    if(d0==0){p0=__builtin_amdgcn_mfma_f32_32x32x16_bf16(b0,qr[0],negm,0,0,0);p1=__builtin_amdgcn_mfma_f32_32x32x16_bf16(b1,qr[0],negm,0,0,0);}
    else{p0=__builtin_amdgcn_mfma_f32_32x32x16_bf16(b0,qr[d0],p0,0,0,0);p1=__builtin_amdgcn_mfma_f32_32x32x16_bf16(b1,qr[d0],p1,0,0,0);}}
}
typedef __attribute__((address_space(3))) const char* lds_cptr;
typedef short v4i16_t __attribute__((ext_vector_type(4)));
__device__ __forceinline__ void kload8(bf16x8*kf,lds_cptr kp){
  kf[0]=*(const __attribute__((address_space(3))) bf16x8*)(kp);      kf[1]=*(const __attribute__((address_space(3))) bf16x8*)(kp+512);
  kf[2]=*(const __attribute__((address_space(3))) bf16x8*)(kp+2048); kf[3]=*(const __attribute__((address_space(3))) bf16x8*)(kp+2560);
  kf[4]=*(const __attribute__((address_space(3))) bf16x8*)(kp+4096); kf[5]=*(const __attribute__((address_space(3))) bf16x8*)(kp+4608);
  kf[6]=*(const __attribute__((address_space(3))) bf16x8*)(kp+6144); kf[7]=*(const __attribute__((address_space(3))) bf16x8*)(kp+6656);
}
__device__ __forceinline__ void kload2(bf16x8*kf,lds_cptr kp,int j){ kf[2*j]=*(const __attribute__((address_space(3))) bf16x8*)(kp+j*2048); kf[2*j+1]=*(const __attribute__((address_space(3))) bf16x8*)(kp+j*2048+512); }
__device__ __forceinline__ s16x4 vtr(lds_cptr p){ return __builtin_bit_cast(s16x4,__builtin_amdgcn_ds_read_tr16_b64_v4i16((__attribute__((address_space(3))) v4i16_t*)p)); }
__device__ __forceinline__ float rowmax(const f32x16&p0,const f32x16&p1){
  float a=max3f(p0[0],p0[1],p1[0]),b=max3f(p0[2],p0[3],p1[1]);a=max3f(a,p1[2],p1[3]);
  #pragma unroll
  for(int r=4;r<16;r+=4){a=max3f(a,p0[r],p0[r+1]);b=max3f(b,p0[r+2],p0[r+3]);a=max3f(a,p1[r],p1[r+1]);b=max3f(b,p1[r+2],p1[r+3]);}
  const float m=max2f(a,b);
  auto rr=__builtin_amdgcn_permlane32_swap(__float_as_uint(m),__float_as_uint(m),false,false);
  return max2f(__uint_as_float(rr[0]),__uint_as_float(rr[1]));
}
__device__ __forceinline__ void pv(f32x16*o,int vb,bf16x8 pa0,bf16x8 pa1,bf16x8 pa2,bf16x8 pa3){
  #pragma unroll
  for(int d0=0;d0<2;++d0){s16x4 lo[4],hi[4];
    #pragma unroll
    for(int ks=0;ks<4;++ks){
      asm volatile("ds_read_b64_tr_b16 %0,%1 offset:%c2":"=&v"(lo[ks]):"v"(vb),"i"(d0*4096+ks*1024):"memory");
      asm volatile("ds_read_b64_tr_b16 %0,%1 offset:%c2":"=&v"(hi[ks]):"v"(vb),"i"(d0*4096+ks*1024+512):"memory");}
    asm volatile("s_waitcnt lgkmcnt(0)":::"memory");SBAR();
    #define PK(k) (bf16x8){lo[k][0],lo[k][1],lo[k][2],lo[k][3],hi[k][0],hi[k][1],hi[k][2],hi[k][3]}
    o[d0]=__builtin_amdgcn_mfma_f32_32x32x16_bf16(pa0,PK(0),o[d0],0,0,0);
    o[d0]=__builtin_amdgcn_mfma_f32_32x32x16_bf16(pa1,PK(1),o[d0],0,0,0);
    o[d0]=__builtin_amdgcn_mfma_f32_32x32x16_bf16(pa2,PK(2),o[d0],0,0,0);
    o[d0]=__builtin_amdgcn_mfma_f32_32x32x16_bf16(pa3,PK(3),o[d0],0,0,0);
    #undef PK
  }
}

#ifndef ATTN_STORE16
#define ATTN_STORE16(p,v) (*(u32x4*)(p)=(v))
#endif
template<int THRL,int PQ,int PO> __device__ __forceinline__ void attn_unit(int qb,const bf16*Qh,const bf16*__restrict__ Kh,const bf16*__restrict__ Vh,bf16*Oh,char*shm){
  int tid_=threadIdx.x; asm volatile("":"+v"(tid_)); const int tid=tid_,lane=tid&63,r32=lane&31,hi=lane>>5; const int wid=__builtin_amdgcn_readfirstlane(tid>>6);
  const int q0=qb*QB;
  const bf16*Qw=Qh+(long)(q0+wid*QBLK)*PQ;
  const unsigned lds0=(unsigned)(uintptr_t)shm;
  float*wsf=(float*)(shm+LDS_WS)+wid*64;
  const bf16*ksrc=Kh+(long)lane*PQ+wid*8;
  const bf16*vsrc=Vh+(long)(16*(wid&3)+(lane>>2))*PQ+(wid>>2)*32+(lane&3)*8;
  const unsigned kdst=lds0+LDS_K+wid*1024, vdst=lds0+LDS_V+wid*1024;
  #define DMA_K(t,slot) glds16(ksrc+(long)(t)*KVBLK*PQ,(unsigned)__builtin_amdgcn_readfirstlane(kdst+(slot)))
  #define DMA_V(t,slot) glds16(vsrc+(long)(t)*KVBLK*PQ,(unsigned)__builtin_amdgcn_readfirstlane(vdst+(slot)))
  const int vb0=(int)(lds0+LDS_V)+((lane>>4)&1)*32+(lane&3)*8+(4*hi+((lane&15)>>2))*64;
  const char*Kbase=shm+LDS_K; bf16x8 kf[8];
  const lds_cptr shm3=(lds_cptr)shm; const lds_cptr kp0=shm3+LDS_K+hi*1024+r32*16; const lds_cptr vp0=shm3+LDS_V+((lane>>4)&1)*32+(lane&3)*8+(4*hi+((lane&15)>>2))*64;
  const int NT=(q0+QB)/KVBLK;
  DMA_K(0,0);DMA_V(0,0);DMA_K(1,SLOTB);
  bf16x8 qr[4];
  #pragma unroll
  for(int d0=0;d0<4;++d0)qr[d0]=*reinterpret_cast<const bf16x8*>(&Qw[(long)r32*PQ+d0*16+hi*8]);
  float mhat=0.f,l_reg=0.f;f32x16 o[2];o[0]=f32x16{};o[1]=f32x16{};f32x16 negm=f32x16{};asm volatile("":"+v"(negm));
  const int qrel=wid*QBLK+r32;
  #define CMASK(P0,P1,t) do{int jb_=(t)-(NT-4); if(jb_>=0)cmask(P0,P1,jb_,qrel,hi);}while(0)
  bool resc=false;
  #define START(P0,P1) do{ const float rm=rowmax(P0,P1); resc=false; \
    { const float dl=rm; mhat=fadd_s(mhat,dl); \
      _Pragma("unroll") for(int r=0;r<16;++r){P0[r]=fsub_s(P0[r],dl);P1[r]=fsub_s(P1[r],dl);} \
      _Pragma("unroll") for(int r=0;r<16;++r)negm[r]=-mhat; asm volatile("":"+v"(negm)); } \
    _Pragma("unroll") for(int r=0;r<16;++r)P0[r]=__builtin_amdgcn_exp2f(P0[r]); }while(0)
  #define RESC() do{ if(resc){ asm volatile("s_waitcnt lgkmcnt(0)":::"memory"); \
      _Pragma("unroll") for(int d_=0;d_<2;++d_) _Pragma("unroll") for(int r=0;r<16;++r)o[d_][r]*=wsf[crow(r,hi)]; } }while(0)
  f32x16 pA0,pA1,pB0,pB1;
  int sl_prev=0,sl_cur=0,sl_next=SLOTB;
  #define ROT() do{sl_prev=sl_cur;sl_cur=sl_next;sl_next=(sl_next==(NSLOT-1)*SLOTB)?0:sl_next+SLOTB;}while(0)
  DMA_K(2,2*SLOTB);
  WAIT_BAR(3);
  qkt(pA0,pA1,Kbase,qr,negm,r32,hi);asm volatile("s_nop 15\n\ts_nop 7":"+v"(pA0),"+v"(pA1));CMASK(pA0,pA1,0);
  START(pA0,pA1);
  _Pragma("unroll") for(int r=0;r<16;++r)pA1[r]=__builtin_amdgcn_exp2f(pA1[r]);
  WAIT_BAR(0);
  DMA_K(3,0);DMA_V(1,SLOTB);
  ROT();
  kload8(kf,kp0+sl_cur);
  WAIT_BAR(2);
  s16x4 vlo[8],vhi[8]; u32x4 pw0,pw1,pw2,pw3;
  #define PKW(P,B) cvtpk_s(P[B],P[B+1])
  #define PAF(k) __builtin_bit_cast(bf16x8,pw##k)
  #define VFR(i) (bf16x8){vlo[i][0],vlo[i][1],vlo[i][2],vlo[i][3],vhi[i][0],vhi[i][1],vhi[i][2],vhi[i][3]}
  #define PIN(x) asm volatile("":"+v"(x))
  #define MX3(a,b,c) __builtin_fmaxf(__builtin_fmaxf((a),(b)),(c))
  #define GAPA(MF,A0,A1,A2,A3,W0,W1,PW) do{ MF; sacc+=A0; sacc+=A1; sacc+=A2; sacc+=A3; PIN(sacc); W0; W1; PIN(PW); SBAR(); }while(0)
  #define EX(v) __builtin_amdgcn_exp2f(v)
  #define GAPB(MF,X,B) do{ MF; X[B]=EX(X[B]); X[B+1]=EX(X[B+1]); X[B+2]=EX(X[B+2]); X[B+3]=EX(X[B+3]); PIN(X); SBAR(); }while(0)
  #define VRD(i) do{ vlo[i]=vtr(vp_+(((i)>>2)*4096+((i)&3)*1024)); vhi[i]=vtr(vp_+(((i)>>2)*4096+((i)&3)*1024+512)); }while(0)
  #define KRD(G,j) do{ if(G){ kload2(kf,kp0+sl_next,j); SBAR(); } }while(0)
  #define STEP(C0,C1,P0,P1,t,GK,GV,GL) do{ SBAR(); \
    const lds_cptr vp_=vp0+sl_prev; \
    VRD(0); SBAR(); float sacc=(P0[0]+P0[1]); \
    GAPA(C0=__builtin_amdgcn_mfma_f32_32x32x16_bf16(kf[0],qr[0],negm,0,0,0), P0[2],P0[3],P0[4],P0[5],     pw0[0]=PKW(P0,0), pw0[1]=PKW(P0,2), pw0); \
    VRD(4); SBAR(); GAPA(C1=__builtin_amdgcn_mfma_f32_32x32x16_bf16(kf[1],qr[0],negm,0,0,0), P0[6],P0[7],P0[8],P0[9],     pw0[2]=PKW(P0,4), pw0[3]=PKW(P0,6), pw0); \
    VRD(1); SBAR(); GAPA(C0=__builtin_amdgcn_mfma_f32_32x32x16_bf16(kf[2],qr[1],C0,0,0,0),   P0[10],P0[11],P0[12],P0[13], pw1[0]=PKW(P0,8), pw1[1]=PKW(P0,10), pw1); \
    VRD(5); SBAR(); GAPA(C1=__builtin_amdgcn_mfma_f32_32x32x16_bf16(kf[3],qr[1],C1,0,0,0),   P0[14],P0[15],P1[0],P1[1],   pw1[2]=PKW(P0,12),pw1[3]=PKW(P0,14), pw1); \
    VRD(2); SBAR(); GAPA(C0=__builtin_amdgcn_mfma_f32_32x32x16_bf16(kf[4],qr[2],C0,0,0,0),   P1[2],P1[3],P1[4],P1[5],     pw2[0]=PKW(P1,0), pw2[1]=PKW(P1,2), pw2); \
    VRD(6); SBAR(); GAPA(C1=__builtin_amdgcn_mfma_f32_32x32x16_bf16(kf[5],qr[2],C1,0,0,0),   P1[6],P1[7],P1[8],P1[9],     pw2[2]=PKW(P1,4), pw2[3]=PKW(P1,6), pw2); \
    VRD(3); SBAR(); GAPA(C0=__builtin_amdgcn_mfma_f32_32x32x16_bf16(kf[6],qr[3],C0,0,0,0),   P1[10],P1[11],P1[12],P1[13], pw3[0]=PKW(P1,8), pw3[1]=PKW(P1,10), pw3); \
    VRD(7); SBAR(); GAPA(C1=__builtin_amdgcn_mfma_f32_32x32x16_bf16(kf[7],qr[3],C1,0,0,0),   P1[14],P1[15],0.f,0.f,       pw3[2]=PKW(P1,12),pw3[3]=PKW(P1,14), pw3); \
    l_reg+=sacc; \
    if(GK){DMA_K((t)+3,sl_cur);} if(GV){DMA_V((t)+1,sl_next);} \
    CMASK(C0,C1,t); \
    { float a=MX3(C0[0],C0[1],C1[0]),b=MX3(C0[2],C0[3],C1[1]); a=MX3(a,C1[2],C1[3]); \
      _Pragma("unroll") for(int r=4;r<16;r+=4){a=MX3(a,C0[r],C0[r+1]);b=MX3(b,C0[r+2],C0[r+3]);a=MX3(a,C1[r],C1[r+1]);b=MX3(b,C1[r+2],C1[r+3]);} \
      float rm=__builtin_fmaxf(a,b); { auto rr=__builtin_amdgcn_permlane32_swap(__float_as_uint(rm),__float_as_uint(rm),false,false); rm=__builtin_fmaxf(__uint_as_float(rr[0]),__uint_as_float(rr[1])); } \
      resc=false; \
      if(__builtin_expect(__any(rm>(float)THRL),0)){ const float dl=__builtin_fmaxf(rm,0.f); mhat+=dl; \
        _Pragma("unroll") for(int r=0;r<16;++r){C0[r]-=dl;C1[r]-=dl;} \
        _Pragma("unroll") for(int r=0;r<16;++r)negm[r]=-mhat; asm volatile("":"+v"(negm)); \
        const float f=__builtin_amdgcn_exp2f(-dl); l_reg*=f; if(hi==0)wsf[r32]=f; resc=true; } } \
    SBAR(); \
    GAPB(o[0]=__builtin_amdgcn_mfma_f32_32x32x16_bf16(PAF(0),VFR(0),o[0],0,0,0), C0,0); \
    GAPB(o[1]=__builtin_amdgcn_mfma_f32_32x32x16_bf16(PAF(0),VFR(4),o[1],0,0,0), C0,4); \
    KRD(GL,0); GAPB(o[0]=__builtin_amdgcn_mfma_f32_32x32x16_bf16(PAF(1),VFR(1),o[0],0,0,0), C0,8); \
    KRD(GL,1); GAPB(o[1]=__builtin_amdgcn_mfma_f32_32x32x16_bf16(PAF(1),VFR(5),o[1],0,0,0), C0,12); \
    KRD(GL,2); GAPB(o[0]=__builtin_amdgcn_mfma_f32_32x32x16_bf16(PAF(2),VFR(2),o[0],0,0,0), C1,0); \
    KRD(GL,3); GAPB(o[1]=__builtin_amdgcn_mfma_f32_32x32x16_bf16(PAF(2),VFR(6),o[1],0,0,0), C1,4); \
    GAPB(o[0]=__builtin_amdgcn_mfma_f32_32x32x16_bf16(PAF(3),VFR(3),o[0],0,0,0), C1,8); \
    GAPB(o[1]=__builtin_amdgcn_mfma_f32_32x32x16_bf16(PAF(3),VFR(7),o[1],0,0,0), C1,12); \
    }while(0)
  int t=1;
  #undef CMASK
  #define CMASK(P0,P1,t) do{}while(0)
  for(;t+5<NT;t+=2){
    STEP(pB0,pB1,pA0,pA1,t,true,true,true);     WAIT_BAR(2); RESC(); ROT();
    STEP(pA0,pA1,pB0,pB1,t+1,true,true,true);   WAIT_BAR(2); RESC(); ROT();
  }
  #undef CMASK
  #define CMASK(P0,P1,t) do{int jb_=(t)-(NT-4); if(jb_>=0)cmask(P0,P1,jb_,qrel,hi);}while(0)
  #define ENDW(tt) do{ if((tt)+3<NT){WAIT_BAR(2);} else if((tt)+2<NT){WAIT_BAR(1);} else {WAIT_BAR(0);} }while(0)
  for(;t+1<NT;t+=2){
    STEP(pB0,pB1,pA0,pA1,t,(t+3<NT),(t+1<NT),(t+1<NT));       ENDW(t);   RESC(); ROT();
    STEP(pA0,pA1,pB0,pB1,t+1,(t+4<NT),(t+2<NT),(t+2<NT));     ENDW(t+1); RESC(); ROT();
  }
  STEP(pB0,pB1,pA0,pA1,NT-1,false,false,false); RESC();
  { float sacc=pB0[0]+pB0[1]; _Pragma("unroll") for(int r=2;r<16;++r)sacc+=pB0[r]; _Pragma("unroll") for(int r=0;r<16;++r)sacc+=pB1[r]; l_reg+=sacc;
    pw0=(u32x4){PKW(pB0,0),PKW(pB0,2),PKW(pB0,4),PKW(pB0,6)};pw1=(u32x4){PKW(pB0,8),PKW(pB0,10),PKW(pB0,12),PKW(pB0,14)};pw2=(u32x4){PKW(pB1,0),PKW(pB1,2),PKW(pB1,4),PKW(pB1,6)};pw3=(u32x4){PKW(pB1,8),PKW(pB1,10),PKW(pB1,12),PKW(pB1,14)};
    SBAR(); pv(o,vb0+sl_cur,PAF(0),PAF(1),PAF(2),PAF(3)); }
  #undef PKW
  #undef PAF
  #undef VFR
  #undef PIN
  #undef MX3
  #undef GAPA
  #undef GAPB
  #undef EX
  #undef VRD
  #undef KRD
  #undef STEP
  #undef ENDW
  {auto rr=__builtin_amdgcn_permlane32_swap(__float_as_uint(l_reg),__float_as_uint(l_reg),false,false);l_reg=__uint_as_float(rr[0])+__uint_as_float(rr[1]);}
  if(hi==0)wsf[32+r32]=l_reg;asm volatile("s_waitcnt lgkmcnt(0)":::"memory");
  float rli[16];
  #pragma unroll
  for(int r=0;r<16;++r)rli[r]=__builtin_amdgcn_rcpf(wsf[32+crow(r,hi)]);
  bf16*Ow=Oh+(long)(q0+wid*QBLK)*PO;
  { bf16*stg=(bf16*)(shm+LDS_OST)+wid*2048;
    #pragma unroll
    for(int r=0;r<16;++r){const int orow=crow(r,hi);
      #pragma unroll
      for(int d0=0;d0<2;++d0)stg[orow*64+d0*32+r32]=__float2bfloat16(o[d0][r]*rli[r]);}
    asm volatile("s_waitcnt lgkmcnt(0)":::"memory");
    #pragma unroll
    for(int i=0;i<4;++i){const int row=i*8+(lane>>3),ch=lane&7; const u32x4 v=*(const u32x4*)(stg+row*64+ch*8); ATTN_STORE16(Ow+(long)row*PO+ch*8,v);} }
  asm volatile("s_waitcnt lgkmcnt(0)\n\ts_barrier":::"memory");
  #undef DMA_K
  #undef DMA_V
  #undef CMASK
  #undef START
  #undef RESC
  #undef ROT
}
constexpr int ATTN_LDS_BYTES=LDS_BYTES;
#undef SBAR
#undef WAIT_BAR
}

#define XB_TMO      128
#define XB_XCNT(j)  (256  + 64 * (j))
#define XB_XSUB(j)  (1280 + 64 * (j))
#define XB_XGEN(j)  (2304 + 64 * (j))
#define XB_TOP      3328
#define XB_TOPGEN   3392
#define XCD_BAR_WORDS 3456
#define XB_SPIN_CAP (1u << 22)
#define LAS __attribute__((address_space(3)))

__device__ __forceinline__ unsigned xb_ld(unsigned* p)              { return __hip_atomic_load(p, __ATOMIC_RELAXED, __HIP_MEMORY_SCOPE_AGENT); }
__device__ __forceinline__ unsigned xb_add(unsigned* p, unsigned v) { return __hip_atomic_fetch_add(p, v, __ATOMIC_RELAXED, __HIP_MEMORY_SCOPE_AGENT); }
__device__ __forceinline__ unsigned xb_xcc_id() { return (unsigned)__builtin_amdgcn_s_getreg((3 << 11) | 20) & 0xFu; }
#define XB_SPIN(cond, bar) do { unsigned _sp = 0; while (cond) { __builtin_amdgcn_s_sleep(1); \
    if ((++_sp & 255u) == 0u) { if (xb_ld(&(bar)[XB_TMO])) break; if (_sp > XB_SPIN_CAP) { atomicAdd(&(bar)[XB_TMO], 1u); break; } } } } while (0)

struct XcdBarrier {
    unsigned* bar; unsigned x;
    volatile LAS unsigned* st;
};

__device__ __forceinline__ XcdBarrier xcd_barrier_post(unsigned* bar, volatile LAS unsigned* st) {
    XcdBarrier b; b.bar = bar; b.x = xb_xcc_id(); b.st = st;
    if (threadIdx.x == 0) (void)xb_add(&bar[XB_XCNT(b.x)], 1u);
    return b;
}
__device__ __forceinline__ void xcd_barrier_complete(unsigned* bar, unsigned x, unsigned& nloc, unsigned& nx) {
    const unsigned G = gridDim.x * gridDim.y * gridDim.z;
    unsigned sum, cnt, mine, sp = 0u;
    for (;;) {
        sum = 0u; cnt = 0u; mine = 0u;
#pragma unroll
        for (unsigned j = 0; j < 16; ++j) { const unsigned c = xb_ld(&bar[XB_XCNT(j)]); sum += c; cnt += (c > 0u) ? 1u : 0u; mine = (j == x) ? c : mine; }
        if (sum == G) break;
        __builtin_amdgcn_s_sleep(1);
        if ((++sp & 255u) == 0u) { if (xb_ld(&bar[XB_TMO])) break; if (sp > XB_SPIN_CAP) { atomicAdd(&bar[XB_TMO], 1u); break; } }
    }
    nloc = mine > 0u ? mine : 1u; nx = cnt > 0u ? cnt : 1u;
}

__device__ __forceinline__ void xcd_barrier(const XcdBarrier& b) {
    asm volatile("s_waitcnt vmcnt(0)" ::: "memory");
    __syncthreads();
    if (threadIdx.x == 0) {
        unsigned* bar = b.bar; unsigned bx = b.x; asm volatile("" : "+s"(bx));
        __builtin_amdgcn_s_waitcnt(0);
        unsigned nloc = b.st[0], nx = b.st[1];
        if (nloc == 0u) { xcd_barrier_complete(bar, bx, nloc, nx); b.st[0] = nloc; b.st[1] = nx; }
        const unsigned old = xb_add(&bar[XB_XSUB(bx)], 1u);
        const unsigned gen = old / nloc;
        if (old + 1u == (gen + 1u) * nloc) {
            __builtin_amdgcn_fence(__ATOMIC_RELEASE, "agent");
            asm volatile("s_waitcnt vmcnt(0)" ::: "memory");
            const unsigned og = xb_add(&bar[XB_TOP], 1u);
            const unsigned tg = og / nx;
            if (og + 1u == (tg + 1u) * nx) xb_add(&bar[XB_TOPGEN], 1u);
            else XB_SPIN(xb_ld(&bar[XB_TOPGEN]) == tg, bar);
            __builtin_amdgcn_fence(__ATOMIC_ACQUIRE, "agent");
            xb_add(&bar[XB_XGEN(bx)], 1u);
            asm volatile("s_waitcnt vmcnt(0)" ::: "memory");
        } else {
            XB_SPIN(xb_ld(&bar[XB_XGEN(bx)]) == gen, bar);
            __builtin_amdgcn_fence(__ATOMIC_ACQUIRE, "agent");
            asm volatile("s_waitcnt vmcnt(0)" ::: "memory");
        }
    }
    __syncthreads();
}


#define LAS __attribute__((address_space(3)))
typedef unsigned short bf16_t;
typedef float f32x4 __attribute__((ext_vector_type(4)));
typedef unsigned u32x4 __attribute__((ext_vector_type(4)));
typedef unsigned u32x2 __attribute__((ext_vector_type(2)));

constexpr int T = 16384, DM = 1024, SEQ = 4096, NB = 4, DEPTH = 2;
constexpr int PLD = 13568;
constexpr int C_Z = 0, C_X = 512, C_QB = 1280, C_KB = 2816, C_VB = 4352, C_QC = 5888, C_KC = 6400, C_VC = 6912,
              C_QD = 7424, C_FD = 7936, C_ID = 8448, C_GD = 8960, C_GATE = 9472;
constexpr int WIN_LD = 13576;
constexpr float EPS = 1e-6f;
constexpr int NWAVES = 8, NTHR = 512;
constexpr int MAXROWS = 49152;

constexpr size_t MiB = 1u << 20, KiB = 1u << 10;
constexpr size_t WS_CTL = 0, CTL_ZERO_BYTES = 1 * MiB;
constexpr int CW_BAR = 4096;
constexpr int CW_WQ = 8192;
constexpr int CW_ECNT = 9216;
constexpr size_t WS_SSQ = 3 * MiB;
constexpr size_t WS_MOD = 1 * MiB;
constexpr size_t WS_DT = 1 * MiB + 256 * KiB;
constexpr size_t WS_RE = 2 * MiB, WS_RS = WS_RE + 128 * KiB, WS_RW = WS_RE + 256 * KiB, WS_POS = WS_RE + 384 * KiB, WS_ROWW = WS_RE + 512 * KiB;
constexpr size_t WS_WIN = 4 * MiB;
constexpr size_t WS_WMG = 31 * MiB;
constexpr size_t WS_WOUT = 35 * MiB;
constexpr size_t WS_H = 38 * MiB;
constexpr size_t WS_MIXS = 70 * MiB;
constexpr size_t WS_BR = 102 * MiB;
constexpr size_t WS_P = 166 * MiB;
constexpr size_t WS_E1 = WS_P, WS_E2 = WS_P + 64 * MiB, WS_XS = WS_P + 96 * MiB, WS_HID = WS_P + 192 * MiB, WS_Y = WS_P + 216 * MiB;
constexpr size_t WS_END = 590 * MiB;
static_assert(WS_Y + (size_t)MAXROWS * 1024 * 2 <= WS_END && WS_P + (size_t)T * PLD * 2 <= WS_END, "ws map");
static_assert(WS_WIN + (size_t)PLD * 1024 * 2 <= WS_WMG, "ws map");

constexpr int SCR_BYTES = 131072, MISC_OFF = SCR_BYTES, LDS_BYTES = 147456;

__device__ __forceinline__ float bf2f(bf16_t v) { return __uint_as_float(((unsigned)v) << 16); }
__device__ __forceinline__ unsigned f2bf(float f) { unsigned u = __float_as_uint(f); return (u + 0x7fffu + ((u >> 16) & 1u)) >> 16; }
__device__ __forceinline__ unsigned pk2(float lo, float hi) { return f2bf(lo) | (f2bf(hi) << 16); }
__device__ __forceinline__ float lo2f(unsigned w) { return __uint_as_float(w << 16); }
__device__ __forceinline__ float hi2f(unsigned w) { return __uint_as_float(w & 0xffff0000u); }
#define wave_sum(v) wave_sum_(v, lane)
#define wave_max(v) wave_max_(v, lane)
__device__ __forceinline__ float wave_sum_(float v, int lane) {
#pragma unroll
    for (int o = 32; o >= 1; o >>= 1) v += __int_as_float(__builtin_amdgcn_ds_bpermute((lane ^ o) << 2, __float_as_int(v)));
    return v; }
__device__ __forceinline__ float wave_max_(float v, int lane) {
#pragma unroll
    for (int o = 32; o >= 1; o >>= 1) v = fmaxf(v, __int_as_float(__builtin_amdgcn_ds_bpermute((lane ^ o) << 2, __float_as_int(v))));
    return v; }
__device__ __forceinline__ float sigmoidf_(float x) { return 1.0f / (1.0f + __expf(-x)); }
__device__ __forceinline__ float siluf_(float x) { return x / (1.0f + __expf(-x)); }
__device__ __forceinline__ float softplusf_(float x) { return x > 20.f ? x : log1pf(__expf(x)); }

struct Ctx {
    float* out; unsigned char* ws;
    LAS unsigned char* lds;
    int G, bid;
};
#define PH_IDS() int tid = threadIdx.x; asm volatile("" : "+v"(tid)); const int lane = tid & 63; const int wave = __builtin_amdgcn_readfirstlane(tid >> 6); (void)lane; (void)wave
__device__ __forceinline__ const float* inp_ptr(const Ctx& C, int k) {
    unsigned ta = MISC_OFF + 1024 + 8 * k; asm volatile("" : "+s"(ta));
    const LAS unsigned* t = (const LAS unsigned*)(LAS unsigned char*)(size_t)0 + 0; t = (const LAS unsigned*)(C.lds + ta);
    const unsigned lo = __builtin_amdgcn_readfirstlane(t[0]), hi = __builtin_amdgcn_readfirstlane(t[1]);
    return (const float*)(((unsigned long long)hi << 32) | lo);
}
#define INP(k) inp_ptr(C, k)
#define MISCW(C) ((volatile LAS unsigned*)((C).lds + MISC_OFF))
enum { I_X = 0, I_C, I_WADA, I_BADA, I_NMIX, I_NFFN, I_WIN, I_CONVW, I_CONVB, I_DTB, I_ALOG, I_SSDD, I_SSDNW, I_DLAM, I_SUBLN, I_LBL, I_HGNW, I_WMG, I_WOUT, I_WR, I_RB, I_EG, I_EU, I_ED, I_FNW };

__device__ __forceinline__ void pro_mods(const Ctx& C) {
    PH_IDS();
    LAS float* cact = (LAS float*)C.lds;
    LAS float* red = cact + 4096;
    for (int i = tid; i < 4096; i += NTHR) cact[i] = siluf_(INP(I_C)[i]);
    __syncthreads();
    float* mod = (float*)(C.ws + WS_MOD);
    for (int u = C.bid; u < 2 * 96; u += C.G) {
        const int l = u / 96, col0 = (u % 96) * 64;
        const float* w = INP(I_WADA) + (size_t)l * 1024 * 6144 + col0 + lane;
        float a0 = 0.f, a1 = 0.f, a2 = 0.f, a3 = 0.f;
        const int kb = wave * 128;
#pragma unroll 8
        for (int kk = 0; kk < 128; ++kk) { const int k = kb + kk; const float wv = w[(size_t)k * 6144];
            a0 += cact[k] * wv; a1 += cact[1024 + k] * wv; a2 += cact[2048 + k] * wv; a3 += cact[3072 + k] * wv; }
        red[(wave * 4 + 0) * 64 + lane] = a0; red[(wave * 4 + 1) * 64 + lane] = a1; red[(wave * 4 + 2) * 64 + lane] = a2; red[(wave * 4 + 3) * 64 + lane] = a3;
        __syncthreads();
        if (tid < 256) { const int b = tid >> 6, cl = tid & 63; float s = 0.f;
#pragma unroll
            for (int wv = 0; wv < 8; ++wv) s += red[(wv * 4 + b) * 64 + cl];
            mod[((size_t)l * 4 + b) * 6144 + col0 + cl] = s + INP(I_BADA)[l * 6144 + col0 + cl]; }
        __syncthreads();
    }
}

template <class Map> __device__ __forceinline__ void transpose_tile(const float* src, int ld, int k0, int n0, bf16_t* dst, int K, const Map& mp, LAS float* scr, int lane) {
    const int nn_l = lane & 31, kh = lane >> 5;
#pragma unroll 8
    for (int i = 0; i < 32; ++i) { const int kk = 2 * i + kh; scr[kk * 33 + nn_l] = src[(size_t)(k0 + kk) * ld + mp.scol(n0 + nn_l)]; }
    asm volatile("s_waitcnt vmcnt(0) lgkmcnt(0)" ::: "memory");
    const int kp = lane & 31;
#pragma unroll 4
    for (int j = 0; j < 16; ++j) { const int nn = 2 * j + kh; const float sc = mp.scale(n0 + nn);
        const float v0 = scr[(2 * kp) * 33 + nn] * sc, v1 = scr[(2 * kp + 1) * 33 + nn] * sc;
        *(unsigned*)(dst + (size_t)mp.drow(n0 + nn) * K + k0 + 2 * kp) = pk2(v0, v1); }
    asm volatile("s_waitcnt lgkmcnt(0)" ::: "memory");
}
struct MapWin {
    __device__ __forceinline__ int scol(int n) const { return n < 1280 ? n : n + 8; }
    __device__ __forceinline__ int drow(int n) const { return n; }
    __device__ __forceinline__ float scale(int n) const { return (n >= C_QC && n < C_QC + 512) ? 0.125f * 1.4426950408889634f : 1.0f; }
};
struct MapPlain { int roff;
    __device__ __forceinline__ int scol(int n) const { return n; }
    __device__ __forceinline__ int drow(int n) const { return roff + n; }
    __device__ __forceinline__ float scale(int) const { return 1.0f; }
};
struct MapGU { int roff, up;
    __device__ __forceinline__ int scol(int n) const { return n; }
    __device__ __forceinline__ int drow(int j) const { return roff + (j >> 7) * 256 + ((j & 127) >> 2) * 8 + (j & 3) + 4 * up; }
    __device__ __forceinline__ float scale(int) const { return 1.0f; }
};
__device__ __forceinline__ void convert_main(const Ctx& C, int l) {
    PH_IDS();
    LAS float* scr = (LAS float*)C.lds + wave * (64 * 33);
    const int gw = C.bid * NWAVES + wave, NGW = C.G * NWAVES;
    constexpr int I_A = 16 * (PLD / 32), I_B = 4 * 8 * 32, I_C2 = 16 * 32;
    bf16_t* WIN = (bf16_t*)(C.ws + WS_WIN); bf16_t* WMG = (bf16_t*)(C.ws + WS_WMG); bf16_t* WO = (bf16_t*)(C.ws + WS_WOUT);
    for (int it = gw; it < I_A + I_B + I_C2; it += NGW) {
        int r = it;
        if (r < I_A) { const int kt = r & 15, nt = r >> 4; transpose_tile(INP(I_WIN) + (size_t)l * 1024 * WIN_LD, WIN_LD, kt * 64, nt * 32, WIN, 1024, MapWin{}, scr, lane); continue; }
        r -= I_A;
        if (r < I_B) { const int n = r >> 8, q = r & 255, kt = q & 7, nt = q >> 3;
            transpose_tile(INP(I_WMG) + ((size_t)l * 4 + n) * 512 * 1024, 1024, kt * 64, nt * 32, WMG, 512, MapPlain{n * 1024}, scr, lane); continue; }
        r -= I_B;
        { const int kt = r & 15, nt = r >> 4; transpose_tile(INP(I_WOUT) + (size_t)l * 1024 * 1024, 1024, kt * 64, nt * 32, WO, 1024, MapPlain{0}, scr, lane); }
    }
}
__device__ __forceinline__ void convert_experts(const Ctx& C, int l) {
    PH_IDS();
    LAS float* scr = (LAS float*)C.lds + wave * (64 * 33);
    const int gw = C.bid * NWAVES + wave, NGW = C.G * NWAVES;
    bf16_t* E1 = (bf16_t*)(C.ws + WS_E1); bf16_t* E2 = (bf16_t*)(C.ws + WS_E2);
    for (int it = gw; it < 64 * 384; it += NGW) {
        const int e = it / 384, r = it % 384, m = r >> 7, q = r & 127;
        if (m < 2) { const int kt = q & 15, nt = q >> 4;
            transpose_tile(INP(m == 0 ? I_EG : I_EU) + ((size_t)l * 64 + e) * 1024 * 256, 256, kt * 64, nt * 32, E1, 1024, MapGU{e * 512, m}, scr, lane); }
        else { const int kt = q & 3, nt = q >> 2;
            transpose_tile(INP(I_ED) + ((size_t)l * 64 + e) * 256 * 1024, 1024, kt * 64, nt * 32, E2, 256, MapPlain{e * 1024}, scr, lane); }
    }
}

template <int MODE> __device__ __forceinline__ void phase_rows(const Ctx& C, int l, bool combine) {
    PH_IDS();
    LAS float* wdt = (LAS float*)C.lds;
    if (MODE == 0) {
        const float* w = INP(I_WIN) + (size_t)l * 1024 * WIN_LD + 1280;
        for (int i = tid; i < 8192; i += NTHR) { const int k = i >> 3, j = i & 7; wdt[j * 1024 + k] = w[(size_t)k * WIN_LD + j]; }
        __syncthreads();
    }
    const int gw = C.bid * NWAVES + wave, NGW = C.G * NWAVES;
    const float* mod = (const float*)(C.ws + WS_MOD);
    float* xres = C.out; bf16_t* hb = (bf16_t*)(C.ws + WS_H); float* dtraw = (float*)(C.ws + WS_DT);
    const int* pos = (const int*)(C.ws + WS_POS); const bf16_t* Y = (const bf16_t*)(C.ws + WS_Y);
    const float* rwt = (const float*)(C.ws + WS_RW);
    const float* xsrc = (l == 0 && MODE == 0) ? INP(I_X) : xres;
    for (int row = gw; row < T; row += NGW) {
        const int b = row >> 12;
        f32x4 v[4];
#pragma unroll
        for (int j = 0; j < 4; ++j) v[j] = *(const f32x4*)(xsrc + (size_t)row * DM + 4 * lane + 256 * j);
        if (combine) {
            const int p0 = pos[row * 2], p1 = pos[row * 2 + 1];
            const float rw0 = rwt[row * 2], rw1 = rwt[row * 2 + 1];
            const float* g2 = mod + ((size_t)(l - 1) * 4 + b) * 6144 + 5120;
#pragma unroll
            for (int j = 0; j < 4; ++j) { const int col = 4 * lane + 256 * j;
                const u32x2 ya = *(const u32x2*)(Y + (size_t)p0 * DM + col), yb = *(const u32x2*)(Y + (size_t)p1 * DM + col);
                const f32x4 g = *(const f32x4*)(g2 + col);
                v[j].x += g.x * (rw0 * lo2f(ya.x) + rw1 * lo2f(yb.x)); v[j].y += g.y * (rw0 * hi2f(ya.x) + rw1 * hi2f(yb.x));
                v[j].z += g.z * (rw0 * lo2f(ya.y) + rw1 * lo2f(yb.y)); v[j].w += g.w * (rw0 * hi2f(ya.y) + rw1 * hi2f(yb.y));
                if (MODE == 0) *(f32x4*)(xres + (size_t)row * DM + col) = v[j]; }
        }
        float ss = 0.f;
#pragma unroll
        for (int j = 0; j < 4; ++j) ss += (v[j].x * v[j].x + v[j].y * v[j].y) + (v[j].z * v[j].z + v[j].w * v[j].w);
        const float rstd = rsqrtf(wave_sum(ss) * (1.0f / DM) + EPS);
        if (MODE == 1) {
#pragma unroll
            for (int j = 0; j < 4; ++j) { const int col = 4 * lane + 256 * j; const f32x4 w = *(const f32x4*)(INP(I_FNW) + col);
                *(f32x4*)(C.out + (size_t)row * DM + col) = v[j] * rstd * w; }
        } else {
            const float* nw = INP(I_NMIX) + l * DM; const float* sh = mod + ((size_t)l * 4 + b) * 6144; const float* sc = sh + 1024;
            float da[8];
#pragma unroll
            for (int i = 0; i < 8; ++i) da[i] = 0.f;
#pragma unroll
            for (int j = 0; j < 4; ++j) { const int col = 4 * lane + 256 * j;
                const f32x4 w = *(const f32x4*)(nw + col), s1 = *(const f32x4*)(sc + col), s0 = *(const f32x4*)(sh + col);
                const f32x4 hv = v[j] * rstd * w * (s1 + 1.0f) + s0;
                u32x2 o; o.x = pk2(hv.x, hv.y); o.y = pk2(hv.z, hv.w);
                *(u32x2*)(hb + (size_t)row * DM + col) = o;
#pragma unroll
                for (int i = 0; i < 8; ++i) { const f32x4 wd = *(const LAS f32x4*)(wdt + i * 1024 + col); da[i] += (hv.x * wd.x + hv.y * wd.y) + (hv.z * wd.z + hv.w * wd.w); } }
#pragma unroll
            for (int i = 0; i < 8; ++i) da[i] = wave_sum(da[i]);
            if (lane == 0) { *(f32x4*)(dtraw + (size_t)row * 8) = (f32x4){da[0], da[1], da[2], da[3]}; *(f32x4*)(dtraw + (size_t)row * 8 + 4) = (f32x4){da[4], da[5], da[6], da[7]}; }
        }
    }
}

__device__ __forceinline__ void phase_n2(const Ctx& C, int l) {
    PH_IDS();
    const int gw = C.bid * NWAVES + wave, NGW = C.G * NWAVES;
    LAS float* hq = (LAS float*)C.lds + wave * 4096;
    const float* mod = (const float*)(C.ws + WS_MOD);
    const float* xres = C.out; bf16_t* hb = (bf16_t*)(C.ws + WS_H);
    int* r_e = (int*)(C.ws + WS_RE); int* r_s = (int*)(C.ws + WS_RS); float* r_w = (float*)(C.ws + WS_RW);
    unsigned* ecnt = (unsigned*)(C.ws + WS_CTL) + CW_ECNT + 64 * l;
    const float* wr = INP(I_WR); const float rbias = INP(I_RB)[lane];
    const float* nw = INP(I_NFFN) + l * DM;
    for (int r0 = gw * 4; r0 < T; r0 += NGW * 4) {
        const int b = r0 >> 12;
        const float* sh = mod + ((size_t)l * 4 + b) * 6144 + 3072; const float* sc = sh + 1024;
#pragma unroll
        for (int rr = 0; rr < 4; ++rr) {
            const int row = r0 + rr;
            f32x4 v[4]; float ss = 0.f;
#pragma unroll
            for (int j = 0; j < 4; ++j) { v[j] = *(const f32x4*)(xres + (size_t)row * DM + 4 * lane + 256 * j); ss += (v[j].x * v[j].x + v[j].y * v[j].y) + (v[j].z * v[j].z + v[j].w * v[j].w); }
            const float rstd = rsqrtf(wave_sum(ss) * (1.0f / DM) + EPS);
#pragma unroll
            for (int j = 0; j < 4; ++j) { const int col = 4 * lane + 256 * j;
                const f32x4 w = *(const f32x4*)(nw + col), s1 = *(const f32x4*)(sc + col), s0 = *(const f32x4*)(sh + col);
                const f32x4 hv = v[j] * rstd * w * (s1 + 1.0f) + s0;
                u32x2 o; o.x = pk2(hv.x, hv.y); o.y = pk2(hv.z, hv.w);
                *(u32x2*)(hb + (size_t)row * DM + col) = o;
                hq[(col + 0) * 4 + rr] = hv.x; hq[(col + 1) * 4 + rr] = hv.y; hq[(col + 2) * 4 + rr] = hv.z; hq[(col + 3) * 4 + rr] = hv.w; }
        }
        asm volatile("s_waitcnt lgkmcnt(0)" ::: "memory");
        float a0 = 0.f, a1 = 0.f, a2 = 0.f, a3 = 0.f;
#pragma unroll 8
        for (int k = 0; k < 1024; ++k) { const float w = wr[k * 64 + lane]; const f32x4 h4 = *(const LAS f32x4*)(hq + k * 4);
            a0 += h4.x * w; a1 += h4.y * w; a2 += h4.z * w; a3 += h4.w * w; }
        asm volatile("s_waitcnt lgkmcnt(0)" ::: "memory");
        { const float s0 = sigmoidf_(a0), s1 = sigmoidf_(a1), s2 = sigmoidf_(a2), s3 = sigmoidf_(a3);
          hq[0 * 64 + lane] = s0 + rbias; hq[1 * 64 + lane] = s1 + rbias; hq[2 * 64 + lane] = s2 + rbias; hq[3 * 64 + lane] = s3 + rbias;
          hq[256 + 0 * 64 + lane] = s0; hq[256 + 1 * 64 + lane] = s1; hq[256 + 2 * 64 + lane] = s2; hq[256 + 3 * 64 + lane] = s3; }
        asm volatile("s_waitcnt lgkmcnt(0)" ::: "memory");
        if (lane < 4) {
            const LAS float* sel = hq + lane * 64; const LAS float* sco = hq + 256 + lane * 64;
            int best = 0; float bestv = -3.0e38f;
            for (int g = 0; g < 8; ++g) { float m1 = -3.0e38f, m2 = -3.0e38f;
                for (int i = 0; i < 8; ++i) { const float x = sel[g * 8 + i]; if (x > m1) { m2 = m1; m1 = x; } else if (x > m2) m2 = x; }
                const float gs = m1 + m2; if (gs > bestv) { bestv = gs; best = g; } }
            int i0 = 0; float v0 = -3.0e38f;
            for (int i = 0; i < 8; ++i) { const float x = sel[best * 8 + i]; if (x > v0) { v0 = x; i0 = i; } }
            int i1 = 0; float v1 = -3.0e38f;
            for (int i = 0; i < 8; ++i) { if (i == i0) continue; const float x = sel[best * 8 + i]; if (x > v1) { v1 = x; i1 = i; } }
            const int e0 = best * 8 + i0, e1 = best * 8 + i1; const float s0 = sco[e0], s1 = sco[e1], inv = 1.0f / (s0 + s1);
            const int row = r0 + lane;
            const unsigned sl0 = atomicAdd(ecnt + e0, 1u), sl1 = atomicAdd(ecnt + e1, 1u);
            r_e[row * 2] = e0; r_e[row * 2 + 1] = e1; r_s[row * 2] = (int)sl0; r_s[row * 2 + 1] = (int)sl1; r_w[row * 2] = s0 * inv; r_w[row * 2 + 1] = s1 * inv;
        }
        asm volatile("s_waitcnt lgkmcnt(0)" ::: "memory");
    }
}

__device__ __forceinline__ void build_blocks(const Ctx& C, int l) {
    PH_IDS();
    const unsigned* ecnt = (const unsigned*)(C.ws + WS_CTL) + CW_ECNT + 64 * l;
    LAS unsigned char* blk_e = C.lds + MISC_OFF + 64; LAS int* blk0 = (LAS int*)(C.lds + MISC_OFF + 512);
    if (tid == 0) { int nb = 0;
        for (int e = 0; e < 64; ++e) { const int c = (int)__hip_atomic_load(ecnt + e, __ATOMIC_RELAXED, __HIP_MEMORY_SCOPE_AGENT); const int k = (c + 255) >> 8; blk0[e] = nb;
            for (int i = 0; i < k && nb + i < 192; ++i) blk_e[nb + i] = (unsigned char)e; nb += k; }
        blk0[64] = nb; MISCW(C)[5] = (unsigned)(nb > 192 ? 192 : nb); }
    __syncthreads();
}
__device__ __forceinline__ void phase_scatter(const Ctx& C, int l) {
    PH_IDS();
    build_blocks(C, l);
    const LAS int* blk0 = (const LAS int*)(C.lds + MISC_OFF + 512);
    const int gw = C.bid * NWAVES + wave, NGW = C.G * NWAVES;
    const int* r_e = (const int*)(C.ws + WS_RE); const int* r_s = (const int*)(C.ws + WS_RS);
    int* pos = (int*)(C.ws + WS_POS);
    const bf16_t* hb = (const bf16_t*)(C.ws + WS_H); bf16_t* XS = (bf16_t*)(C.ws + WS_XS);
    for (int it = gw; it < T * 2; it += NGW) {
        const int t = it >> 1; const int e = r_e[it], sl = r_s[it]; const int row = blk0[e] * 256 + sl;
        const u32x4 a = *(const u32x4*)(hb + (size_t)t * DM + lane * 8), b2 = *(const u32x4*)(hb + (size_t)t * DM + 512 + lane * 8);
        *(u32x4*)(XS + (size_t)row * DM + lane * 8) = a; *(u32x4*)(XS + (size_t)row * DM + 512 + lane * 8) = b2;
        if (lane == 0) pos[it] = row;
    }
}

template <int TYPE> __device__ __forceinline__ void chain_unit(const Ctx& C, int l, int b, int head) {
    PH_IDS();
    constexpr int CH = 32;
    LAS float* Fs = (LAS float*)C.lds; LAS float* Ks = Fs + 2048; LAS float* Qs = Fs + 4096; LAS float* Vs = Fs + 6144; LAS float* Xc = Fs + 8192; LAS float* Yp = Fs + 10240;
        const bf16_t* P = (const bf16_t*)(C.ws + WS_P);
    const float* dtraw = (const float*)(C.ws + WS_DT);
    bf16_t* BR = (bf16_t*)(C.ws + WS_BR) + (size_t)(TYPE == 0 ? 0 : 3) * T * 512;
    float* ssq = (float*)(C.ws + WS_SSQ);
    float S[8];
#pragma unroll
    for (int j = 0; j < 8; ++j) S[j] = 0.f;
    float cw[3][4], cb[3]; float a_h = 0.f, dtb = 0.f, dsk = 0.f, nwv = 0.f, lb = 0.f;
    const int grp = head >> 2;
    if (TYPE == 0) {
        const int chs[3] = {head * 64 + lane, 512 + grp * 64 + lane, 640 + grp * 64 + lane};
#pragma unroll
        for (int a = 0; a < 3; ++a) { cb[a] = INP(I_CONVB)[l * 768 + chs[a]];
#pragma unroll
            for (int j = 0; j < 4; ++j) cw[a][j] = INP(I_CONVW)[((size_t)l * 4 + j) * 768 + chs[a]]; }
        a_h = -__expf(INP(I_ALOG)[l * 8 + head]); dtb = INP(I_DTB)[l * 8 + head]; dsk = INP(I_SSDD)[l * 8 + head]; nwv = INP(I_SSDNW)[l * 512 + head * 64 + lane];
    } else {
        if (l == 0) lb = 0.f; else lb = sigmoidf_(INP(I_LBL)[512 + head * 64 + lane] - INP(I_LBL)[head * 64 + lane]);
        nwv = INP(I_HGNW)[l * 64 + lane];
    }
    for (int c = 0; c < SEQ / CH; ++c) {
#pragma unroll
        for (int r = 0; r < 4; ++r) {
            const int i = wave + 8 * r, t = c * CH + i; const size_t row = (size_t)b * SEQ + t;
            if (TYPE == 0) {
                const float dtv = softplusf_(dtraw[row * 8 + head] + dtb);
                float cv[3];
#pragma unroll
                for (int a = 0; a < 3; ++a) { const int ch = (a == 0) ? head * 64 + lane : (a == 1 ? 512 + grp * 64 + lane : 640 + grp * 64 + lane);
                    float s = cb[a];
#pragma unroll
                    for (int j = 0; j < 4; ++j) { const int tt = t - 3 + j; if (tt >= 0) s += cw[a][j] * bf2f(P[((size_t)b * SEQ + tt) * PLD + C_X + ch]); }
                    cv[a] = siluf_(s); }
                Fs[i * 64 + lane] = __expf(dtv * a_h); Ks[i * 64 + lane] = cv[1]; Qs[i * 64 + lane] = cv[2]; Vs[i * 64 + lane] = dtv * cv[0]; Xc[i * 64 + lane] = cv[0];
            } else {
                const bf16_t* pr = P + row * PLD + head * 64 + lane;
                const float f = lb + (1.0f - lb) * sigmoidf_(bf2f(pr[C_FD]));
                Fs[i * 64 + lane] = f; Ks[i * 64 + lane] = 1.0f - f; Qs[i * 64 + lane] = siluf_(bf2f(pr[C_QD])); Vs[i * 64 + lane] = bf2f(pr[C_ID]);
            }
        }
        __syncthreads();
        for (int i = 0; i < CH; ++i) {
            const float v = Vs[i * 64 + lane];
            const f32x4 f0 = *(const LAS f32x4*)(Fs + i * 64 + 8 * wave), f1 = *(const LAS f32x4*)(Fs + i * 64 + 8 * wave + 4);
            const f32x4 k0 = *(const LAS f32x4*)(Ks + i * 64 + 8 * wave), k1 = *(const LAS f32x4*)(Ks + i * 64 + 8 * wave + 4);
            const f32x4 q0 = *(const LAS f32x4*)(Qs + i * 64 + 8 * wave), q1 = *(const LAS f32x4*)(Qs + i * 64 + 8 * wave + 4);
            S[0] = f0.x * S[0] + k0.x * v; S[1] = f0.y * S[1] + k0.y * v; S[2] = f0.z * S[2] + k0.z * v; S[3] = f0.w * S[3] + k0.w * v;
            S[4] = f1.x * S[4] + k1.x * v; S[5] = f1.y * S[5] + k1.y * v; S[6] = f1.z * S[6] + k1.z * v; S[7] = f1.w * S[7] + k1.w * v;
            const float acc = ((q0.x * S[0] + q0.y * S[1]) + (q0.z * S[2] + q0.w * S[3])) + ((q1.x * S[4] + q1.y * S[5]) + (q1.z * S[6] + q1.w * S[7]));
            Yp[(wave * CH + i) * 64 + lane] = acc;
        }
        __syncthreads();
#pragma unroll
        for (int r = 0; r < 4; ++r) {
            const int i = wave + 8 * r, t = c * CH + i; const size_t row = (size_t)b * SEQ + t;
            float y = 0.f;
#pragma unroll
            for (int w = 0; w < 8; ++w) y += Yp[(w * CH + i) * 64 + lane];
            if (TYPE == 0) {
                y += dsk * Xc[i * 64 + lane];
                const float u = y * siluf_(bf2f(P[row * PLD + C_Z + head * 64 + lane]));
                const float ss = wave_sum(u * u);
                if (lane == 0) ssq[row * 8 + head] = ss;
                BR[row * 512 + head * 64 + lane] = (bf16_t)f2bf(u * nwv);
            } else {
                const float ss = wave_sum(y * y);
                const float o = y * rsqrtf(ss * (1.0f / 64.0f) + EPS) * nwv * siluf_(bf2f(P[row * PLD + C_GD + head * 64 + lane]));
                BR[row * 512 + head * 64 + lane] = (bf16_t)f2bf(o);
            }
        }
        __syncthreads();
    }
}

__device__ __forceinline__ void dilated_unit(const Ctx& C, int u) {
    PH_IDS();
        LAS float* ql = (LAS float*)C.lds + wave * 1024;
    LAS float* pl = ql + 128;
    const bf16_t* P = (const bf16_t*)(C.ws + WS_P);
    bf16_t* BR = (bf16_t*)(C.ws + WS_BR) + (size_t)1 * T * 512;
    const float scale = 0.08838834764831845f;
    for (int it = 0; it < 16; ++it) {
        const int tt = u * 32 + wave * 4 + (it >> 2), j = it & 3;
        const int t = tt & (SEQ - 1); const size_t row = (size_t)tt;
        float og[3][2], mg[3], lg[3];
#pragma unroll
        for (int g = 0; g < 3; ++g) {
            const int dil = (g == 0) ? 1 : (g == 1 ? 4 : 16); const int hh = g * 4 + j;
            { const unsigned qq = *(const unsigned*)(P + row * PLD + C_QB + hh * 128 + 2 * lane); ql[2 * lane] = lo2f(qq); ql[2 * lane + 1] = hi2f(qq); }
            asm volatile("s_waitcnt lgkmcnt(0)" ::: "memory");
            float sc[3];
#pragma unroll
            for (int s = 0; s < 2; ++s) {
                const int m = lane + 64 * s; const bool valid = (t - m * dil) >= 0;
                float d = 0.f;
                if (valid) { const bf16_t* kr = P + (row - (size_t)m * dil) * PLD + C_KB + hh * 128;
#pragma unroll 4
                    for (int c8 = 0; c8 < 16; ++c8) { const u32x4 kk = *(const u32x4*)(kr + c8 * 8); const f32x4 qa = *(const LAS f32x4*)(ql + c8 * 8), qb = *(const LAS f32x4*)(ql + c8 * 8 + 4);
                        d += (lo2f(kk.x) * qa.x + hi2f(kk.x) * qa.y) + (lo2f(kk.y) * qa.z + hi2f(kk.y) * qa.w) + (lo2f(kk.z) * qb.x + hi2f(kk.z) * qb.y) + (lo2f(kk.w) * qb.z + hi2f(kk.w) * qb.w); } }
                sc[s] = valid ? d * scale : -3.0e38f;
            }
            {
                const bool valid = (t - 128 * dil) >= 0; float d = 0.f;
                if (valid) { const unsigned kk = *(const unsigned*)(P + (row - (size_t)128 * dil) * PLD + C_KB + hh * 128 + 2 * lane); d = lo2f(kk) * ql[2 * lane] + hi2f(kk) * ql[2 * lane + 1]; d = wave_sum(d); }
                sc[2] = valid ? d * scale : -3.0e38f;
            }
            const float mx = wave_max(fmaxf(fmaxf(sc[0], sc[1]), sc[2]));
            const float p0 = (sc[0] > -1.0e38f) ? __expf(sc[0] - mx) : 0.f, p1 = (sc[1] > -1.0e38f) ? __expf(sc[1] - mx) : 0.f, p2 = (sc[2] > -1.0e38f) ? __expf(sc[2] - mx) : 0.f;
            const float lsum = wave_sum(p0 + p1) + p2;
            pl[g * 192 + lane] = p0; pl[g * 192 + 64 + lane] = p1; if (lane == 0) pl[g * 192 + 128] = p2;
            asm volatile("s_waitcnt lgkmcnt(0)" ::: "memory");
            float o0 = 0.f, o1 = 0.f;
            int nk = t / dil + 1; if (nk > 129) nk = 129;
            const bf16_t* vr = P + row * PLD + C_VB + hh * 128 + 2 * lane;
#pragma unroll 4
            for (int m = 0; m < nk; ++m) { const unsigned vv = *(const unsigned*)(vr - (size_t)m * dil * PLD); const float pv = pl[g * 192 + m]; o0 += pv * lo2f(vv); o1 += pv * hi2f(vv); }
            og[g][0] = o0; og[g][1] = o1; mg[g] = mx; lg[g] = lsum;
            asm volatile("s_waitcnt lgkmcnt(0)" ::: "memory");
        }
        const float l0 = mg[0] + __logf(lg[0]), l1 = mg[1] + __logf(lg[1]), l2 = mg[2] + __logf(lg[2]);
        const float M = fmaxf(fmaxf(l0, l1), l2); const float w0 = __expf(l0 - M), w1 = __expf(l1 - M), w2 = __expf(l2 - M); const float inv = 1.0f / (w0 + w1 + w2);
        const float c0 = w0 * inv / lg[0], c1 = w1 * inv / lg[1], c2 = w2 * inv / lg[2];
        const float r0 = c0 * og[0][0] + c1 * og[1][0] + c2 * og[2][0], r1 = c0 * og[0][1] + c1 * og[1][1] + c2 * og[2][1];
        *(unsigned*)(BR + row * 512 + j * 128 + 2 * lane) = pk2(r0, r1);
    }
}

__device__ __forceinline__ void phase_mix(const Ctx& C, int l) {
    PH_IDS();
#ifndef NO_CHAIN
    if (C.bid < 32) chain_unit<0>(C, l, C.bid >> 3, C.bid & 7);
    else if (C.bid < 64) chain_unit<1>(C, l, (C.bid - 32) >> 3, C.bid & 7);
#endif
    unsigned* wq = (unsigned*)(C.ws + WS_CTL) + CW_WQ + 64 * (2 * l);
    const attn_body::bf16* P = (const attn_body::bf16*)(C.ws + WS_P); attn_body::bf16* O16 = (attn_body::bf16*)(C.ws + WS_H);
#ifndef NO_ATTN
    for (;;) {
        __syncthreads();
        if (tid == 0) MISCW(C)[4] = atomicAdd(wq, 1u);
        __syncthreads();
        const int u = (int)MISCW(C)[4]; if (u >= 1024) break;
        const int qb = 15 - (u >> 6), bh = u & 63, b = bh >> 4, hp = bh & 15, i = hp >> 1, half = hp & 1;
        const size_t r0 = (size_t)b * SEQ;
        attn_body::attn_unit<8, PLD, 1024>(qb, P + r0 * PLD + C_QC + i * 64, P + r0 * PLD + C_KC + i * 64, P + r0 * PLD + C_VC + (i >> 1) * 128 + half * 64, O16 + r0 * 1024 + hp * 64, (char*)C.lds);
    }
#endif
#ifndef NO_DIL
    for (;;) {
        __syncthreads();
        if (tid == 0) MISCW(C)[4] = atomicAdd(wq + 64, 1u);
        __syncthreads();
        const int u = (int)MISCW(C)[4]; if (u >= T / 32) break;
        dilated_unit(C, u);
    }
#endif
}

__device__ __forceinline__ void phase_comb(const Ctx& C, int l) {
    PH_IDS();
    if (tid < 64) {
        const float* dl = INP(I_DLAM) + l * 256;
        const float s1 = wave_sum(dl[lane] * dl[64 + lane]), s2 = wave_sum(dl[128 + lane] * dl[192 + lane]);
        const float lam_init = (l == 0) ? 0.2f : 0.35550907f;
        if (tid == 0) { MISCW(C)[6] = __float_as_uint(expf(s1) - expf(s2) + lam_init); MISCW(C)[7] = __float_as_uint(1.0f - lam_init); }
    }
    __syncthreads();
    const float lam = __uint_as_float(MISCW(C)[6]), oml = __uint_as_float(MISCW(C)[7]);
    const int gw = C.bid * NWAVES + wave, NGW = C.G * NWAVES;
    const bf16_t* O16 = (const bf16_t*)(C.ws + WS_H); bf16_t* BR = (bf16_t*)(C.ws + WS_BR) + (size_t)2 * T * 512;
    const float w0 = INP(I_SUBLN)[l * 128 + lane] * oml, w1 = INP(I_SUBLN)[l * 128 + 64 + lane] * oml;
    for (int row = gw; row < T; row += NGW) {
#pragma unroll
        for (int h = 0; h < 4; ++h) {
            const bf16_t* o = O16 + (size_t)row * 1024 + lane;
            const float a0 = bf2f(o[(4 * h + 0) * 64]), a1 = bf2f(o[(4 * h + 1) * 64]), b0 = bf2f(o[(4 * h + 2) * 64]), b1 = bf2f(o[(4 * h + 3) * 64]);
            const float d0 = a0 - lam * b0, d1 = a1 - lam * b1;
            const float rstd = rsqrtf(wave_sum(d0 * d0 + d1 * d1) * (1.0f / 128.0f) + EPS);
            BR[(size_t)row * 512 + h * 128 + lane] = (bf16_t)f2bf(d0 * rstd * w0); BR[(size_t)row * 512 + h * 128 + 64 + lane] = (bf16_t)f2bf(d1 * rstd * w1);
        }
    }
}

using pg8::Unit; using pg8::HALF; using pg8::BM;
struct EpiMerge {
    static constexpr bool PERM = true, AFTER_DRAIN = false;
    const bf16_t* P; bf16_t* MS; const float* ssq;
    __device__ __forceinline__ void operator()(const pg8::f32x4 (&acc)[2][2][4][2], const Unit& u, int wr, int wc, int fr, int fq) const {
        const int n = u.pn >> 2, pn = u.pn & 3, pm = u.pm & 63;
        const int row0 = pm * BM + wr * 64 + fr, col0 = pn * BM + wc * 32 + 8 * fq;
#pragma unroll
        for (int ai = 0; ai < 2; ++ai)
#pragma unroll
            for (int m = 0; m < 4; ++m) { const int row = row0 + ai * HALF + m * 16;
                float rs = 1.0f;
                if (n == 0) { const pg8::f32x4 q0 = *(const pg8::f32x4*)(ssq + (size_t)row * 8), q1 = *(const pg8::f32x4*)(ssq + (size_t)row * 8 + 4);
                    rs = rsqrtf((((q0[0] + q0[1]) + (q0[2] + q0[3])) + ((q1[0] + q1[1]) + (q1[2] + q1[3]))) * (1.0f / 512.0f) + EPS); }
#pragma unroll
                for (int bj = 0; bj < 2; ++bj) { const int col = col0 + bj * HALF;
                    const u32x4 gl = *(const u32x4*)(P + (size_t)row * PLD + C_GATE + n * 1024 + col);
                    const pg8::f32x4 v0 = acc[ai][bj][m][0], v1 = acc[ai][bj][m][1];
                    float r[8];
                    r[0] = sigmoidf_(lo2f(gl.x)) * rs * v0[0]; r[1] = sigmoidf_(hi2f(gl.x)) * rs * v0[1]; r[2] = sigmoidf_(lo2f(gl.y)) * rs * v0[2]; r[3] = sigmoidf_(hi2f(gl.y)) * rs * v0[3];
                    r[4] = sigmoidf_(lo2f(gl.z)) * rs * v1[0]; r[5] = sigmoidf_(hi2f(gl.z)) * rs * v1[1]; r[6] = sigmoidf_(lo2f(gl.w)) * rs * v1[2]; r[7] = sigmoidf_(hi2f(gl.w)) * rs * v1[3];
                    bf16_t* dst = MS + (size_t)row * DM + col;
                    if (n > 0) { const u32x4 pv = *(const u32x4*)dst;
                        r[0] += lo2f(pv.x); r[1] += hi2f(pv.x); r[2] += lo2f(pv.y); r[3] += hi2f(pv.y); r[4] += lo2f(pv.z); r[5] += hi2f(pv.z); r[6] += lo2f(pv.w); r[7] += hi2f(pv.w); }
                    u32x4 w; w.x = pk2(r[0], r[1]); w.y = pk2(r[2], r[3]); w.z = pk2(r[4], r[5]); w.w = pk2(r[6], r[7]);
                    *(u32x4*)dst = w; } }
    }
};
struct OrderMerge { int G, c;
    __device__ __forceinline__ bool next(int i, Unit& u) const { const int L = (i >> 2) * G + c; if (L >= 256) return false; const int n = i & 3; u.pm = n * 64 + (L >> 2); u.pn = n * 4 + (L & 3); return true; }
    __device__ __forceinline__ void a_ready(const Unit&) const {}
    __device__ __forceinline__ void done(const Unit&) const {}
};
struct EpiWout {
    static constexpr bool PERM = false, AFTER_DRAIN = false;
    const float* xin; float* xout; const float* g1;
    __device__ __forceinline__ void operator()(const pg8::f32x4 (&acc)[2][2][4][2], const Unit& u, int wr, int wc, int fr, int fq) const {
        const int row0 = u.pm * BM + wr * 64 + fr, col0 = u.pn * BM + wc * 32 + 4 * fq;
        const float* g = g1 + (size_t)(row0 >> 12) * 6144;
#pragma unroll
        for (int ai = 0; ai < 2; ++ai)
#pragma unroll
            for (int m = 0; m < 4; ++m) { const size_t off = (size_t)(row0 + ai * HALF + m * 16) * DM + col0;
#pragma unroll
                for (int bj = 0; bj < 2; ++bj)
#pragma unroll
                    for (int n = 0; n < 2; ++n) { const int co = bj * HALF + n * 16; const pg8::f32x4 xv = *(const pg8::f32x4*)(xin + off + co), gv = *(const pg8::f32x4*)(g + col0 + co);
                        *(pg8::f32x4*)(xout + off + co) = xv + gv * acc[ai][bj][m][n]; } }
    }
};
struct EpiMoe1 {
    static constexpr bool PERM = true, AFTER_DRAIN = false;
    bf16_t* HID;
    __device__ __forceinline__ void operator()(const pg8::f32x4 (&acc)[2][2][4][2], const Unit& u, int wr, int wc, int fr, int fq) const {
        const int j = u.pn & 1, row0 = u.pm * BM + wr * 64 + fr, c0 = 128 * j + 16 * wc + 4 * fq;
#pragma unroll
        for (int ai = 0; ai < 2; ++ai)
#pragma unroll
            for (int m = 0; m < 4; ++m) { bf16_t* rp = HID + (size_t)(row0 + ai * HALF + m * 16) * 256 + c0;
#pragma unroll
                for (int bj = 0; bj < 2; ++bj) { const pg8::f32x4 g = acc[ai][bj][m][0], up = acc[ai][bj][m][1];
                    u32x2 w; w.x = pk2(siluf_(g[0]) * up[0], siluf_(g[1]) * up[1]); w.y = pk2(siluf_(g[2]) * up[2], siluf_(g[3]) * up[3]);
                    *(u32x2*)(rp + 64 * bj) = w; } }
    }
};
struct EpiMoe2 {
    static constexpr bool PERM = true, AFTER_DRAIN = false;
    bf16_t* Y;
    __device__ __forceinline__ void operator()(const pg8::f32x4 (&acc)[2][2][4][2], const Unit& u, int wr, int wc, int fr, int fq) const {
        const int j = u.pn & 3, row0 = u.pm * BM + wr * 64 + fr, c0 = 256 * j + 32 * wc + 8 * fq;
#pragma unroll
        for (int ai = 0; ai < 2; ++ai)
#pragma unroll
            for (int m = 0; m < 4; ++m) { const int row = row0 + ai * HALF + m * 16; bf16_t* rp = Y + (size_t)row * DM + c0;
#pragma unroll
                for (int bj = 0; bj < 2; ++bj) { const pg8::f32x4 v0 = acc[ai][bj][m][0], v1 = acc[ai][bj][m][1];
                    u32x4 w; w.x = pk2(v0[0], v0[1]); w.y = pk2(v0[2], v0[3]); w.z = pk2(v1[0], v1[1]); w.w = pk2(v1[2], v1[3]);
                    *(u32x4*)(rp + HALF * bj) = w; } }
    }
};
template <int SH> struct OrderMoe { int G, c, nunits; const LAS unsigned char* blk_e;
    __device__ __forceinline__ bool next(int i, Unit& u) const { const int L = i * G + c; if (L >= nunits) return false; u.pm = L >> SH; u.pn = ((int)blk_e[L >> SH] << SH) + (L & ((1 << SH) - 1)); return true; }
    __device__ __forceinline__ void a_ready(const Unit&) const {}
    __device__ __forceinline__ void done(const Unit&) const {}
};

struct Args { const float* in[25]; float* out; unsigned char* ws; };
__global__ void __launch_bounds__(NTHR, 2) mega_fwd(Args args) {
    extern __shared__ __attribute__((aligned(16))) unsigned char lds_raw[];
    Ctx C;
    C.out = args.out; C.ws = args.ws;
    C.lds = (LAS unsigned char*)lds_raw; C.G = gridDim.x; C.bid = blockIdx.x;
    { const int tid0 = threadIdx.x;
      for (int i = tid0; i < (LDS_BYTES - MISC_OFF) / 4; i += NTHR) MISCW(C)[i] = 0u;
      __syncthreads();
      if (tid0 < 25) { const unsigned long long p = (unsigned long long)args.in[tid0]; LAS unsigned* t = (LAS unsigned*)(C.lds + MISC_OFF + 1024) + 2 * tid0; t[0] = (unsigned)p; t[1] = (unsigned)(p >> 32); }
      __syncthreads(); }
    XcdBarrier bar = xcd_barrier_post((unsigned*)(C.ws + WS_CTL) + CW_BAR, MISCW(C));
    LAS unsigned char* stage = C.lds;
#define WSP(T_, off) ((T_*)(C.ws + (off)))

#ifndef NO_PRO
    pro_mods(C);
    convert_main(C, 0);
#endif
    xcd_barrier(bar);
    for (int l = 0; l < DEPTH; ++l) {
#ifndef NO_N1
        phase_rows<0>(C, l, l > 0);
#endif
        xcd_barrier(bar);
#ifndef NO_G1
        { pg8::Gemm g{WSP(const bf16_t, WS_H), WSP(const bf16_t, WS_WIN), T, PLD, 1024}; pg8::StaticOrder S; S.init(T, PLD, C.G, C.bid);
          pg8::EpiBf16<0> E{WSP(bf16_t, WS_P), PLD, nullptr, 0, 0};
          pg8::gemm_phase<pg8::EpiBf16<0>, pg8::StaticOrder, false>(stage, g, S, E, nullptr); }
#endif
        xcd_barrier(bar);
#ifndef NO_MIX
        phase_mix(C, l);
#endif
        xcd_barrier(bar);
#ifndef NO_COMB
        phase_comb(C, l);
#endif
        xcd_barrier(bar);
#ifndef NO_MERGE
        { pg8::Gemm g{WSP(const bf16_t, WS_BR), WSP(const bf16_t, WS_WMG), 4 * T, 4096, 512}; OrderMerge S{C.G, C.bid};
          EpiMerge E{WSP(const bf16_t, WS_P), WSP(bf16_t, WS_MIXS), WSP(const float, WS_SSQ)};
          pg8::gemm_phase<EpiMerge, OrderMerge, false>(stage, g, S, E, nullptr); }
#endif
        xcd_barrier(bar);
#ifndef NO_WOUT
        { pg8::Gemm g{WSP(const bf16_t, WS_MIXS), WSP(const bf16_t, WS_WOUT), T, 1024, 1024}; pg8::StaticOrder S; S.init(T, 1024, C.G, C.bid);
          EpiWout E{l == 0 ? INP(I_X) : (const float*)C.out, C.out, WSP(const float, WS_MOD) + (size_t)l * 4 * 6144 + 2048};
          pg8::gemm_phase<EpiWout, pg8::StaticOrder, false>(stage, g, S, E, nullptr); }
#endif
        xcd_barrier(bar);
#ifndef NO_N2
        phase_n2(C, l);
        __syncthreads();
        convert_experts(C, l);
        if (l + 1 < DEPTH) convert_main(C, l + 1);
#endif
        xcd_barrier(bar);
#ifndef NO_SCAT
        phase_scatter(C, l);
#endif
        xcd_barrier(bar);
#ifndef NO_MOE1
        { const int nblk = (int)MISCW(C)[5];
          pg8::Gemm g{(const bf16_t*)(C.ws + WS_XS), (const bf16_t*)(C.ws + WS_E1), MAXROWS, 64 * 512, 1024}; OrderMoe<1> S{C.G, C.bid, nblk * 2, C.lds + MISC_OFF + 64};
          EpiMoe1 E{(bf16_t*)(C.ws + WS_HID)};
          pg8::gemm_phase<EpiMoe1, OrderMoe<1>, false>(stage, g, S, E, nullptr); }
#endif
        xcd_barrier(bar);
#ifndef NO_MOE2
        { const int nblk = (int)MISCW(C)[5];
          pg8::Gemm g{(const bf16_t*)(C.ws + WS_HID), (const bf16_t*)(C.ws + WS_E2), MAXROWS, 64 * 1024, 256}; OrderMoe<2> S{C.G, C.bid, nblk * 4, C.lds + MISC_OFF + 64};
          EpiMoe2 E{(bf16_t*)(C.ws + WS_Y)};
          pg8::gemm_phase<EpiMoe2, OrderMoe<2>, false>(stage, g, S, E, nullptr); }
#endif
        xcd_barrier(bar);
    }
#ifndef NO_FIN
    phase_rows<1>(C, DEPTH, true);
#endif
}

extern "C" void kernel_launch(void* const* d_in, const int* in_sizes, int n_in, void* d_out, int out_size, void* d_ws, size_t ws_size, hipStream_t stream) {
    static int grid = 0;
    if (grid == 0) {
        if (n_in != 25 || out_size != T * DM || ws_size < WS_END) { fprintf(stderr, "kernel_launch: unexpected sizes (n_in %d out %d ws %zu need %zu)\n", n_in, out_size, ws_size, (size_t)WS_END); grid = -1; return; }
        int dev = 0, cus = 0, per_cu = 0;
        if (hipGetDevice(&dev) != hipSuccess || hipDeviceGetAttribute(&cus, hipDeviceAttributeMultiprocessorCount, dev) != hipSuccess) { grid = -1; return; }
        if (hipFuncSetAttribute((const void*)mega_fwd, hipFuncAttributeMaxDynamicSharedMemorySize, LDS_BYTES) != hipSuccess) { fprintf(stderr, "kernel_launch: hipFuncSetAttribute failed\n"); grid = -1; return; }
        if (hipOccupancyMaxActiveBlocksPerMultiprocessor(&per_cu, (const void*)mega_fwd, NTHR, LDS_BYTES) != hipSuccess || per_cu < 1) { fprintf(stderr, "kernel_launch: occupancy query says %d\n", per_cu); (void)hipGetLastError(); grid = -1; return; }
        grid = cus;
    }
    if (grid < 0) return;
    if (hipMemsetAsync((char*)d_ws + WS_CTL, 0, CTL_ZERO_BYTES, stream) != hipSuccess) return;
    Args a{};
    for (int i = 0; i < 25; ++i) a.in[i] = (const float*)d_in[i];
    a.out = (float*)d_out; a.ws = (unsigned char*)d_ws;
    hipLaunchKernelGGL(mega_fwd, dim3(grid), dim3(NTHR), LDS_BYTES, stream, a);
}
```

```cpp
#include <hip/hip_runtime.h>
#include <hip/hip_bf16.h>
#include <cstdio>
#include <cstdint>
namespace pg8 {
#define PG8_LAS __attribute__((address_space(3)))
typedef unsigned short bf16_t;
typedef short bf16x8 __attribute__((ext_vector_type(8)));
typedef float f32x4 __attribute__((ext_vector_type(4)));
typedef unsigned u32x4 __attribute__((ext_vector_type(4)));
constexpr int BM = 256, BK = 64, HALF = 128, HTB = HALF * BK * 2  , STAGE_BYTES = 8 * HTB, NXCD = 8, WGM = 8;

__host__ __device__ __forceinline__ int lds_byte(int r, int c) { const int st = (r >> 4) * 2 + (c >> 5), rr = r & 15, cc = c & 31, ob = rr * 64 + cc * 2; return st * 1024 + (ob ^ (((ob >> 9) & 1) << 5)); }
__host__ __device__ __forceinline__ void stage_rc(int b, int& R, int& C) { const int st = b / 1024, sb = b % 1024, swz = sb ^ (((sb >> 9) & 1) << 5); R = (st >> 1) * 16 + swz / 64; C = (st & 1) * 32 + (swz % 64) / 2; }
__host__ __device__ __forceinline__ int perm32(int rho) { const int n = rho >> 4, i = rho & 15; return 8 * (i >> 2) + 4 * n + (i & 3); }

struct Unit { int pm, pn; };
struct Gemm { const bf16_t* A; const bf16_t* Bt; int M, N, K; };

struct StaticOrder {
    int nM, nN, nwg, G, c;
    __host__ __device__ void init(int M, int N, int G_, int c_) { nM = M / BM; nN = N / BM; nwg = nM * nN; G = G_; c = c_; }
    __host__ __device__ bool next(int i, Unit& u) const {
        const long L = (long)i * G + c; if (L >= nwg) return false;
        int wgid = (int)L; { const int q = nwg / NXCD, r = nwg % NXCD, xcd = wgid % NXCD, off = wgid / NXCD; wgid = (xcd < r ? xcd * (q + 1) : r * (q + 1) + (xcd - r) * q) + off; }
        const int nig = WGM * nN, gid = wgid / nig, fm = gid * WGM, gsz = (nM - fm) < WGM ? (nM - fm) : WGM;
        u.pm = fm + ((wgid % nig) % gsz); u.pn = (wgid % nig) / gsz; return true;
    }
    __device__ __forceinline__ void a_ready(const Unit&) const {}
    __device__ __forceinline__ void done(const Unit&) const {}
};
__device__ __forceinline__ unsigned cvt_pk_bf16(float lo, float hi) { unsigned r; asm volatile("v_cvt_pk_bf16_f32 %0, %1, %2" : "=v"(r) : "v"(lo), "v"(hi)); return r; }
template <int ACT  > struct EpiBf16 {
    static constexpr bool PERM = true, AFTER_DRAIN = false;
    bf16_t* O; int ldc; const float* bias; int split_cols; size_t split_stride;
    __device__ __forceinline__ void operator()(const f32x4 (&acc)[2][2][4][2], const Unit& u, int wr, int wc, int fr, int fq) const {
        const int row0 = u.pm * BM + wr * 64 + fr; int colt = u.pn * BM; bf16_t* base = O;
        if (split_cols) { const int t = colt / split_cols; base += (size_t)t * split_stride; colt -= t * split_cols; }
        const int col0 = colt + wc * 32 + 8 * fq, bcol0 = u.pn * BM + wc * 32 + 8 * fq;
        f32x4 bv[2][2];
#pragma unroll
        for (int bj = 0; bj < 2; ++bj)
#pragma unroll
            for (int n = 0; n < 2; ++n) bv[bj][n] = bias ? *(const f32x4*)(bias + bcol0 + bj * HALF + 4 * n) : (f32x4){0.f, 0.f, 0.f, 0.f};
#pragma unroll
        for (int ai = 0; ai < 2; ++ai)
#pragma unroll
            for (int m = 0; m < 4; ++m) { bf16_t* rowp = base + (size_t)(row0 + ai * HALF + m * 16) * ldc + col0;
#pragma unroll
                for (int bj = 0; bj < 2; ++bj) { f32x4 v0 = acc[ai][bj][m][0] + bv[bj][0], v1 = acc[ai][bj][m][1] + bv[bj][1];
                    u32x4 w; w.x = cvt_pk_bf16(v0[0], v0[1]); w.y = cvt_pk_bf16(v0[2], v0[3]); w.z = cvt_pk_bf16(v1[0], v1[1]); w.w = cvt_pk_bf16(v1[2], v1[3]);
                    *(u32x4*)(rowp + bj * HALF) = w; } }
    }
};

template <class Epi, class Sched, bool STAMP = false, bool GATHER = false>
__device__ __forceinline__ void gemm_phase(PG8_LAS unsigned char* lds, const Gemm g, const Sched& S, const Epi& E, unsigned long long* stamps, const PG8_LAS int* rowl = nullptr) {
    int tid_ = threadIdx.x; asm volatile("" : "+v"(tid_));
    const int tid = tid_, wid = __builtin_amdgcn_readfirstlane(tid >> 6), lane = tid & 63, wr = wid >> 2, wc = wid & 3, fr = lane & 15, fq = lane >> 4;
    const int K = g.K, nt = K / BK;
    int ts_lo = 0, ts_hi = 0, nts = 0; const unsigned long long rt_entry = STAMP ? (unsigned long long)wall_clock64() : 0ull;
#define PG8_STAMP() do { if (STAMP && wid == 0 && nts < 64) { const unsigned long long _c = (unsigned long long)clock64(); \
        ts_lo = (lane == nts) ? (int)(unsigned)_c : ts_lo; ts_hi = (lane == nts) ? (int)(unsigned)(_c >> 32) : ts_hi; ++nts; } } while (0)
    PG8_STAMP();
    unsigned voffA[2], voffB[2];
#pragma unroll
    for (int i = 0; i < 2; ++i) { int R, C; stage_rc(tid * 16 + i * 8192, R, C); const int Rb = Epi::PERM ? ((R & ~31) + perm32(R & 31)) : R;
        voffA[i] = (unsigned)(R * K + C) * 2u; voffB[i] = (unsigned)(Rb * K + C) * 2u; }
    unsigned vA0[2], vA1[2], nA0[2], nA1[2];
#define PG8_GOFF(d0, d1, u_) do { _Pragma("unroll") for (int _i = 0; _i < 2; ++_i) { int R_, C_; stage_rc(tid * 16 + _i * 8192, R_, C_);     \
        (d0)[_i] = (unsigned)rowl[256 * (u_) + R_] * (unsigned)(K * 2) + (unsigned)C_ * 2u; (d1)[_i] = (unsigned)rowl[256 * (u_) + 128 + R_] * (unsigned)(K * 2) + (unsigned)C_ * 2u; } } while (0)
    const size_t kstep = (size_t)(BK * 2);
    const size_t hstep = (size_t)HALF * K * 2;
    const size_t tstep = 2 * hstep;
    const unsigned ldsw = (unsigned)wid * 1024u;
    const int aoff = lds_byte(wr * 64 + fr, fq * 8), boff = lds_byte(wc * 32 + fr, fq * 8);
#define PG8_SA(b, h) (((b) * 2 + (h)) * HTB)
#define PG8_SB(b, h) ((4 + (b) * 2 + (h)) * HTB)
#define PG8_STAGE(bufoff, gbase, voff) do { _Pragma("unroll") for (int _i = 0; _i < 2; ++_i) \
        __builtin_amdgcn_global_load_lds((const unsigned*)((const char*)(gbase) + (voff)[_i]), (PG8_LAS unsigned*)(lds + (bufoff) + ldsw + _i * 8192), 16, 0, 0); } while (0)
#define PG8_LDA(dst, b, h) do { _Pragma("unroll") for (int m = 0; m < 4; ++m) _Pragma("unroll") for (int k = 0; k < 2; ++k) dst[m][k] = *(const PG8_LAS bf16x8*)(lds + PG8_SA(b, h) + aoff + m * 2048 + k * 1024); } while (0)
#define PG8_LDB(dst, b, h) do { _Pragma("unroll") for (int n = 0; n < 2; ++n) _Pragma("unroll") for (int k = 0; k < 2; ++k) dst[n][k] = *(const PG8_LAS bf16x8*)(lds + PG8_SB(b, h) + boff + n * 2048 + k * 1024); } while (0)
#define PG8_MMA(ai, bj, At, Bt) do { __builtin_amdgcn_s_setprio(1); _Pragma("unroll") for (int m = 0; m < 4; ++m) _Pragma("unroll") for (int n = 0; n < 2; ++n) _Pragma("unroll") for (int k = 0; k < 2; ++k) \
        acc[ai][bj][m][n] = __builtin_amdgcn_mfma_f32_16x16x32_bf16(Bt[n][k], At[m][k], acc[ai][bj][m][n], 0, 0, 0); __builtin_amdgcn_s_setprio(0); } while (0)
#define PG8_WAIT_V(n) asm volatile("s_waitcnt vmcnt(" #n ")" ::: "memory")
#define PG8_WAIT_L(n) asm volatile("s_waitcnt lgkmcnt(" #n ")" ::: "memory")
#define PG8_BAR __builtin_amdgcn_s_barrier()
#define PG8_SCHED __builtin_amdgcn_sched_barrier(0)
    Unit cur, nxt; int ui = 0;
    if (!S.next(0, cur)) return;
    f32x4 acc[2][2][4][2];
#pragma unroll
    for (int a = 0; a < 2; ++a)
#pragma unroll
        for (int b = 0; b < 2; ++b)
#pragma unroll
            for (int m = 0; m < 4; ++m)
#pragma unroll
                for (int n = 0; n < 2; ++n) acc[a][b][m][n] = (f32x4){0.f, 0.f, 0.f, 0.f};
    bf16x8 At[4][2], B0[2][2], B1[2][2];
    const char* cA = GATHER ? (const char*)g.A : (const char*)g.A + (size_t)cur.pm * tstep; const char* cB = (const char*)g.Bt + (size_t)cur.pn * tstep;
    if constexpr (GATHER) { PG8_GOFF(vA0, vA1, 0); }
    S.a_ready(cur);
    PG8_STAGE(PG8_SB(0, 0), cB, voffB); if constexpr (GATHER) PG8_STAGE(PG8_SA(0, 0), cA, vA0); else PG8_STAGE(PG8_SA(0, 0), cA, voffA); PG8_STAGE(PG8_SB(0, 1), cB + hstep, voffB); if constexpr (GATHER) PG8_STAGE(PG8_SA(0, 1), cA, vA1); else PG8_STAGE(PG8_SA(0, 1), cA + hstep, voffA);
    if (wr == 1) PG8_BAR;
    PG8_WAIT_V(4); PG8_BAR;
    PG8_STAGE(PG8_SB(1, 0), cB + kstep, voffB); if constexpr (GATHER) PG8_STAGE(PG8_SA(1, 0), cA + kstep, vA0); else PG8_STAGE(PG8_SA(1, 0), cA + kstep, voffA); PG8_STAGE(PG8_SB(1, 1), cB + hstep + kstep, voffB);
    PG8_WAIT_V(6); PG8_BAR;
    PG8_STAMP();
    for (;;) {
        const bool has_next = S.next(ui + 1, nxt);
        const char* nA = GATHER ? cA : (has_next ? (const char*)g.A + (size_t)nxt.pm * tstep : cA); const char* nB = has_next ? (const char*)g.Bt + (size_t)nxt.pn * tstep : cB;
        if constexpr (GATHER) { if (has_next) { PG8_GOFF(nA0, nA1, ui + 1); } else { nA0[0] = vA0[0]; nA0[1] = vA0[1]; nA1[0] = vA1[0]; nA1[1] = vA1[1]; } }
#pragma unroll 1
        for (int t = 0; t < nt; t += 2) {
            const bool last = (t == nt - 2);
            const char* a1 = cA + (size_t)(t + 1) * kstep;
            const char* a2 = last ? nA : cA + (size_t)(t + 2) * kstep; const char* b2 = last ? nB : cB + (size_t)(t + 2) * kstep;
            const char* a3 = a2 + kstep; const char* b3 = b2 + kstep;
            if (last && has_next) S.a_ready(nxt);
            unsigned sA0[2], sA1[2];
            if constexpr (GATHER) { sA0[0] = last ? nA0[0] : vA0[0]; sA0[1] = last ? nA0[1] : vA0[1]; sA1[0] = last ? nA1[0] : vA1[0]; sA1[1] = last ? nA1[1] : vA1[1]; }
            PG8_LDB(B0, 0, 0); PG8_SCHED; PG8_LDA(At, 0, 0); if constexpr (GATHER) PG8_STAGE(PG8_SA(1, 1), a1, vA1); else PG8_STAGE(PG8_SA(1, 1), a1 + hstep, voffA);
            PG8_WAIT_L(8); PG8_BAR; PG8_WAIT_L(0); PG8_MMA(0, 0, At, B0); PG8_BAR; PG8_SCHED;
            PG8_LDB(B1, 0, 1); PG8_STAGE(PG8_SB(0, 0), b2, voffB);
            PG8_BAR; PG8_WAIT_L(0); PG8_MMA(0, 1, At, B1); PG8_BAR;
            PG8_LDA(At, 0, 1); if constexpr (GATHER) PG8_STAGE(PG8_SA(0, 0), a2, sA0); else PG8_STAGE(PG8_SA(0, 0), a2, voffA);
            PG8_BAR; PG8_WAIT_L(0); PG8_MMA(1, 0, At, B0); PG8_BAR; PG8_SCHED;
            PG8_STAGE(PG8_SB(0, 1), b2 + hstep, voffB);
            PG8_WAIT_V(6); PG8_BAR; PG8_MMA(1, 1, At, B1); PG8_BAR;
            PG8_LDB(B0, 1, 0); PG8_SCHED; PG8_LDA(At, 1, 0); if constexpr (GATHER) PG8_STAGE(PG8_SA(0, 1), a2, sA1); else PG8_STAGE(PG8_SA(0, 1), a2 + hstep, voffA);
            PG8_WAIT_L(8); PG8_BAR; PG8_WAIT_L(0); PG8_MMA(0, 0, At, B0); PG8_BAR; PG8_SCHED;
            PG8_LDB(B1, 1, 1); PG8_STAGE(PG8_SB(1, 0), b3, voffB);
            PG8_BAR; PG8_WAIT_L(0); PG8_MMA(0, 1, At, B1); PG8_BAR;
            PG8_LDA(At, 1, 1); if constexpr (GATHER) PG8_STAGE(PG8_SA(1, 0), a3, sA0); else PG8_STAGE(PG8_SA(1, 0), a3, voffA);
            PG8_BAR; PG8_WAIT_L(0); PG8_MMA(1, 0, At, B0); PG8_BAR; PG8_SCHED;
            PG8_STAGE(PG8_SB(1, 1), b3 + hstep, voffB);
            PG8_WAIT_V(6); PG8_BAR; PG8_MMA(1, 1, At, B1); PG8_BAR;
        }
        PG8_STAMP();
        if constexpr (!Epi::AFTER_DRAIN) { E(acc, cur, wr, wc, fr, fq); S.done(cur); }
        PG8_STAMP();
        if (!has_next) break;
#pragma unroll
        for (int a = 0; a < 2; ++a)
#pragma unroll
            for (int b = 0; b < 2; ++b)
#pragma unroll
                for (int m = 0; m < 4; ++m)
#pragma unroll
                    for (int n = 0; n < 2; ++n) acc[a][b][m][n] = (f32x4){0.f, 0.f, 0.f, 0.f};
        cur = nxt; cA = nA; cB = nB; ++ui;
        if constexpr (GATHER) { vA0[0] = nA0[0]; vA0[1] = nA0[1]; vA1[0] = nA1[0]; vA1[1] = nA1[1]; }
    }
    PG8_WAIT_V(0);
    if (wr == 0) PG8_BAR;
    PG8_BAR;
    if constexpr (Epi::AFTER_DRAIN) { E.fused(acc, cur, wr, wc, fr, fq, lds, wid, lane); S.done(cur); }
    PG8_STAMP();
    if (STAMP && wid == 0) { stamps[lane] = lane < nts ? (((unsigned long long)(unsigned)ts_hi << 32) | (unsigned)ts_lo) : 0ull;
        if (lane == 62) stamps[62] = rt_entry; if (lane == 63) stamps[63] = (unsigned long long)wall_clock64(); }
#undef PG8_STAMP
#undef PG8_SA
#undef PG8_SB
#undef PG8_STAGE
#undef PG8_GOFF
#undef PG8_LDA
#undef PG8_LDB
#undef PG8_MMA
#undef PG8_WAIT_V
#undef PG8_WAIT_L
#undef PG8_BAR
#undef PG8_SCHED
}
}

namespace attn_body {
using bf16=__hip_bfloat16;
using bf16x8=__attribute__((ext_vector_type(8)))short;
using s16x4=__attribute__((ext_vector_type(4)))short;
using f32x16=__attribute__((ext_vector_type(16)))float;
using u32x4=__attribute__((ext_vector_type(4)))unsigned;
constexpr int D=64;
constexpr int NW=8,QBLK=32,QB=QBLK*NW,KVBLK=64;
__device__ __forceinline__ int crow(int r,int hi){return (r&3)+8*(r>>2)+4*hi;}
#define SBAR() __builtin_amdgcn_sched_barrier(0)
__device__ __forceinline__ void cmask(f32x16&p0,f32x16&p1,int jb,int qrel,int hi){
  const float NEG=-INFINITY; int kb=64*jb+4*hi;
  #pragma unroll
  for(int r=0;r<16;++r){int kv=kb+(r&3)+8*(r>>2); if(kv>qrel)p0[r]=NEG; if(kv+32>qrel)p1[r]=NEG;}
}

constexpr int NSLOT=3, SLOTB=8192;
constexpr int LDS_K=0, LDS_V=NSLOT*SLOTB, LDS_WS=2*NSLOT*SLOTB, LDS_OST=LDS_WS+NW*64*4, LDS_BYTES=LDS_OST+NW*4096;
constexpr float C2=0.125f*1.4426950408889634f;
__device__ __forceinline__ void glds16(const void*gsrc,unsigned lds_dst){unsigned keep;
  asm volatile("s_mov_b32 %0, m0\n\ts_mov_b32 m0, %2\n\ts_nop 0\n\tglobal_load_lds_dwordx4 %1, off\n\ts_mov_b32 m0, %0":"=&s"(keep):"v"(gsrc),"s"(lds_dst):"memory");}
__device__ __forceinline__ float max3f(float a,float b,float c){float r;asm("v_max3_f32 %0, %1, %2, %3":"=v"(r):"v"(a),"v"(b),"v"(c));return r;}
__device__ __forceinline__ float max2f(float a,float b){float r;asm("v_max_f32_e32 %0, %1, %2":"=v"(r):"v"(a),"v"(b));return r;}
__device__ __forceinline__ float fadd_s(float a,float b){float r;asm("v_add_f32_e32 %0, %1, %2":"=v"(r):"v"(a),"v"(b));return r;}
__device__ __forceinline__ float fsub_s(float a,float b){float r;asm("v_sub_f32_e32 %0, %1, %2":"=v"(r):"v"(a),"v"(b));return r;}
typedef float f32x2_t __attribute__((ext_vector_type(2))); typedef __bf16 bf16x2_t __attribute__((ext_vector_type(2)));
__device__ __forceinline__ unsigned cvtpk_s(float lo,float hi){f32x2_t v={lo,hi};bf16x2_t b=__builtin_convertvector(v,bf16x2_t);return __builtin_bit_cast(unsigned,b);}
#define WAIT_BAR(N) asm volatile("s_waitcnt vmcnt(" #N ") lgkmcnt(0)\n\ts_barrier":::"memory")

__device__ __forceinline__ void qkt(f32x16&p0,f32x16&p1,const char*Kslot,const bf16x8*qr,const f32x16&negm,int r32,int hi){
  const char*kb=Kslot+hi*1024+r32*16;
  #pragma unroll
  for(int d0=0;d0<4;++d0){
    const bf16x8 b0=*reinterpret_cast<const bf16x8*>(kb+d0*2048);
    const bf16x8 b1=*reinterpret_cast<const bf16x8*>(kb+d0*2048+512);
    if(d0==0){p0=__builtin_amdgcn_mfma_f32_32x32x16_bf16(b0,qr[0],negm,0,0,0);p1=__builtin_amdgcn_mfma_f32_32x32x16_bf16(b1,qr[0],negm,0,0,0);}
    else{p0=__builtin_amdgcn_mfma_f32_32x32x16_bf16(b0,qr[d0],p0,0,0,0);p1=__builtin_amdgcn_mfma_f32_32x32x16_bf16(b1,qr[d0],p1,0,0,0);}}
}
typedef __attribute__((address_space(3))) const char* lds_cptr;
typedef short v4i16_t __attribute__((ext_vector_type(4)));
__device__ __forceinline__ void kload8(bf16x8*kf,lds_cptr kp){
  kf[0]=*(const __attribute__((address_space(3))) bf16x8*)(kp);      kf[1]=*(const __attribute__((address_space(3))) bf16x8*)(kp+512);
  kf[2]=*(const __attribute__((address_space(3))) bf16x8*)(kp+2048); kf[3]=*(const __attribute__((address_space(3))) bf16x8*)(kp+2560);
  kf[4]=*(const __attribute__((address_space(3))) bf16x8*)(kp+4096); kf[5]=*(const __attribute__((address_space(3))) bf16x8*)(kp+4608);
  kf[6]=*(const __attribute__((address_space(3))) bf16x8*)(kp+6144); kf[7]=*(const __attribute__((address_space(3))) bf16x8*)(kp+6656);
}
__device__ __forceinline__ void kload2(bf16x8*kf,lds_cptr kp,int j){ kf[2*j]=*(const __attribute__((address_space(3))) bf16x8*)(kp+j*2048); kf[2*j+1]=*(const __attribute__((address_space(3))) bf16x8*)(kp+j*2048+512); }
__device__ __forceinline__ s16x4 vtr(lds_cptr p){ return __builtin_bit_cast(s16x4,__builtin_amdgcn_ds_read_tr16_b64_v4i16((__attribute__((address_space(3))) v4i16_t*)p)); }
__device__ __forceinline__ float rowmax(const f32x16&p0,const f32x16&p1){
  float a=max3f(p0[0],p0[1],p1[0]),b=max3f(p0[2],p0[3],p1[1]);a=max3f(a,p1[2],p1[3]);
  #pragma unroll
  for(int r=4;r<16;r+=4){a=max3f(a,p0[r],p0[r+1]);b=max3f(b,p0[r+2],p0[r+3]);a=max3f(a,p1[r],p1[r+1]);b=max3f(b,p1[r+2],p1[r+3]);}
  const float m=max2f(a,b);
  auto rr=__builtin_amdgcn_permlane32_swap(__float_as_uint(m),__float_as_uint(m),false,false);
  return max2f(__uint_as_float(rr[0]),__uint_as_float(rr[1]));
}
__device__ __forceinline__ void pv(f32x16*o,int vb,bf16x8 pa0,bf16x8 pa1,bf16x8 pa2,bf16x8 pa3){
  #pragma unroll
  for(int d0=0;d0<2;++d0){s16x4 lo[4],hi[4];
    #pragma unroll
    for(int ks=0;ks<4;++ks){
      asm volatile("ds_read_b64_tr_b16 %0,%1 offset:%c2":"=&v"(lo[ks]):"v"(vb),"i"(d0*4096+ks*1024):"memory");
      asm volatile("ds_read_b64_tr_b16 %0,%1 offset:%c2":"=&v"(hi[ks]):"v"(vb),"i"(d0*4096+ks*1024+512):"memory");}
    asm volatile("s_waitcnt lgkmcnt(0)":::"memory");SBAR();
    #define PK(k) (bf16x8){lo[k][0],lo[k][1],lo[k][2],lo[k][3],hi[k][0],hi[k][1],hi[k][2],hi[k][3]}
    o[d0]=__builtin_amdgcn_mfma_f32_32x32x16_bf16(pa0,PK(0),o[d0],0,0,0);
    o[d0]=__builtin_amdgcn_mfma_f32_32x32x16_bf16(pa1,PK(1),o[d0],0,0,0);
    o[d0]=__builtin_amdgcn_mfma_f32_32x32x16_bf16(pa2,PK(2),o[d0],0,0,0);
    o[d0]=__builtin_amdgcn_mfma_f32_32x32x16_bf16(pa3,PK(3),o[d0],0,0,0);
    #undef PK
  }
}

#ifndef ATTN_STORE16
#define ATTN_STORE16(p,v) (*(u32x4*)(p)=(v))
#endif
template<int THRL,int PQ,int PO> __device__ __forceinline__ void attn_unit(int qb,const bf16*Qh,const bf16*__restrict__ Kh,const bf16*__restrict__ Vh,bf16*Oh,char*shm){
  int tid_=threadIdx.x; asm volatile("":"+v"(tid_)); const int tid=tid_,lane=tid&63,r32=lane&31,hi=lane>>5; const int wid=__builtin_amdgcn_readfirstlane(tid>>6);
  const int q0=qb*QB;
  const bf16*Qw=Qh+(long)(q0+wid*QBLK)*PQ;
  const unsigned lds0=(unsigned)(uintptr_t)shm;
  float*wsf=(float*)(shm+LDS_WS)+wid*64;
  const bf16*ksrc=Kh+(long)lane*PQ+wid*8;
  const bf16*vsrc=Vh+(long)(16*(wid&3)+(lane>>2))*PQ+(wid>>2)*32+(lane&3)*8;
  const unsigned kdst=lds0+LDS_K+wid*1024, vdst=lds0+LDS_V+wid*1024;
  #define DMA_K(t,slot) glds16(ksrc+(long)(t)*KVBLK*PQ,(unsigned)__builtin_amdgcn_readfirstlane(kdst+(slot)))
  #define DMA_V(t,slot) glds16(vsrc+(long)(t)*KVBLK*PQ,(unsigned)__builtin_amdgcn_readfirstlane(vdst+(slot)))
  const int vb0=(int)(lds0+LDS_V)+((lane>>4)&1)*32+(lane&3)*8+(4*hi+((lane&15)>>2))*64;
  const char*Kbase=shm+LDS_K; bf16x8 kf[8];
  const lds_cptr shm3=(lds_cptr)shm; const lds_cptr kp0=shm3+LDS_K+hi*1024+r32*16; const lds_cptr vp0=shm3+LDS_V+((lane>>4)&1)*32+(lane&3)*8+(4*hi+((lane&15)>>2))*64;
  const int NT=(q0+QB)/KVBLK;
  DMA_K(0,0);DMA_V(0,0);DMA_K(1,SLOTB);
  bf16x8 qr[4];
  #pragma unroll
  for(int d0=0;d0<4;++d0)qr[d0]=*reinterpret_cast<const bf16x8*>(&Qw[(long)r32*PQ+d0*16+hi*8]);
  float mhat=0.f,l_reg=0.f;f32x16 o[2];o[0]=f32x16{};o[1]=f32x16{};f32x16 negm=f32x16{};asm volatile("":"+v"(negm));
  const int qrel=wid*QBLK+r32;
  #define CMASK(P0,P1,t) do{int jb_=(t)-(NT-4); if(jb_>=0)cmask(P0,P1,jb_,qrel,hi);}while(0)
  bool resc=false;
  #define START(P0,P1) do{ const float rm=rowmax(P0,P1); resc=false; \
    { const float dl=rm; mhat=fadd_s(mhat,dl); \
      _Pragma("unroll") for(int r=0;r<16;++r){P0[r]=fsub_s(P0[r],dl);P1[r]=fsub_s(P1[r],dl);} \
      _Pragma("unroll") for(int r=0;r<16;++r)negm[r]=-mhat; asm volatile("":"+v"(negm)); } \
    _Pragma("unroll") for(int r=0;r<16;++r)P0[r]=__builtin_amdgcn_exp2f(P0[r]); }while(0)
  #define RESC() do{ if(resc){ asm volatile("s_waitcnt lgkmcnt(0)":::"memory"); \
      _Pragma("unroll") for(int d_=0;d_<2;++d_) _Pragma("unroll") for(int r=0;r<16;++r)o[d_][r]*=wsf[crow(r,hi)]; } }while(0)
  f32x16 pA0,pA1,pB0,pB1;
  int sl_prev=0,sl_cur=0,sl_next=SLOTB;
  #define ROT() do{sl_prev=sl_cur;sl_cur=sl_next;sl_next=(sl_next==(NSLOT-1)*SLOTB)?0:sl_next+SLOTB;}while(0)
  DMA_K(2,2*SLOTB);
  WAIT_BAR(3);
  qkt(pA0,pA1,Kbase,qr,negm,r32,hi);asm volatile("s_nop 15\n\ts_nop 7":"+v"(pA0),"+v"(pA1));CMASK(pA0,pA1,0);
  START(pA0,pA1);
  _Pragma("unroll") for(int r=0;r<16;++r)pA1[r]=__builtin_amdgcn_exp2f(pA1[r]);
  WAIT_BAR(0);
  DMA_K(3,0);DMA_V(1,SLOTB);
  ROT();
  kload8(kf,kp0+sl_cur);
  WAIT_BAR(2);
  s16x4 vlo[8],vhi[8]; u32x4 pw0,pw1,pw2,pw3;
  #define PKW(P,B) cvtpk_s(P[B],P[B+1])
  #define PAF(k) __builtin_bit_cast(bf16x8,pw##k)
  #define VFR(i) (bf16x8){vlo[i][0],vlo[i][1],vlo[i][2],vlo[i][3],vhi[i][0],vhi[i][1],vhi[i][2],vhi[i][3]}
  #define PIN(x) asm volatile("":"+v"(x))
  #define MX3(a,b,c) __builtin_fmaxf(__builtin_fmaxf((a),(b)),(c))
  #define GAPA(MF,A0,A1,A2,A3,W0,W1,PW) do{ MF; sacc+=A0; sacc+=A1; sacc+=A2; sacc+=A3; PIN(sacc); W0; W1; PIN(PW); SBAR(); }while(0)
  #define EX(v) __builtin_amdgcn_exp2f(v)
  #define GAPB(MF,X,B) do{ MF; X[B]=EX(X[B]); X[B+1]=EX(X[B+1]); X[B+2]=EX(X[B+2]); X[B+3]=EX(X[B+3]); PIN(X); SBAR(); }while(0)
  #define VRD(i) do{ vlo[i]=vtr(vp_+(((i)>>2)*4096+((i)&3)*1024)); vhi[i]=vtr(vp_+(((i)>>2)*4096+((i)&3)*1024+512)); }while(0)
  #define KRD(G,j) do{ if(G){ kload2(kf,kp0+sl_next,j); SBAR(); } }while(0)
  #define STEP(C0,C1,P0,P1,t,GK,GV,GL) do{ SBAR(); \
    const lds_cptr vp_=vp0+sl_prev; \
    VRD(0); SBAR(); float sacc=(P0[0]+P0[1]); \
    GAPA(C0=__builtin_amdgcn_mfma_f32_32x32x16_bf16(kf[0],qr[0],negm,0,0,0), P0[2],P0[3],P0[4],P0[5],     pw0[0]=PKW(P0,0), pw0[1]=PKW(P0,2), pw0); \
    VRD(4); SBAR(); GAPA(C1=__builtin_amdgcn_mfma_f32_32x32x16_bf16(kf[1],qr[0],negm,0,0,0), P0[6],P0[7],P0[8],P0[9],     pw0[2]=PKW(P0,4), pw0[3]=PKW(P0,6), pw0); \
    VRD(1); SBAR(); GAPA(C0=__builtin_amdgcn_mfma_f32_32x32x16_bf16(kf[2],qr[1],C0,0,0,0),   P0[10],P0[11],P0[12],P0[13], pw1[0]=PKW(P0,8), pw1[1]=PKW(P0,10), pw1); \
    VRD(5); SBAR(); GAPA(C1=__builtin_amdgcn_mfma_f32_32x32x16_bf16(kf[3],qr[1],C1,0,0,0),   P0[14],P0[15],P1[0],P1[1],   pw1[2]=PKW(P0,12),pw1[3]=PKW(P0,14), pw1); \
    VRD(2); SBAR(); GAPA(C0=__builtin_amdgcn_mfma_f32_32x32x16_bf16(kf[4],qr[2],C0,0,0,0),   P1[2],P1[3],P1[4],P1[5],     pw2[0]=PKW(P1,0), pw2[1]=PKW(P1,2), pw2); \
    VRD(6); SBAR(); GAPA(C1=__builtin_amdgcn_mfma_f32_32x32x16_bf16(kf[5],qr[2],C1,0,0,0),   P1[6],P1[7],P1[8],P1[9],     pw2[2]=PKW(P1,4), pw2[3]=PKW(P1,6), pw2); \
    VRD(3); SBAR(); GAPA(C0=__builtin_amdgcn_mfma_f32_32x32x16_bf16(kf[6],qr[3],C0,0,0,0),   P1[10],P1[11],P1[12],P1[13], pw3[0]=PKW(P1,8), pw3[1]=PKW(P1,10), pw3); \
    VRD(7); SBAR(); GAPA(C1=__builtin_amdgcn_mfma_f32_32x32x16_bf16(kf[7],qr[3],C1,0,0,0),   P1[14],P1[15],0.f,0.f,       pw3[2]=PKW(P1,12),pw3[3]=PKW(P1,14), pw3); \
    l_reg+=sacc; \
    if(GK){DMA_K((t)+3,sl_cur);} if(GV){DMA_V((t)+1,sl_next);} \
    CMASK(C0,C1,t); \
    { float a=MX3(C0[0],C0[1],C1[0]),b=MX3(C0[2],C0[3],C1[1]); a=MX3(a,C1[2],C1[3]); \
      _Pragma("unroll") for(int r=4;r<16;r+=4){a=MX3(a,C0[r],C0[r+1]);b=MX3(b,C0[r+2],C0[r+3]);a=MX3(a,C1[r],C1[r+1]);b=MX3(b,C1[r+2],C1[r+3]);} \
      float rm=__builtin_fmaxf(a,b); { auto rr=__builtin_amdgcn_permlane32_swap(__float_as_uint(rm),__float_as_uint(rm),false,false); rm=__builtin_fmaxf(__uint_as_float(rr[0]),__uint_as_float(rr[1])); } \
      resc=false; \
      if(__builtin_expect(__any(rm>(float)THRL),0)){ const float dl=__builtin_fmaxf(rm,0.f); mhat+=dl; \
        _Pragma("unroll") for(int r=0;r<16;++r){C0[r]-=dl;C1[r]-=dl;} \
        _Pragma("unroll") for(int r=0;r<16;++r)negm[r]=-mhat; asm volatile("":"+v"(negm)); \
        const float f=__builtin_amdgcn_exp2f(-dl); l_reg*=f; if(hi==0)wsf[r32]=f; resc=true; } } \
    SBAR(); \
    GAPB(o[0]=__builtin_amdgcn_mfma_f32_32x32x16_bf16(PAF(0),VFR(0),o[0],0,0,0), C0,0); \
    GAPB(o[1]=__builtin_amdgcn_mfma_f32_32x32x16_bf16(PAF(0),VFR(4),o[1],0,0,0), C0,4); \
    KRD(GL,0); GAPB(o[0]=__builtin_amdgcn_mfma_f32_32x32x16_bf16(PAF(1),VFR(1),o[0],0,0,0), C0,8); \
    KRD(GL,1); GAPB(o[1]=__builtin_amdgcn_mfma_f32_32x32x16_bf16(PAF(1),VFR(5),o[1],0,0,0), C0,12); \
    KRD(GL,2); GAPB(o[0]=__builtin_amdgcn_mfma_f32_32x32x16_bf16(PAF(2),VFR(2),o[0],0,0,0), C1,0); \
    KRD(GL,3); GAPB(o[1]=__builtin_amdgcn_mfma_f32_32x32x16_bf16(PAF(2),VFR(6),o[1],0,0,0), C1,4); \
    GAPB(o[0]=__builtin_amdgcn_mfma_f32_32x32x16_bf16(PAF(3),VFR(3),o[0],0,0,0), C1,8); \
    GAPB(o[1]=__builtin_amdgcn_mfma_f32_32x32x16_bf16(PAF(3),VFR(7),o[1],0,0,0), C1,12); \
    }while(0)
  int t=1;
  #undef CMASK
  #define CMASK(P0,P1,t) do{}while(0)
  for(;t+5<NT;t+=2){
    STEP(pB0,pB1,pA0,pA1,t,true,true,true);     WAIT_BAR(2); RESC(); ROT();
    STEP(pA0,pA1,pB0,pB1,t+1,true,true,true);   WAIT_BAR(2); RESC(); ROT();
  }
  #undef CMASK
  #define CMASK(P0,P1,t) do{int jb_=(t)-(NT-4); if(jb_>=0)cmask(P0,P1,jb_,qrel,hi);}while(0)
  #define ENDW(tt) do{ if((tt)+3<NT){WAIT_BAR(2);} else if((tt)+2<NT){WAIT_BAR(1);} else {WAIT_BAR(0);} }while(0)
  for(;t+1<NT;t+=2){
    STEP(pB0,pB1,pA0,pA1,t,(t+3<NT),(t+1<NT),(t+1<NT));       ENDW(t);   RESC(); ROT();
    STEP(pA0,pA1,pB0,pB1,t+1,(t+4<NT),(t+2<NT),(t+2<NT));     ENDW(t+1); RESC(); ROT();
  }
  STEP(pB0,pB1,pA0,pA1,NT-1,false,false,false); RESC();
  { float sacc=pB0[0]+pB0[1]; _Pragma("unroll") for(int r=2;r<16;++r)sacc+=pB0[r]; _Pragma("unroll") for(int r=0;r<16;++r)sacc+=pB1[r]; l_reg+=sacc;
    pw0=(u32x4){PKW(pB0,0),PKW(pB0,2),PKW(pB0,4),PKW(pB0,6)};pw1=(u32x4){PKW(pB0,8),PKW(pB0,10),PKW(pB0,12),PKW(pB0,14)};pw2=(u32x4){PKW(pB1,0),PKW(pB1,2),PKW(pB1,4),PKW(pB1,6)};pw3=(u32x4){PKW(pB1,8),PKW(pB1,10),PKW(pB1,12),PKW(pB1,14)};
    SBAR(); pv(o,vb0+sl_cur,PAF(0),PAF(1),PAF(2),PAF(3)); }
  #undef PKW
  #undef PAF
  #undef VFR
  #undef PIN
  #undef MX3
  #undef GAPA
  #undef GAPB
  #undef EX
  #undef VRD
  #undef KRD
  #undef STEP
  #undef ENDW
  {auto rr=__builtin_amdgcn_permlane32_swap(__float_as_uint(l_reg),__float_as_uint(l_reg),false,false);l_reg=__uint_as_float(rr[0])+__uint_as_float(rr[1]);}
  if(hi==0)wsf[32+r32]=l_reg;asm volatile("s_waitcnt lgkmcnt(0)":::"memory");
  float rli[16];
  #pragma unroll
  for(int r=0;r<16;++r)rli[r]=__builtin_amdgcn_rcpf(wsf[32+crow(r,hi)]);
  bf16*Ow=Oh+(long)(q0+wid*QBLK)*PO;
  { bf16*stg=(bf16*)(shm+LDS_OST)+wid*2048;
    #pragma unroll
    for(int r=0;r<16;++r){const int orow=crow(r,hi);
      #pragma unroll
      for(int d0=0;d0<2;++d0)stg[orow*64+d0*32+r32]=__float2bfloat16(o[d0][r]*rli[r]);}
    asm volatile("s_waitcnt lgkmcnt(0)":::"memory");
    #pragma unroll
    for(int i=0;i<4;++i){const int row=i*8+(lane>>3),ch=lane&7; const u32x4 v=*(const u32x4*)(stg+row*64+ch*8); ATTN_STORE16(Ow+(long)row*PO+ch*8,v);} }
  asm volatile("s_waitcnt lgkmcnt(0)\n\ts_barrier":::"memory");
  #undef DMA_K
  #undef DMA_V
  #undef CMASK
  #undef START
  #undef RESC
  #undef ROT
}
constexpr int ATTN_LDS_BYTES=LDS_BYTES;
#undef SBAR
#undef WAIT_BAR
}

#define XB_TMO      128
#define XB_XCNT(j)  (256  + 64 * (j))
#define XB_XSUB(j)  (1280 + 64 * (j))
#define XB_XGEN(j)  (2304 + 64 * (j))
#define XB_TOP      3328
#define XB_TOPGEN   3392
#define XCD_BAR_WORDS 3456
#define XB_SPIN_CAP (1u << 22)
#define LAS __attribute__((address_space(3)))

__device__ __forceinline__ unsigned xb_ld(unsigned* p)              { return __hip_atomic_load(p, __ATOMIC_RELAXED, __HIP_MEMORY_SCOPE_AGENT); }
__device__ __forceinline__ unsigned xb_add(unsigned* p, unsigned v) { return __hip_atomic_fetch_add(p, v, __ATOMIC_RELAXED, __HIP_MEMORY_SCOPE_AGENT); }
__device__ __forceinline__ unsigned xb_xcc_id() { return (unsigned)__builtin_amdgcn_s_getreg((3 << 11) | 20) & 0xFu; }
#define XB_SPIN(cond, bar) do { unsigned _sp = 0; while (cond) { __builtin_amdgcn_s_sleep(1); \
    if ((++_sp & 255u) == 0u) { if (xb_ld(&(bar)[XB_TMO])) break; if (_sp > XB_SPIN_CAP) { atomicAdd(&(bar)[XB_TMO], 1u); break; } } } } while (0)

struct XcdBarrier {
    unsigned* bar; unsigned x;
    volatile LAS unsigned* st;
};

__device__ __forceinline__ XcdBarrier xcd_barrier_post(unsigned* bar, volatile LAS unsigned* st) {
    XcdBarrier b; b.bar = bar; b.x = xb_xcc_id(); b.st = st;
    if (threadIdx.x == 0) (void)xb_add(&bar[XB_XCNT(b.x)], 1u);
    return b;
}
__device__ __forceinline__ void xcd_barrier_complete(unsigned* bar, unsigned x, unsigned& nloc, unsigned& nx) {
    const unsigned G = gridDim.x * gridDim.y * gridDim.z;
    unsigned sum, cnt, mine, sp = 0u;
    for (;;) {
        sum = 0u; cnt = 0u; mine = 0u;
#pragma unroll
        for (unsigned j = 0; j < 16; ++j) { const unsigned c = xb_ld(&bar[XB_XCNT(j)]); sum += c; cnt += (c > 0u) ? 1u : 0u; mine = (j == x) ? c : mine; }
        if (sum == G) break;
        __builtin_amdgcn_s_sleep(1);
        if ((++sp & 255u) == 0u) { if (xb_ld(&bar[XB_TMO])) break; if (sp > XB_SPIN_CAP) { atomicAdd(&bar[XB_TMO], 1u); break; } }
    }
    nloc = mine > 0u ? mine : 1u; nx = cnt > 0u ? cnt : 1u;
}

__device__ __forceinline__ void xcd_barrier(const XcdBarrier& b) {
    asm volatile("s_waitcnt vmcnt(0)" ::: "memory");
    __syncthreads();
    if (threadIdx.x == 0) {
        unsigned* bar = b.bar; unsigned bx = b.x; asm volatile("" : "+s"(bx));
        __builtin_amdgcn_s_waitcnt(0);
        unsigned nloc = b.st[0], nx = b.st[1];
        if (nloc == 0u) { xcd_barrier_complete(bar, bx, nloc, nx); b.st[0] = nloc; b.st[1] = nx; }
        const unsigned old = xb_add(&bar[XB_XSUB(bx)], 1u);
        const unsigned gen = old / nloc;
        if (old + 1u == (gen + 1u) * nloc) {
            __builtin_amdgcn_fence(__ATOMIC_RELEASE, "agent");
            asm volatile("s_waitcnt vmcnt(0)" ::: "memory");
            const unsigned og = xb_add(&bar[XB_TOP], 1u);
            const unsigned tg = og / nx;
            if (og + 1u == (tg + 1u) * nx) xb_add(&bar[XB_TOPGEN], 1u);
            else XB_SPIN(xb_ld(&bar[XB_TOPGEN]) == tg, bar);
            __builtin_amdgcn_fence(__ATOMIC_ACQUIRE, "agent");
            xb_add(&bar[XB_XGEN(bx)], 1u);
            asm volatile("s_waitcnt vmcnt(0)" ::: "memory");
        } else {
            XB_SPIN(xb_ld(&bar[XB_XGEN(bx)]) == gen, bar);
            __builtin_amdgcn_fence(__ATOMIC_ACQUIRE, "agent");
            asm volatile("s_waitcnt vmcnt(0)" ::: "memory");
        }
    }
    __syncthreads();
}


#define LAS __attribute__((address_space(3)))
typedef unsigned short bf16_t;
typedef float f32x4 __attribute__((ext_vector_type(4)));
typedef unsigned u32x4 __attribute__((ext_vector_type(4)));
typedef unsigned u32x2 __attribute__((ext_vector_type(2)));

constexpr int T = 16384, DM = 1024, SEQ = 4096, NB = 4, DEPTH = 2;
constexpr int PLD = 13568;
constexpr int C_Z = 0, C_X = 512, C_QB = 1280, C_KB = 2816, C_VB = 4352, C_QC = 5888, C_KC = 6400, C_VC = 6912,
              C_QD = 7424, C_FD = 7936, C_ID = 8448, C_GD = 8960, C_GATE = 9472;
constexpr int WIN_LD = 13576;
constexpr float EPS = 1e-6f;
constexpr int NWAVES = 8, NTHR = 512;
constexpr int MAXROWS = 49152;

constexpr size_t MiB = 1u << 20, KiB = 1u << 10;
constexpr size_t WS_CTL = 0, CTL_ZERO_BYTES = 1 * MiB;
constexpr int CW_BAR = 4096;
constexpr int CW_WQ = 8192;
constexpr int CW_ECNT = 9216;
constexpr size_t WS_SSQ = 3 * MiB + 256 * KiB;
constexpr size_t WS_MOD = 1 * MiB;
constexpr size_t WS_DT = 1 * MiB + 256 * KiB;
constexpr size_t WS_RE = 2 * MiB, WS_RS = WS_RE + 128 * KiB, WS_RW = WS_RE + 256 * KiB, WS_POS = WS_RE + 384 * KiB;
constexpr size_t WS_ROWTOK = 3 * MiB + 512 * KiB;
constexpr size_t WS_CNT = 3 * MiB + 256 * KiB;
constexpr size_t WS_LSE = WS_RE + 512 * KiB;
constexpr size_t WS_WIN = 4 * MiB;
constexpr size_t WS_WMG = 31 * MiB;
constexpr size_t WS_WOUT = 35 * MiB;
constexpr size_t WS_H = 38 * MiB;
constexpr size_t WS_MIXS = 70 * MiB;
constexpr size_t WS_BR = 102 * MiB;
constexpr size_t WS_P = 166 * MiB;
constexpr size_t WS_E1 = WS_P, WS_E2 = WS_P + 64 * MiB, WS_XS = WS_P + 96 * MiB, WS_HID = WS_P + 192 * MiB, WS_Y = WS_P + 216 * MiB;
constexpr size_t WS_O16 = 590 * MiB;
constexpr size_t WS_END = 622 * MiB;
constexpr size_t WS_CT = WS_H, WS_VT = WS_H + 16 * MiB;
constexpr size_t WS_QG = WS_MIXS, WS_KHT = WS_MIXS + 16 * MiB;
constexpr size_t WS_HL = WS_WIN, WS_DG = WS_WIN + 16 * MiB, WS_DEC = WS_WIN + 17 * MiB;
constexpr int CW_P2 = 9472;
static_assert(WS_Y + (size_t)MAXROWS * 1024 * 2 <= WS_END && WS_P + (size_t)T * PLD * 2 <= WS_END, "ws map");
static_assert(WS_WIN + (size_t)PLD * 1024 * 2 <= WS_WMG, "ws map");

constexpr int SCR_BYTES = 131072, MISC_OFF = SCR_BYTES, LDS_BYTES = 147456;

__device__ __forceinline__ float bf2f(bf16_t v) { return __uint_as_float(((unsigned)v) << 16); }
typedef float pk_f32x2 __attribute__((ext_vector_type(2))); typedef __bf16 pk_bf16x2 __attribute__((ext_vector_type(2)));
__device__ __forceinline__ unsigned pk2(float lo, float hi) { const pk_f32x2 v = {lo, hi}; return __builtin_bit_cast(unsigned, __builtin_convertvector(v, pk_bf16x2)); }
__device__ __forceinline__ unsigned f2bf(float f) { return pk2(f, 0.f) & 0xffffu; }
__device__ __forceinline__ float lo2f(unsigned w) { return __uint_as_float(w << 16); }
__device__ __forceinline__ float hi2f(unsigned w) { return __uint_as_float(w & 0xffff0000u); }
#define wave_sum(v) wave_sum_(v, lane)
#define wave_max(v) wave_max_(v, lane)
__device__ __forceinline__ float wave_sum_(float v, int lane) {
#pragma unroll
    for (int o = 32; o >= 1; o >>= 1) v += __int_as_float(__builtin_amdgcn_ds_bpermute((lane ^ o) << 2, __float_as_int(v)));
    return v; }
__device__ __forceinline__ float wave_max_(float v, int lane) {
#pragma unroll
    for (int o = 32; o >= 1; o >>= 1) v = fmaxf(v, __int_as_float(__builtin_amdgcn_ds_bpermute((lane ^ o) << 2, __float_as_int(v))));
    return v; }
__device__ __forceinline__ float sigmoidf_(float x) { return __builtin_amdgcn_rcpf(1.0f + __expf(-x)); }
__device__ __forceinline__ float siluf_(float x) { return x * __builtin_amdgcn_rcpf(1.0f + __expf(-x)); }
__device__ __forceinline__ float softplusf_(float x) { return x > 20.f ? x : log1pf(__expf(x)); }

struct Ctx {
    float* out; unsigned char* ws;
    LAS unsigned char* lds;
    int G, bid;
};
#define PH_IDS() int tid = threadIdx.x; asm volatile("" : "+v"(tid)); const int lane = tid & 63; const int wave = __builtin_amdgcn_readfirstlane(tid >> 6); (void)lane; (void)wave
__device__ __forceinline__ const float* inp_ptr(const Ctx& C, int k) {
    unsigned ta = MISC_OFF + 1024 + 8 * k; asm volatile("" : "+s"(ta));
    const LAS unsigned* t = (const LAS unsigned*)(LAS unsigned char*)(size_t)0 + 0; t = (const LAS unsigned*)(C.lds + ta);
    const unsigned lo = __builtin_amdgcn_readfirstlane(t[0]), hi = __builtin_amdgcn_readfirstlane(t[1]);
    return (const float*)(((unsigned long long)hi << 32) | lo);
}
#define INP(k) inp_ptr(C, k)
#define MISCW(C) ((volatile LAS unsigned*)((C).lds + MISC_OFF))
enum { I_X = 0, I_C, I_WADA, I_BADA, I_NMIX, I_NFFN, I_WIN, I_CONVW, I_CONVB, I_DTB, I_ALOG, I_SSDD, I_SSDNW, I_DLAM, I_SUBLN, I_LBL, I_HGNW, I_WMG, I_WOUT, I_WR, I_RB, I_EG, I_EU, I_ED, I_FNW };

__device__ __forceinline__ void pro_mods(const Ctx& C) {
    PH_IDS();
    LAS float* cact = (LAS float*)C.lds;
    LAS float* red = cact + 4096;
    for (int i = tid; i < 4096; i += NTHR) cact[i] = siluf_(INP(I_C)[i]);
    __syncthreads();
    float* mod = (float*)(C.ws + WS_MOD);
    for (int u = C.bid; u < 2 * 96; u += C.G) {
        const int l = u / 96, col0 = (u % 96) * 64;
        const float* w = INP(I_WADA) + (size_t)l * 1024 * 6144 + col0 + lane;
        float a0 = 0.f, a1 = 0.f, a2 = 0.f, a3 = 0.f;
        const int kb = wave * 128;
#pragma unroll 32
        for (int kk = 0; kk < 128; ++kk) { const int k = kb + kk; const float wv = w[(size_t)k * 6144];
            a0 += cact[k] * wv; a1 += cact[1024 + k] * wv; a2 += cact[2048 + k] * wv; a3 += cact[3072 + k] * wv; }
        red[(wave * 4 + 0) * 64 + lane] = a0; red[(wave * 4 + 1) * 64 + lane] = a1; red[(wave * 4 + 2) * 64 + lane] = a2; red[(wave * 4 + 3) * 64 + lane] = a3;
        __syncthreads();
        if (tid < 256) { const int b = tid >> 6, cl = tid & 63; float s = 0.f;
#pragma unroll
            for (int wv = 0; wv < 8; ++wv) s += red[(wv * 4 + b) * 64 + cl];
            mod[((size_t)l * 4 + b) * 6144 + col0 + cl] = s + INP(I_BADA)[l * 6144 + col0 + cl]; }
        __syncthreads();
    }
}

template <class Map> __device__ __forceinline__ void transpose_tile(const float* src, int ld, int k0, int n0, bf16_t* dst, int K, const Map& mp, LAS float* scr, int lane) {
    const int nn_l = lane & 31, kh = lane >> 5;
    float tv[32];
    { const float* sp = src + (size_t)(k0 + kh) * ld + mp.scol(n0 + nn_l);
#pragma unroll
      for (int i = 0; i < 32; ++i) tv[i] = sp[(size_t)(2 * i) * ld]; }
#pragma unroll
    for (int i = 0; i < 32; ++i) scr[(2 * i + kh) * 33 + nn_l] = tv[i];
    asm volatile("s_waitcnt vmcnt(0) lgkmcnt(0)" ::: "memory");
    const int kp = lane & 31;
#pragma unroll 4
    for (int j = 0; j < 16; ++j) { const int nn = 2 * j + kh; const float sc = mp.scale(n0 + nn);
        const float v0 = scr[(2 * kp) * 33 + nn] * sc, v1 = scr[(2 * kp + 1) * 33 + nn] * sc;
        *(unsigned*)(dst + (size_t)mp.drow(n0 + nn) * K + k0 + 2 * kp) = pk2(v0, v1); }
    asm volatile("s_waitcnt lgkmcnt(0)" ::: "memory");
}
struct MapWin {
    __device__ __forceinline__ int scol(int n) const { return n < 1280 ? n : n + 8; }
    __device__ __forceinline__ int drow(int n) const { return n; }
    __device__ __forceinline__ float scale(int n) const { return (n >= C_QC && n < C_QC + 512) ? 0.125f * 1.4426950408889634f : 1.0f; }
};
struct MapPlain { int roff;
    __device__ __forceinline__ int scol(int n) const { return n; }
    __device__ __forceinline__ int drow(int n) const { return roff + n; }
    __device__ __forceinline__ float scale(int) const { return 1.0f; }
};
struct MapGU { int roff, up;
    __device__ __forceinline__ int scol(int n) const { return n; }
    __device__ __forceinline__ int drow(int j) const { return roff + (j >> 7) * 256 + ((j & 127) >> 2) * 8 + (j & 3) + 4 * up; }
    __device__ __forceinline__ float scale(int) const { return 1.0f; }
};
__device__ __forceinline__ void convert_main(const Ctx& C, int l) {
    PH_IDS();
    LAS float* scr = (LAS float*)C.lds + wave * (64 * 33);
    const int gw = C.bid * NWAVES + wave, NGW = C.G * NWAVES;
    constexpr int I_A = 16 * (PLD / 32), I_B = 4 * 8 * 32, I_C2 = 16 * 32;
    bf16_t* WIN = (bf16_t*)(C.ws + WS_WIN); bf16_t* WMG = (bf16_t*)(C.ws + WS_WMG); bf16_t* WO = (bf16_t*)(C.ws + WS_WOUT);
    for (int it = gw; it < I_A + I_B + I_C2; it += NGW) {
        int r = it;
        if (r < I_A) { const int kt = r & 15, nt = r >> 4; transpose_tile(INP(I_WIN) + (size_t)l * 1024 * WIN_LD, WIN_LD, kt * 64, nt * 32, WIN, 1024, MapWin{}, scr, lane); continue; }
        r -= I_A;
        if (r < I_B) { const int n = r >> 8, q = r & 255, kt = q & 7, nt = q >> 3;
            transpose_tile(INP(I_WMG) + ((size_t)l * 4 + n) * 512 * 1024, 1024, kt * 64, nt * 32, WMG, 512, MapPlain{n * 1024}, scr, lane); continue; }
        r -= I_B;
        { const int kt = r & 15, nt = r >> 4; transpose_tile(INP(I_WOUT) + (size_t)l * 1024 * 1024, 1024, kt * 64, nt * 32, WO, 1024, MapPlain{0}, scr, lane); }
    }
}
__device__ __forceinline__ void convert_experts(const Ctx& C, int l) {
    PH_IDS();
    LAS float* scr = (LAS float*)C.lds + wave * (64 * 33);
    const int gw = C.bid * NWAVES + wave, NGW = C.G * NWAVES;
    bf16_t* E1 = (bf16_t*)(C.ws + WS_E1); bf16_t* E2 = (bf16_t*)(C.ws + WS_E2);
    for (int it = gw; it < 64 * 384; it += NGW) {
        const int e = it / 384, r = it % 384, m = r >> 7, q = r & 127;
        if (m < 2) { const int kt = q & 15, nt = q >> 4;
            transpose_tile(INP(m == 0 ? I_EG : I_EU) + ((size_t)l * 64 + e) * 1024 * 256, 256, kt * 64, nt * 32, E1, 1024, MapGU{e * 512, m}, scr, lane); }
        else { const int kt = q & 3, nt = q >> 2;
            transpose_tile(INP(I_ED) + ((size_t)l * 64 + e) * 256 * 1024, 1024, kt * 64, nt * 32, E2, 256, MapPlain{e * 1024}, scr, lane); }
    }
}

struct ConvItem { const float* src; bf16_t* dst; int ld, k0, n0, K, kind, roff, up; };
__device__ __forceinline__ bool conv_item(const Ctx& C, int l, int idx, bool with_main, ConvItem& it) {
    if (idx < 64 * 384) { const int e = idx / 384, r = idx % 384, m = r >> 7, q = r & 127;
        if (m < 2) { it.src = INP(m == 0 ? I_EG : I_EU) + ((size_t)l * 64 + e) * 1024 * 256; it.ld = 256; it.k0 = (q & 15) * 64; it.n0 = (q >> 4) * 32; it.dst = (bf16_t*)(C.ws + WS_E1); it.K = 1024; it.kind = 2; it.roff = e * 512; it.up = m; }
        else { it.src = INP(I_ED) + ((size_t)l * 64 + e) * 256 * 1024; it.ld = 1024; it.k0 = (q & 3) * 64; it.n0 = (q >> 2) * 32; it.dst = (bf16_t*)(C.ws + WS_E2); it.K = 256; it.kind = 1; it.roff = e * 1024; it.up = 0; }
        return true; }
    if (!with_main) return false;
    int r = idx - 64 * 384; constexpr int I_A = 16 * (PLD / 32), I_B = 4 * 8 * 32, I_C2 = 16 * 32;
    if (r >= I_A + I_B + I_C2) return false;
    it.up = 0;
    if (r < I_A) { it.src = INP(I_WIN) + (size_t)(l + 1) * 1024 * WIN_LD; it.ld = WIN_LD; it.k0 = (r & 15) * 64; it.n0 = (r >> 4) * 32; it.dst = (bf16_t*)(C.ws + WS_WIN); it.K = 1024; it.kind = 0; it.roff = 0; return true; }
    r -= I_A;
    if (r < I_B) { const int n = r >> 8, q = r & 255; it.src = INP(I_WMG) + ((size_t)(l + 1) * 4 + n) * 512 * 1024; it.ld = 1024; it.k0 = (q & 7) * 64; it.n0 = (q >> 3) * 32; it.dst = (bf16_t*)(C.ws + WS_WMG); it.K = 512; it.kind = 1; it.roff = n * 1024; return true; }
    r -= I_B;
    it.src = INP(I_WOUT) + (size_t)(l + 1) * 1024 * 1024; it.ld = 1024; it.k0 = (r & 15) * 64; it.n0 = (r >> 4) * 32; it.dst = (bf16_t*)(C.ws + WS_WOUT); it.K = 1024; it.kind = 1; it.roff = 0; return true;
}
__device__ __forceinline__ void conv_load(const ConvItem& it, float (&tv)[32], int lane) {
    const int nn = it.n0 + (lane & 31), kh = lane >> 5; const int scol = (it.kind == 0 && nn >= 1280) ? nn + 8 : nn;
    const float* sp = it.src + (size_t)(it.k0 + kh) * it.ld + scol;
#pragma unroll
    for (int i = 0; i < 32; ++i) tv[i] = sp[(size_t)(2 * i) * it.ld];
}
__device__ __forceinline__ void conv_store(const ConvItem& it, const float (&tv)[32], LAS float* scr, int lane) {
    const int nn_l = lane & 31, kh = lane >> 5, kp = lane & 31;
#pragma unroll
    for (int i = 0; i < 32; ++i) scr[(2 * i + kh) * 33 + nn_l] = tv[i];
    asm volatile("s_waitcnt lgkmcnt(0)" ::: "memory");
#pragma unroll 4
    for (int j = 0; j < 16; ++j) { const int n = it.n0 + 2 * j + kh;
        const float sc = (it.kind == 0 && n >= C_QC && n < C_QC + 512) ? 0.125f * 1.4426950408889634f : 1.0f;
        const int drow = (it.kind == 2) ? it.roff + (n >> 7) * 256 + ((n & 127) >> 2) * 8 + (n & 3) + 4 * it.up : it.roff + n;
        const float v0 = scr[(2 * kp) * 33 + 2 * j + kh] * sc, v1 = scr[(2 * kp + 1) * 33 + 2 * j + kh] * sc;
        *(unsigned*)(it.dst + (size_t)drow * it.K + it.k0 + 2 * kp) = pk2(v0, v1); }
    asm volatile("s_waitcnt lgkmcnt(0)" ::: "memory");
}

template <int MODE, bool combine, bool CONV> __device__ __forceinline__ void phase_rows(const Ctx& C, int l) {
    PH_IDS();
    LAS float* wdt = (LAS float*)C.lds;
    if (MODE == 0) {
        const float* w = INP(I_WIN) + (size_t)l * 1024 * WIN_LD + 1280;
        for (int i = tid; i < 8192; i += NTHR) { const int k = i >> 3, j = i & 7; wdt[j * 1024 + k] = w[(size_t)k * WIN_LD + j]; }
        __syncthreads();
    }
    const int gw = C.bid * NWAVES + wave, NGW = C.G * NWAVES;
    const float* mod = (const float*)(C.ws + WS_MOD);
    float* xres = C.out; bf16_t* hb = (bf16_t*)(C.ws + WS_H); float* dtraw = (float*)(C.ws + WS_DT);
    const int* pos = (const int*)(C.ws + WS_POS); const bf16_t* Y = (const bf16_t*)(C.ws + WS_Y);
    const float* rwt = (const float*)(C.ws + WS_RW);
    const float* xsrc = (l == 0 && MODE == 0) ? INP(I_X) : xres;
    constexpr int RB = 2;
    int p0n[RB], p1n[RB]; float rw0n[RB], rw1n[RB];
#define ROWS_LOAD1(R0) do { _Pragma("unroll") for (int q = 0; q < RB; ++q) { \
        if (combine) { p0n[q] = pos[((R0) + q) * 2]; p1n[q] = pos[((R0) + q) * 2 + 1]; rw0n[q] = rwt[((R0) + q) * 2]; rw1n[q] = rwt[((R0) + q) * 2 + 1]; } else { p0n[q] = 0; p1n[q] = 0; rw0n[q] = 0.f; rw1n[q] = 0.f; } } } while (0)
    ROWS_LOAD1(gw * RB);
    constexpr bool cvon = CONV;
    LAS float* cscr = (LAS float*)(C.lds + 32768 + wave * 8448);
    constexpr int CTOT = 16 * (PLD / 32) + 4 * 8 * 32 + 16 * 32;
    int cj = 0;
    for (int r0 = gw * RB; r0 < T; r0 += NGW * RB) {
        const int b = r0 >> 12;
        ConvItem ci; float tvc[32]; bool cvv = false;
        if (cvon) { cvv = (gw + cj * NGW < CTOT) && conv_item(C, -1, 64 * 384 + gw + cj * NGW, true, ci); ++cj; if (cvv) conv_load(ci, tvc, lane); }
        f32x4 v[RB][4]; int p0[RB], p1[RB]; float rw0[RB], rw1[RB];
#pragma unroll
        for (int q = 0; q < RB; ++q) { p0[q] = p0n[q]; p1[q] = p1n[q]; rw0[q] = rw0n[q]; rw1[q] = rw1n[q];
#pragma unroll
            for (int j = 0; j < 4; ++j) v[q][j] = *(const f32x4*)(xsrc + (size_t)(r0 + q) * DM + 4 * lane + 256 * j); }
        { const int rn = (r0 + NGW * RB < T) ? r0 + NGW * RB : r0; ROWS_LOAD1(rn); }
        f32x4 nwv[4], scv[4], shv[4];
        if (MODE == 0) { const float* nw = INP(I_NMIX) + l * DM; const float* sh = mod + ((size_t)l * 4 + b) * 6144; const float* sc = sh + 1024;
#pragma unroll
            for (int j = 0; j < 4; ++j) { const int col = 4 * lane + 256 * j; nwv[j] = *(const f32x4*)(nw + col); scv[j] = *(const f32x4*)(sc + col); shv[j] = *(const f32x4*)(sh + col); } }
        if (combine) {
            const float* g2 = mod + ((size_t)(l - 1) * 4 + b) * 6144 + 5120;
            f32x4 g2v[4];
#pragma unroll
            for (int j = 0; j < 4; ++j) g2v[j] = *(const f32x4*)(g2 + 4 * lane + 256 * j);
            u32x2 ya[RB][4], yb[RB][4];
#pragma unroll
            for (int q = 0; q < RB; ++q)
#pragma unroll
                for (int j = 0; j < 4; ++j) { const int col = 4 * lane + 256 * j; ya[q][j] = *(const u32x2*)(Y + (size_t)p0[q] * DM + col); yb[q][j] = *(const u32x2*)(Y + (size_t)p1[q] * DM + col); }
#pragma unroll
            for (int j = 0; j < 4; ++j) { const int col = 4 * lane + 256 * j; const f32x4 g = g2v[j];
#pragma unroll
                for (int q = 0; q < RB; ++q) {
                    v[q][j].x += g.x * (rw0[q] * lo2f(ya[q][j].x) + rw1[q] * lo2f(yb[q][j].x)); v[q][j].y += g.y * (rw0[q] * hi2f(ya[q][j].x) + rw1[q] * hi2f(yb[q][j].x));
                    v[q][j].z += g.z * (rw0[q] * lo2f(ya[q][j].y) + rw1[q] * lo2f(yb[q][j].y)); v[q][j].w += g.w * (rw0[q] * hi2f(ya[q][j].y) + rw1[q] * hi2f(yb[q][j].y));
                    if (MODE == 0) *(f32x4*)(xres + (size_t)(r0 + q) * DM + col) = v[q][j]; } }
        }
        float rstd[RB];
#pragma unroll
        for (int q = 0; q < RB; ++q) { float ss = 0.f;
#pragma unroll
            for (int j = 0; j < 4; ++j) ss += (v[q][j].x * v[q][j].x + v[q][j].y * v[q][j].y) + (v[q][j].z * v[q][j].z + v[q][j].w * v[q][j].w);
            rstd[q] = rsqrtf(wave_sum(ss) * (1.0f / DM) + EPS); }
        if (MODE == 1) {
#pragma unroll
            for (int j = 0; j < 4; ++j) { const int col = 4 * lane + 256 * j; const f32x4 w = *(const f32x4*)(INP(I_FNW) + col);
#pragma unroll
                for (int q = 0; q < RB; ++q) *(f32x4*)(C.out + (size_t)(r0 + q) * DM + col) = v[q][j] * rstd[q] * w; }
        } else {
            float da[RB][8];
#pragma unroll
            for (int q = 0; q < RB; ++q)
#pragma unroll
                for (int i = 0; i < 8; ++i) da[q][i] = 0.f;
#pragma unroll
            for (int j = 0; j < 4; ++j) { const int col = 4 * lane + 256 * j;
                const f32x4 w = nwv[j], s1 = scv[j], s0 = shv[j];
                f32x4 hv[RB];
#pragma unroll
                for (int q = 0; q < RB; ++q) { hv[q] = v[q][j] * rstd[q] * w * (s1 + 1.0f) + s0;
                    u32x2 o; o.x = pk2(hv[q].x, hv[q].y); o.y = pk2(hv[q].z, hv[q].w);
                    *(u32x2*)(hb + (size_t)(r0 + q) * DM + col) = o; }
#pragma unroll
                for (int i = 0; i < 8; ++i) { const f32x4 wd = *(const LAS f32x4*)(wdt + i * 1024 + col);
#pragma unroll
                    for (int q = 0; q < RB; ++q) da[q][i] += (hv[q].x * wd.x + hv[q].y * wd.y) + (hv[q].z * wd.z + hv[q].w * wd.w); } }
#pragma unroll
            for (int q = 0; q < RB; ++q) {
#pragma unroll
                for (int i = 0; i < 8; ++i) da[q][i] = wave_sum(da[q][i]);
                if (lane == 0) { *(f32x4*)(dtraw + (size_t)(r0 + q) * 8) = (f32x4){da[q][0], da[q][1], da[q][2], da[q][3]}; *(f32x4*)(dtraw + (size_t)(r0 + q) * 8 + 4) = (f32x4){da[q][4], da[q][5], da[q][6], da[q][7]}; } }
        }
        if (cvv) conv_store(ci, tvc, cscr, lane);
    }
    if (cvon) for (; gw + cj * NGW < CTOT; ++cj) { ConvItem c2; float t2[32]; if (conv_item(C, -1, 64 * 384 + gw + cj * NGW, true, c2)) { conv_load(c2, t2, lane); conv_store(c2, t2, cscr, lane); } }
}

typedef float n2_f32x16 __attribute__((ext_vector_type(16)));
__device__ __forceinline__ void phase_n2(const Ctx& C, int l, bool with_main) {
    PH_IDS();
    constexpr int HP = 129;
    LAS float* hsl = (LAS float*)C.lds;
    LAS float* wsl = hsl + 8320;
    LAS float* Pl = hsl;
    LAS float* cscr = (wave < 7) ? (LAS float*)(C.lds + 66048 + wave * 8448) : (LAS float*)(C.lds + MISC_OFF + 4096);
    const int cgw = C.bid * NWAVES + wave, CNGW = C.G * NWAVES;
    const int ctotal = 64 * 384 + (with_main ? (16 * (PLD / 32) + 4 * 8 * 32 + 16 * 32) : 0);
    int cj = 0;
    const float* mod = (const float*)(C.ws + WS_MOD);
    const float* xres = C.out; bf16_t* hb = (bf16_t*)(C.ws + WS_H);
    int* r_e = (int*)(C.ws + WS_RE); int* r_s = (int*)(C.ws + WS_RS); float* r_w = (float*)(C.ws + WS_RW);
    const float* wr = INP(I_WR); const float rbias = INP(I_RB)[lane];
    const float* nw = INP(I_NFFN) + l * DM;
    const int n32 = lane & 31, hi = lane >> 5, et = wave & 1, rt = (wave >> 1) & 1, kh = wave >> 2;
    for (int rb = C.bid; rb < T / 64; rb += C.G) {
        const int rbase = rb * 64 + wave * 8, b = (rb * 64) >> 12;
        const float* sh = mod + ((size_t)l * 4 + b) * 6144 + 3072; const float* sc = sh + 1024;
        float rstd[8];
#pragma unroll
        for (int r = 0; r < 8; ++r) { float ss = 0.f;
#pragma unroll
            for (int jj = 0; jj < 4; ++jj) { const f32x4 v = *(const f32x4*)(xres + (size_t)(rbase + r) * DM + 4 * lane + 256 * jj); ss += (v.x * v.x + v.y * v.y) + (v.z * v.z + v.w * v.w); }
            rstd[r] = rsqrtf(wave_sum(ss) * (1.0f / DM) + EPS); }
        const int sr = lane >> 3, c16 = lane & 7;
        float myrs = rstd[0];
#pragma unroll
        for (int r = 1; r < 8; ++r) myrs = (sr == r) ? rstd[r] : myrs;
        n2_f32x16 acc;
#pragma unroll
        for (int r = 0; r < 16; ++r) acc[r] = 0.f;
        f32x4 xv[4], nwv[4], scv[4], shv[4], wv4[4];
#define N2_LOAD(S8) do { const int col0_ = 128 * (S8) + 16 * c16; const size_t row_ = (size_t)(rbase + sr); \
            _Pragma("unroll") for (int q = 0; q < 4; ++q) { xv[q] = *(const f32x4*)(xres + row_ * DM + col0_ + 4 * q); nwv[q] = *(const f32x4*)(nw + col0_ + 4 * q); scv[q] = *(const f32x4*)(sc + col0_ + 4 * q); shv[q] = *(const f32x4*)(sh + col0_ + 4 * q); \
                wv4[q] = *(const f32x4*)(wr + (size_t)128 * 64 * (S8) + 4 * (tid + 512 * q)); } } while (0)
        N2_LOAD(0);
        for (int s8 = 0; s8 < 8; ++s8) {
            __syncthreads();
            { const int col0 = 128 * s8 + 16 * c16; const size_t row = (size_t)(rbase + sr);
#pragma unroll
              for (int q = 0; q < 4; ++q) { const int col = col0 + 4 * q;
                  const f32x4 hv = xv[q] * myrs * nwv[q] * (scv[q] + 1.0f) + shv[q];
                  u32x2 o; o.x = pk2(hv.x, hv.y); o.y = pk2(hv.z, hv.w);
                  *(u32x2*)(hb + row * DM + col) = o;
                  LAS float* hp = hsl + (8 * wave + sr) * HP + 16 * c16 + 4 * q; hp[0] = hv.x; hp[1] = hv.y; hp[2] = hv.z; hp[3] = hv.w; } }
#pragma unroll
            for (int i = 0; i < 4; ++i) *(LAS f32x4*)(wsl + 4 * (tid + 512 * i)) = wv4[i];
            if (s8 + 1 < 8) N2_LOAD(s8 + 1);
            ConvItem ci0; float tv0[32];
            const bool cv0 = (cgw + cj * CNGW < ctotal) && conv_item(C, l, cgw + cj * CNGW, with_main, ci0); ++cj;
            if (cv0) conv_load(ci0, tv0, lane);
            __syncthreads();
            const LAS float* ap = wsl + (64 * kh + hi) * 64 + 32 * et + n32; const LAS float* bp = hsl + (32 * rt + n32) * HP + 64 * kh + hi;
#pragma unroll 8
            for (int ks = 0; ks < 32; ++ks) acc = __builtin_amdgcn_mfma_f32_32x32x2f32(ap[ks * 128], bp[ks * 2], acc, 0, 0, 0);
            if (cv0) conv_store(ci0, tv0, cscr, lane);
        }
#undef N2_LOAD
        __syncthreads();
#pragma unroll
        for (int r = 0; r < 16; ++r) Pl[(kh * 64 + 32 * rt + n32) * 64 + 32 * et + (r & 3) + 8 * (r >> 2) + 4 * hi] = acc[r];
        __syncthreads();
        LAS float* sw = wsl + wave * 1024; LAS int* pick = (LAS int*)(hsl + 8192);
#pragma unroll
        for (int r = 0; r < 8; ++r) { const float lg = Pl[(8 * wave + r) * 64 + lane] + Pl[(64 + 8 * wave + r) * 64 + lane]; const float sg = sigmoidf_(lg); sw[r * 64 + lane] = sg + rbias; sw[512 + r * 64 + lane] = sg; }
        asm volatile("s_waitcnt lgkmcnt(0)" ::: "memory");
        if (lane < 8) {
            const LAS float* sel = sw + lane * 64; const LAS float* sco = sw + 512 + lane * 64;
            int best = 0; float bestv = -3.0e38f;
            for (int g = 0; g < 8; ++g) { float m1 = -3.0e38f, m2 = -3.0e38f;
                for (int i = 0; i < 8; ++i) { const float x = sel[g * 8 + i]; if (x > m1) { m2 = m1; m1 = x; } else if (x > m2) m2 = x; }
                const float gs = m1 + m2; if (gs > bestv) { bestv = gs; best = g; } }
            int i0 = 0; float v0 = -3.0e38f;
            for (int i = 0; i < 8; ++i) { const float x = sel[best * 8 + i]; if (x > v0) { v0 = x; i0 = i; } }
            int i1 = 0; float v1 = -3.0e38f;
            for (int i = 0; i < 8; ++i) { if (i == i0) continue; const float x = sel[best * 8 + i]; if (x > v1) { v1 = x; i1 = i; } }
            const int e0 = best * 8 + i0, e1 = best * 8 + i1; const float s0 = sco[e0], s1 = sco[e1], inv = 1.0f / (s0 + s1);
            const int row = rbase + lane;
            r_e[row * 2] = e0; r_e[row * 2 + 1] = e1; r_w[row * 2] = s0 * inv; r_w[row * 2 + 1] = s1 * inv;
            pick[(wave * 8 + lane) * 2] = e0; pick[(wave * 8 + lane) * 2 + 1] = e1;
        }
        __syncthreads();
        if (tid < 64) { int cnt = 0;
            for (int i = 0; i < 128; ++i) if (pick[i] == tid) { r_s[rb * 128 + i] = cnt; ++cnt; }
            ((int*)(C.ws + WS_CNT))[rb * 64 + tid] = cnt; }
    }
    { ConvItem ca; float ta[32]; bool va = (cgw + cj * CNGW < ctotal) && conv_item(C, l, cgw + cj * CNGW, with_main, ca); if (va) conv_load(ca, ta, lane);
      while (va) { ++cj;
          ConvItem cb; float tb[32]; const bool vb = (cgw + cj * CNGW < ctotal) && conv_item(C, l, cgw + cj * CNGW, with_main, cb); if (vb) conv_load(cb, tb, lane);
          conv_store(ca, ta, cscr, lane);
          ca = cb; va = vb;
#pragma unroll
          for (int i = 0; i < 32; ++i) ta[i] = tb[i]; } }
}

__device__ __forceinline__ void phase_scatter(const Ctx& C, int l) {
    PH_IDS();
    LAS unsigned char* blk_e = C.lds + MISC_OFF + 64; LAS int* blk0 = (LAS int*)(C.lds + MISC_OFF + 512);
    LAS int* basel = (LAS int*)C.lds; LAS int* totl = basel + 64; LAS int* parts = basel + 128;
    const int* CNT = (const int*)(C.ws + WS_CNT);
    const int* r_e = (const int*)(C.ws + WS_RE); const int* r_s = (const int*)(C.ws + WS_RS);
    int* pos = (int*)(C.ws + WS_POS); int* ROWTOK = (int*)(C.ws + WS_ROWTOK);
    bool first = true;
    for (int rb = C.bid; rb < T / 64 || first; rb += C.G) {
        __syncthreads();
        { const int e = tid & 63, part = tid >> 6; int base = 0, tot = 0; int cv[32];
#pragma unroll
          for (int w = 0; w < 32; ++w) cv[w] = CNT[(part * 32 + w) * 64 + e];
#pragma unroll
          for (int w = 0; w < 32; ++w) { base += (part * 32 + w < rb) ? cv[w] : 0; tot += cv[w]; }
          parts[part * 64 + e] = base; parts[512 + part * 64 + e] = tot; }
        __syncthreads();
        if (tid < 64) { int base = 0, tot = 0;
#pragma unroll
            for (int p = 0; p < 8; ++p) { base += parts[p * 64 + tid]; tot += parts[512 + p * 64 + tid]; }
            basel[tid] = base; totl[tid] = tot; }
        __syncthreads();
        if (first && tid == 0) { int nb = 0;
            for (int e = 0; e < 64; ++e) { const int k = (totl[e] + 255) >> 8; blk0[e] = nb;
                for (int i = 0; i < k && nb + i < 192; ++i) blk_e[nb + i] = (unsigned char)e; nb += k; }
            blk0[64] = nb; MISCW(C)[5] = (unsigned)(nb > 192 ? 192 : nb);
            LAS int* m1 = (LAS int*)(C.lds + MISC_OFF + 2048); LAS int* m2 = m1 + 64;
            const int x8 = C.bid & 7, y = C.bid >> 3, ny = (C.G + 7 - x8) >> 3;
            int n1 = 0, n2 = 0, c1 = 0, c2 = 0;
            for (int e = x8; e < 64; e += 8) for (int pb = blk0[e]; pb < blk0[e + 1] && pb < 192; ++pb) {
                for (int jj = 0; jj < 2; ++jj) { if (n1 % ny == y && c1 < 12) m1[1 + c1++] = (pb << 8) | (2 * e + jj); ++n1; }
                for (int jj = 0; jj < 4; ++jj) { if (n2 % ny == y && c2 < 62) m2[1 + c2++] = (pb << 8) | (4 * e + jj); ++n2; } }
            m1[0] = c1; m2[0] = c2; }
        __syncthreads();
        if (first && C.bid < 64 && tid < 256) { const int e = C.bid; const int r = blk0[e] * 256 + totl[e] + tid; if (r < blk0[e + 1] * 256 && r < MAXROWS) ROWTOK[r] = 0; }
        first = false;
        if (rb < T / 64) {
            if (lane < 16) { const int it = rb * 128 + wave * 16 + lane; const int e = r_e[it]; const int row = blk0[e] * 256 + basel[e] + r_s[it];
                pos[it] = row; ROWTOK[row] = it >> 1; }
        }
    }
}

typedef short ch_bf16x8 __attribute__((ext_vector_type(8)));
typedef short ch_s16x4 __attribute__((ext_vector_type(4)));
constexpr int IMG_P = 144;
__device__ __forceinline__ int kperm(int k) { const int kt = k >> 4; return 32 * (kt >> 1) + 8 * ((k >> 2) & 3) + 4 * (kt & 1) + (k & 3); }
__device__ __forceinline__ ch_bf16x8 tr_pair(const LAS unsigned char* a0, const LAS unsigned char* a1) {
    const ch_s16x4 lo = __builtin_bit_cast(ch_s16x4, __builtin_amdgcn_ds_read_tr16_b64_v4i16((LAS ch_s16x4*)a0));
    const ch_s16x4 hi = __builtin_bit_cast(ch_s16x4, __builtin_amdgcn_ds_read_tr16_b64_v4i16((LAS ch_s16x4*)a1));
    return (ch_bf16x8){lo[0], lo[1], lo[2], lo[3], hi[0], hi[1], hi[2], hi[3]};
}
__device__ __forceinline__ ch_bf16x8 pack8(const pg8::f32x4& a, const pg8::f32x4& b) { u32x4 w; w.x = pk2(a[0], a[1]); w.y = pk2(a[2], a[3]); w.z = pk2(b[0], b[1]); w.w = pk2(b[2], b[3]); return __builtin_bit_cast(ch_bf16x8, w); }

__device__ __forceinline__ void ssd_pass1(const Ctx& C, int l, int unit) {
    PH_IDS();
    const int c = unit & 31, head = (unit >> 5) & 7, b = unit >> 8, grp = head >> 2;
    const size_t row0 = (size_t)b * SEQ + (size_t)c * 128;
    LAS unsigned char* XD = C.lds; LAS unsigned char* BW = XD + 128 * IMG_P; LAS unsigned char* BB = BW + 128 * IMG_P; LAS unsigned char* CC = BB + 128 * IMG_P;
    LAS float* acs = (LAS float*)(CC + 128 * IMG_P); LAS float* dtv = acs + 128;
    const bf16_t* P = (const bf16_t*)(C.ws + WS_P);
    const float a_h = -__expf(INP(I_ALOG)[l * 8 + head]);
    if (wave < 2) {
        const float* dtraw = (const float*)(C.ws + WS_DT); const float dtb = INP(I_DTB)[l * 8 + head];
        const float d0 = softplusf_(dtraw[(row0 + lane) * 8 + head] + dtb);
        float dmine = d0, pre = 0.f;
        if (wave == 1) { dmine = softplusf_(dtraw[(row0 + 64 + lane) * 8 + head] + dtb); pre = wave_sum(d0 * a_h); }
        float sc = dmine * a_h;
#pragma unroll
        for (int o = 1; o < 64; o <<= 1) { const float t = __int_as_float(__builtin_amdgcn_ds_bpermute((lane - o) << 2, __float_as_int(sc))); if (lane >= o) sc += t; }
        acs[wave * 64 + lane] = sc + pre; dtv[wave * 64 + lane] = dmine;
    }
    const int cg = tid % 24, rb = tid / 24;
    const int ch0 = (cg < 8) ? head * 64 + 8 * cg : (cg < 16 ? 512 + grp * 64 + 8 * (cg - 8) : 640 + grp * 64 + 8 * (cg - 16));
    u32x4 raw[11];
    if (tid < 384) {
#pragma unroll
        for (int j = 0; j < 11; ++j) { const int t = c * 128 + 8 * rb - 3 + j;
            raw[j] = (t >= 0) ? *(const u32x4*)(P + ((size_t)b * SEQ + t) * PLD + C_X + ch0) : (u32x4){0u, 0u, 0u, 0u}; }
    }
    float wj[4][8], bs[8];
    if (tid < 384) {
        { const float* cw = INP(I_CONVW) + (size_t)l * 4 * 768 + ch0; const float* cb = INP(I_CONVB) + l * 768 + ch0;
#pragma unroll
          for (int j = 0; j < 4; ++j) { const f32x4 a = *(const f32x4*)(cw + j * 768), bq = *(const f32x4*)(cw + j * 768 + 4); wj[j][0] = a.x; wj[j][1] = a.y; wj[j][2] = a.z; wj[j][3] = a.w; wj[j][4] = bq.x; wj[j][5] = bq.y; wj[j][6] = bq.z; wj[j][7] = bq.w; }
          const f32x4 a = *(const f32x4*)cb, bq = *(const f32x4*)(cb + 4); bs[0] = a.x; bs[1] = a.y; bs[2] = a.z; bs[3] = a.w; bs[4] = bq.x; bs[5] = bq.y; bs[6] = bq.z; bs[7] = bq.w; }
    }
    __syncthreads();
    if (tid < 384) {
        const float acl = acs[127];
        bf16_t* CT = (bf16_t*)(C.ws + WS_CT);
#pragma unroll
        for (int r = 0; r < 8; ++r) {
            const int lr = 8 * rb + r;
            float v[8];
#pragma unroll
            for (int e = 0; e < 8; ++e) v[e] = bs[e];
#pragma unroll
            for (int j = 0; j < 4; ++j) { const u32x4 q = raw[r + j];
                v[0] += wj[j][0] * lo2f(q.x); v[1] += wj[j][1] * hi2f(q.x); v[2] += wj[j][2] * lo2f(q.y); v[3] += wj[j][3] * hi2f(q.y);
                v[4] += wj[j][4] * lo2f(q.z); v[5] += wj[j][5] * hi2f(q.z); v[6] += wj[j][6] * lo2f(q.w); v[7] += wj[j][7] * hi2f(q.w); }
#pragma unroll
            for (int e = 0; e < 8; ++e) v[e] = siluf_(v[e]);
            if (cg < 8) { const float d = dtv[lr];
                u32x4 w; w.x = pk2(v[0] * d, v[1] * d); w.y = pk2(v[2] * d, v[3] * d); w.z = pk2(v[4] * d, v[5] * d); w.w = pk2(v[6] * d, v[7] * d);
                *(LAS u32x4*)(XD + lr * IMG_P + 16 * cg) = w;
            } else if (cg < 16) { const float wd = __expf(acl - acs[lr]);
                u32x4 w; w.x = pk2(v[0], v[1]); w.y = pk2(v[2], v[3]); w.z = pk2(v[4], v[5]); w.w = pk2(v[6], v[7]);
                *(LAS u32x4*)(BB + lr * IMG_P + 16 * (cg - 8)) = w;
                w.x = pk2(v[0] * wd, v[1] * wd); w.y = pk2(v[2] * wd, v[3] * wd); w.z = pk2(v[4] * wd, v[5] * wd); w.w = pk2(v[6] * wd, v[7] * wd);
                *(LAS u32x4*)(BW + lr * IMG_P + 16 * (cg - 8)) = w;
            } else { const float ea = __expf(acs[lr]); const int n0 = 8 * (cg - 16);
                u32x4 w; w.x = pk2(v[0], v[1]); w.y = pk2(v[2], v[3]); w.z = pk2(v[4], v[5]); w.w = pk2(v[6], v[7]);
                *(LAS u32x4*)(CC + lr * IMG_P + 16 * (cg - 16)) = w;
                bf16_t* cp = CT + (row0 + lr) * 512 + head * 64;
                u32x2 wa; wa.x = pk2(v[0] * ea, v[1] * ea); wa.y = pk2(v[2] * ea, v[3] * ea); *(u32x2*)(cp + kperm(n0)) = wa;
                u32x2 wb; wb.x = pk2(v[4] * ea, v[5] * ea); wb.y = pk2(v[6] * ea, v[7] * ea); *(u32x2*)(cp + kperm(n0 + 4)) = wb;
            }
        }
    }
    __syncthreads();
    const int n16 = lane & 15, kq = lane >> 4, q4 = n16 >> 2, p4 = lane & 3;
    const float dsk = INP(I_SSDD)[l * 8 + head];
    ch_bf16x8 cf[2];
#pragma unroll
    for (int ks = 0; ks < 2; ++ks) cf[ks] = *(const LAS ch_bf16x8*)(CC + (16 * wave + n16) * IMG_P + 64 * ks + 16 * kq);
    const float acl_l = acs[16 * wave + n16];
    const float dskd = dsk / dtv[16 * wave + n16];
    ch_bf16x8 pa[4];
#pragma unroll
    for (int kp = 0; kp < 4; ++kp) {
        pg8::f32x4 g2[2];
#pragma unroll
        for (int h2 = 0; h2 < 2; ++h2) {
            const int ts = 2 * kp + h2;
            pg8::f32x4 a = {0.f, 0.f, 0.f, 0.f};
            if (ts <= wave) {
#pragma unroll
                for (int ks = 0; ks < 2; ++ks) { const ch_bf16x8 bf = *(const LAS ch_bf16x8*)(BB + (16 * ts + n16) * IMG_P + 64 * ks + 16 * kq); a = __builtin_amdgcn_mfma_f32_16x16x32_bf16(bf, cf[ks], a, 0, 0, 0); }
                const f32x4 as4 = *(const LAS f32x4*)(acs + 16 * ts + 4 * kq);
                const int ll = 16 * wave + n16, s0 = 16 * ts + 4 * kq;
                a[0] = (s0 + 0 <= ll) ? a[0] * __expf(acl_l - as4.x) : 0.f; a[1] = (s0 + 1 <= ll) ? a[1] * __expf(acl_l - as4.y) : 0.f;
                a[2] = (s0 + 2 <= ll) ? a[2] * __expf(acl_l - as4.z) : 0.f; a[3] = (s0 + 3 <= ll) ? a[3] * __expf(acl_l - as4.w) : 0.f;
                if (s0 + 0 == ll) a[0] += dskd; if (s0 + 1 == ll) a[1] += dskd; if (s0 + 2 == ll) a[2] += dskd; if (s0 + 3 == ll) a[3] += dskd;
            }
            g2[h2] = a;
        }
        pa[kp] = pack8(g2[0], g2[1]);
    }
    pg8::f32x4 o[4];
#pragma unroll
    for (int pt = 0; pt < 4; ++pt) o[pt] = (pg8::f32x4){0.f, 0.f, 0.f, 0.f};
#pragma unroll
    for (int kp = 0; kp < 4; ++kp) if (2 * kp <= wave) {
        const LAS unsigned char* xb = XD + (32 * kp + 4 * kq + q4) * IMG_P + 8 * p4;
#pragma unroll
        for (int pt = 0; pt < 4; ++pt) o[pt] = __builtin_amdgcn_mfma_f32_16x16x32_bf16(pa[kp], tr_pair(xb + 32 * pt, xb + 16 * IMG_P + 32 * pt), o[pt], 0, 0, 0);
    }
    { bf16_t* yb = (bf16_t*)(C.ws + WS_BR) + (row0 + 16 * wave + 4 * kq) * 512 + head * 64 + n16;
#pragma unroll
      for (int i = 0; i < 4; ++i)
#pragma unroll
          for (int pt = 0; pt < 4; ++pt) yb[i * 512 + 16 * pt] = (bf16_t)f2bf(o[pt][i]); }
    { f32x4* HL = (f32x4*)(C.ws + WS_HL) + (size_t)unit * 16 * 64;
#pragma unroll
      for (int h2 = 0; h2 < 2; ++h2) { const int id = 2 * wave + h2, nt = id >> 2, pt = id & 3;
          pg8::f32x4 a = {0.f, 0.f, 0.f, 0.f};
#pragma unroll
          for (int ks = 0; ks < 4; ++ks) { const int rowa = 32 * ks + 8 * kq + q4;
              const ch_bf16x8 af = tr_pair(BW + rowa * IMG_P + 32 * nt + 8 * p4, BW + (rowa + 4) * IMG_P + 32 * nt + 8 * p4);
              const ch_bf16x8 bf = tr_pair(XD + rowa * IMG_P + 32 * pt + 8 * p4, XD + (rowa + 4) * IMG_P + 32 * pt + 8 * p4);
              a = __builtin_amdgcn_mfma_f32_16x16x32_bf16(af, bf, a, 0, 0, 0); }
          HL[id * 64 + lane] = (f32x4){a[0], a[1], a[2], a[3]}; } }
    if (tid == 0) ((float*)(C.ws + WS_DEC))[unit] = __expf(acs[127]);
    __syncthreads();
}
struct Ssd2Ops { f32x4 hl[4]; float dec; ch_bf16x8 cf[2][2]; unsigned short yv[2][4]; };
__device__ __forceinline__ void ssd2_load(Ssd2Ops& o, const bf16_t* CT, const f32x4* HL, const float* DEC, const bf16_t* Y, int chain, int c, int wv, int lq, int head, int b, int lane) {
    const int n16 = lane & 15, kq = lane >> 4;
    const int unit = chain * 32 + c; const size_t row0 = (size_t)b * SEQ + (size_t)c * 128 + 32 * lq;
#pragma unroll
    for (int nt = 0; nt < 4; ++nt) o.hl[nt] = HL[((size_t)unit * 16 + nt * 4 + wv) * 64 + lane];
    o.dec = DEC[unit];
#pragma unroll
    for (int lt = 0; lt < 2; ++lt) { const bf16_t* cp = CT + (row0 + 16 * lt + n16) * 512 + head * 64 + 8 * kq; o.cf[lt][0] = *(const ch_bf16x8*)cp; o.cf[lt][1] = *(const ch_bf16x8*)(cp + 32);
        const bf16_t* yp = Y + (row0 + 16 * lt + 4 * kq) * 512 + head * 64 + 16 * wv + n16;
#pragma unroll
        for (int i = 0; i < 4; ++i) o.yv[lt][i] = yp[i * 512]; }
}
__device__ __forceinline__ void ssd_pass2(const Ctx& C, int chain, int wv, int lq) {
    PH_IDS();
    const int n16 = lane & 15, kq = lane >> 4;
    const int head = chain & 7, b = chain >> 3;
    const bf16_t* CT = (const bf16_t*)(C.ws + WS_CT); const f32x4* HL = (const f32x4*)(C.ws + WS_HL); const float* DEC = (const float*)(C.ws + WS_DEC);
    bf16_t* Y = (bf16_t*)(C.ws + WS_BR);
    pg8::f32x4 H[4];
#pragma unroll
    for (int nt = 0; nt < 4; ++nt) H[nt] = (pg8::f32x4){0.f, 0.f, 0.f, 0.f};
    Ssd2Ops cur, nx1; ssd2_load(cur, CT, HL, DEC, Y, chain, 0, wv, lq, head, b, lane); ssd2_load(nx1, CT, HL, DEC, Y, chain, 1, wv, lq, head, b, lane);
    for (int c = 0; c < 32; ++c) {
        Ssd2Ops nxt; ssd2_load(nxt, CT, HL, DEC, Y, chain, c + 2 < 32 ? c + 2 : 31, wv, lq, head, b, lane);
        if (c > 0) {
            const ch_bf16x8 hb0 = pack8(H[0], H[1]), hb1 = pack8(H[2], H[3]);
            const size_t row0 = (size_t)b * SEQ + (size_t)c * 128 + 32 * lq;
#pragma unroll
            for (int lt = 0; lt < 2; ++lt) {
                pg8::f32x4 a = {0.f, 0.f, 0.f, 0.f};
                a = __builtin_amdgcn_mfma_f32_16x16x32_bf16(cur.cf[lt][0], hb0, a, 0, 0, 0);
                a = __builtin_amdgcn_mfma_f32_16x16x32_bf16(cur.cf[lt][1], hb1, a, 0, 0, 0);
                bf16_t* yp = Y + (row0 + 16 * lt + 4 * kq) * 512 + head * 64 + 16 * wv + n16;
#pragma unroll
                for (int i = 0; i < 4; ++i) yp[i * 512] = (bf16_t)f2bf(bf2f(cur.yv[lt][i]) + a[i]);
            }
        }
#pragma unroll
        for (int nt = 0; nt < 4; ++nt) { H[nt][0] = cur.dec * H[nt][0] + cur.hl[nt].x; H[nt][1] = cur.dec * H[nt][1] + cur.hl[nt].y; H[nt][2] = cur.dec * H[nt][2] + cur.hl[nt].z; H[nt][3] = cur.dec * H[nt][3] + cur.hl[nt].w; }
        cur = nx1; nx1 = nxt;
    }
}
__device__ __forceinline__ void hgrn_pass1(const Ctx& C, int l, int unit) {
    PH_IDS();
    const int blk = unit & 31, head = (unit >> 5) & 7, b = unit >> 8;
    const size_t row0 = (size_t)b * SEQ + (size_t)blk * 128;
    LAS unsigned char* QT = C.lds; LAS unsigned char* KT = QT + 128 * IMG_P; LAS unsigned char* VV = KT + 128 * IMG_P;
    const bf16_t* P = (const bf16_t*)(C.ws + WS_P);
    { u32x4 rq[2], rf[2], rv[2];
#pragma unroll
      for (int h2 = 0; h2 < 2; ++h2) { const int r = (tid >> 3) + 64 * h2, ch = tid & 7; const bf16_t* pr = P + (row0 + r) * PLD + head * 64 + ch * 8;
          rq[h2] = *(const u32x4*)(pr + C_QD); rf[h2] = *(const u32x4*)(pr + C_FD); rv[h2] = *(const u32x4*)(pr + C_ID); }
#pragma unroll
      for (int h2 = 0; h2 < 2; ++h2) { const int r = (tid >> 3) + 64 * h2, ch = tid & 7;
          *(LAS u32x4*)(QT + r * IMG_P + 16 * ch) = rq[h2]; *(LAS u32x4*)(KT + r * IMG_P + 16 * ch) = rf[h2]; *(LAS u32x4*)(VV + r * IMG_P + 16 * ch) = rv[h2]; } }
    __syncthreads();
    const int c4 = (tid >> 6) & 3;
    const size_t cgi = ((size_t)(b * 8 + head) * 128 + blk * 4 + c4);
    if (tid < 256) {
        const int k = lane;
        float lb = 0.f; if (l > 0) lb = sigmoidf_(INP(I_LBL)[512 + head * 64 + k] - INP(I_LBL)[head * 64 + k]);
        float G = 0.f; float kt[32];
#pragma unroll
        for (int t = 0; t < 32; ++t) {
            LAS bf16_t* pq = (LAS bf16_t*)(QT + (32 * c4 + t) * IMG_P + 2 * k); LAS bf16_t* pf = (LAS bf16_t*)(KT + (32 * c4 + t) * IMG_P + 2 * k);
            const float f = lb + (1.0f - lb) * sigmoidf_(bf2f(*pf)); const float q = siluf_(bf2f(*pq));
            G += __logf(f);
            const float qt = q * __expf(G), ktv = (1.0f - f) * __expf(-fmaxf(G, -80.0f));
            kt[t] = ktv;
            *pq = (bf16_t)f2bf(qt); *pf = (bf16_t)f2bf(ktv);
        }
        const float eg = __expf(G);
        ((float*)(C.ws + WS_DG))[cgi * 64 + k] = eg;
        u32x4* kh = (u32x4*)((bf16_t*)(C.ws + WS_KHT) + (cgi * 64 + k) * 32);
#pragma unroll
        for (int q = 0; q < 4; ++q) { u32x4 w; w.x = pk2(kt[8 * q] * eg, kt[8 * q + 1] * eg); w.y = pk2(kt[8 * q + 2] * eg, kt[8 * q + 3] * eg); w.z = pk2(kt[8 * q + 4] * eg, kt[8 * q + 5] * eg); w.w = pk2(kt[8 * q + 6] * eg, kt[8 * q + 7] * eg); kh[q] = w; }
    } else {
        const int v = lane;
        unsigned short vv[32];
#pragma unroll
        for (int t = 0; t < 32; ++t) vv[t] = *(const LAS bf16_t*)(VV + (32 * c4 + t) * IMG_P + 2 * v);
        u32x4* vt = (u32x4*)((bf16_t*)(C.ws + WS_VT) + (cgi * 64 + v) * 32);
#pragma unroll
        for (int q = 0; q < 4; ++q) { u32x4 w; w.x = vv[8 * q] | ((unsigned)vv[8 * q + 1] << 16); w.y = vv[8 * q + 2] | ((unsigned)vv[8 * q + 3] << 16); w.z = vv[8 * q + 4] | ((unsigned)vv[8 * q + 5] << 16); w.w = vv[8 * q + 6] | ((unsigned)vv[8 * q + 7] << 16); vt[q] = w; }
    }
    __syncthreads();
    { bf16_t* QG = (bf16_t*)(C.ws + WS_QG);
#pragma unroll
      for (int i = 0; i < 4; ++i) { const int idx = tid + 512 * i, r = idx >> 4, g4 = idx & 15;
          const u32x2 w = *(const LAS u32x2*)(QT + r * IMG_P + 8 * g4);
          *(u32x2*)(QG + (row0 + r) * 512 + head * 64 + kperm(4 * g4)) = w; } }
    { const int n16 = lane & 15, kq = lane >> 4, q4 = n16 >> 2, p4 = lane & 3;
      const int cw = wave >> 1, it = wave & 1;
      ch_bf16x8 qf[2];
#pragma unroll
      for (int ks = 0; ks < 2; ++ks) qf[ks] = *(const LAS ch_bf16x8*)(QT + (32 * cw + 16 * it + n16) * IMG_P + 64 * ks + 16 * kq);
      pg8::f32x4 at[2];
#pragma unroll
      for (int jt = 0; jt < 2; ++jt) { pg8::f32x4 a = {0.f, 0.f, 0.f, 0.f};
          if (jt <= it) {
#pragma unroll
              for (int ks = 0; ks < 2; ++ks) { const ch_bf16x8 kf = *(const LAS ch_bf16x8*)(KT + (32 * cw + 16 * jt + n16) * IMG_P + 64 * ks + 16 * kq); a = __builtin_amdgcn_mfma_f32_16x16x32_bf16(kf, qf[ks], a, 0, 0, 0); }
              const int ii = 16 * it + n16, j0 = 16 * jt + 4 * kq;
              a[0] = (j0 + 0 <= ii) ? a[0] : 0.f; a[1] = (j0 + 1 <= ii) ? a[1] : 0.f; a[2] = (j0 + 2 <= ii) ? a[2] : 0.f; a[3] = (j0 + 3 <= ii) ? a[3] : 0.f; }
          at[jt] = a; }
      const ch_bf16x8 pa = pack8(at[0], at[1]);
      const LAS unsigned char* vb = VV + (32 * cw + 4 * kq + q4) * IMG_P + 8 * p4;
      bf16_t* ob = (bf16_t*)(C.ws + WS_BR) + (size_t)3 * T * 512 + (row0 + 32 * cw + 16 * it + 4 * kq) * 512 + head * 64 + n16;
#pragma unroll
      for (int vt = 0; vt < 4; ++vt) { pg8::f32x4 o = {0.f, 0.f, 0.f, 0.f};
          o = __builtin_amdgcn_mfma_f32_16x16x32_bf16(pa, tr_pair(vb + 32 * vt, vb + 16 * IMG_P + 32 * vt), o, 0, 0, 0);
#pragma unroll
          for (int i = 0; i < 4; ++i) ob[i * 512 + 16 * vt] = (bf16_t)f2bf(o[i]); } }
    __syncthreads();
}
struct Hg2A { ch_bf16x8 vtf; ch_bf16x8 khf[4]; f32x4 dd[4]; };
__device__ __forceinline__ void hg2a_load(Hg2A& o, const bf16_t* KHT, const bf16_t* VT, const float* DG, size_t cgi, int wv, int lane) {
    const int n16 = lane & 15, kq = lane >> 4;
    o.vtf = *(const ch_bf16x8*)(VT + (cgi * 64 + 16 * wv + n16) * 32 + 8 * kq);
#pragma unroll
    for (int kt = 0; kt < 4; ++kt) { o.khf[kt] = *(const ch_bf16x8*)(KHT + (cgi * 64 + 16 * kt + n16) * 32 + 8 * kq); o.dd[kt] = *(const f32x4*)(DG + cgi * 64 + 16 * kt + 4 * kq); }
}
struct Hg2B { ch_bf16x8 qf[2][2]; unsigned short ov[2][4]; };
__device__ __forceinline__ void hg2b_load(Hg2B& o, const bf16_t* QG, const bf16_t* O, size_t crow, int wv, int head, int lane) {
    const int n16 = lane & 15, kq = lane >> 4;
#pragma unroll
    for (int it = 0; it < 2; ++it) { const bf16_t* qp = QG + (crow + 16 * it + n16) * 512 + head * 64 + 8 * kq; o.qf[it][0] = *(const ch_bf16x8*)qp; o.qf[it][1] = *(const ch_bf16x8*)(qp + 32);
        const bf16_t* op = O + (crow + 16 * it + 4 * kq) * 512 + head * 64 + 16 * wv + n16;
#pragma unroll
        for (int i = 0; i < 4; ++i) o.ov[it][i] = op[i * 512]; }
}
__device__ __forceinline__ void hgrn_pass2(const Ctx& C, int chain, int wv) {
    PH_IDS();
    const int n16 = lane & 15, kq = lane >> 4;
    const int head = chain & 7, b = chain >> 3, grp = wave;
    const bf16_t* QG = (const bf16_t*)(C.ws + WS_QG); const bf16_t* KHT = (const bf16_t*)(C.ws + WS_KHT); const bf16_t* VT = (const bf16_t*)(C.ws + WS_VT); const float* DG = (const float*)(C.ws + WS_DG);
    bf16_t* O = (bf16_t*)(C.ws + WS_BR) + (size_t)3 * T * 512;
    LAS f32x4* X = (LAS f32x4*)C.lds;
    pg8::f32x4 S[4], Dp[4];
#pragma unroll
    for (int kt = 0; kt < 4; ++kt) { S[kt] = (pg8::f32x4){0.f, 0.f, 0.f, 0.f}; Dp[kt] = (pg8::f32x4){1.f, 1.f, 1.f, 1.f}; }
    const size_t cg0 = (size_t)chain * 128 + 16 * grp;
    { Hg2A cur, nx1; hg2a_load(cur, KHT, VT, DG, cg0, wv, lane); hg2a_load(nx1, KHT, VT, DG, cg0 + 1, wv, lane);
      for (int c = 0; c < 16; ++c) {
          Hg2A nxt; hg2a_load(nxt, KHT, VT, DG, cg0 + (c + 2 < 16 ? c + 2 : 15), wv, lane);
#pragma unroll
          for (int kt = 0; kt < 4; ++kt) { pg8::f32x4 sl = {0.f, 0.f, 0.f, 0.f};
              sl = __builtin_amdgcn_mfma_f32_16x16x32_bf16(cur.khf[kt], cur.vtf, sl, 0, 0, 0);
              S[kt][0] = cur.dd[kt].x * S[kt][0] + sl[0]; S[kt][1] = cur.dd[kt].y * S[kt][1] + sl[1]; S[kt][2] = cur.dd[kt].z * S[kt][2] + sl[2]; S[kt][3] = cur.dd[kt].w * S[kt][3] + sl[3];
              Dp[kt][0] *= cur.dd[kt].x; Dp[kt][1] *= cur.dd[kt].y; Dp[kt][2] *= cur.dd[kt].z; Dp[kt][3] *= cur.dd[kt].w; }
          cur = nx1; nx1 = nxt;
      } }
#pragma unroll
    for (int kt = 0; kt < 4; ++kt) { X[(grp * 8 + kt) * 64 + lane] = (f32x4){Dp[kt][0], Dp[kt][1], Dp[kt][2], Dp[kt][3]}; X[(grp * 8 + 4 + kt) * 64 + lane] = (f32x4){S[kt][0], S[kt][1], S[kt][2], S[kt][3]}; }
    __syncthreads();
#pragma unroll
    for (int kt = 0; kt < 4; ++kt) S[kt] = (pg8::f32x4){0.f, 0.f, 0.f, 0.f};
    for (int g = 0; g < grp; ++g) {
#pragma unroll
        for (int kt = 0; kt < 4; ++kt) { const f32x4 d = X[(g * 8 + kt) * 64 + lane], lq = X[(g * 8 + 4 + kt) * 64 + lane];
            S[kt][0] = d.x * S[kt][0] + lq.x; S[kt][1] = d.y * S[kt][1] + lq.y; S[kt][2] = d.z * S[kt][2] + lq.z; S[kt][3] = d.w * S[kt][3] + lq.w; }
    }
    { Hg2A cur, na1; hg2a_load(cur, KHT, VT, DG, cg0, wv, lane); hg2a_load(na1, KHT, VT, DG, cg0 + 1, wv, lane);
      Hg2B cub, nb1; hg2b_load(cub, QG, O, (size_t)b * SEQ + (size_t)(16 * grp) * 32, wv, head, lane); hg2b_load(nb1, QG, O, (size_t)b * SEQ + (size_t)(16 * grp + 1) * 32, wv, head, lane);
      for (int c = 0; c < 16; ++c) {
          const int cn = (c + 2 < 16 ? c + 2 : 15);
          Hg2A nxt; hg2a_load(nxt, KHT, VT, DG, cg0 + cn, wv, lane);
          Hg2B nxb; hg2b_load(nxb, QG, O, (size_t)b * SEQ + (size_t)(16 * grp + cn) * 32, wv, head, lane);
          if (grp > 0 || c > 0) {
              const ch_bf16x8 sb0 = pack8(S[0], S[1]), sb1 = pack8(S[2], S[3]);
              const size_t crow = (size_t)b * SEQ + (size_t)(16 * grp + c) * 32;
#pragma unroll
              for (int it = 0; it < 2; ++it) {
                  pg8::f32x4 a = {0.f, 0.f, 0.f, 0.f};
                  a = __builtin_amdgcn_mfma_f32_16x16x32_bf16(cub.qf[it][0], sb0, a, 0, 0, 0);
                  a = __builtin_amdgcn_mfma_f32_16x16x32_bf16(cub.qf[it][1], sb1, a, 0, 0, 0);
                  bf16_t* op = O + (crow + 16 * it + 4 * kq) * 512 + head * 64 + 16 * wv + n16;
#pragma unroll
                  for (int i = 0; i < 4; ++i) op[i * 512] = (bf16_t)f2bf(bf2f(cub.ov[it][i]) + a[i]);
              }
          }
#pragma unroll
          for (int kt = 0; kt < 4; ++kt) { pg8::f32x4 sl = {0.f, 0.f, 0.f, 0.f};
              sl = __builtin_amdgcn_mfma_f32_16x16x32_bf16(cur.khf[kt], cur.vtf, sl, 0, 0, 0);
              S[kt][0] = cur.dd[kt].x * S[kt][0] + sl[0]; S[kt][1] = cur.dd[kt].y * S[kt][1] + sl[1]; S[kt][2] = cur.dd[kt].z * S[kt][2] + sl[2]; S[kt][3] = cur.dd[kt].w * S[kt][3] + sl[3]; }
          cur = na1; na1 = nxt; cub = nb1; nb1 = nxb;
      } }
}

#ifndef PROBE_MASK
#define PROBE_MASK 0
#endif
#ifndef PROBE_AMP
#define PROBE_AMP 1
#endif
#ifndef PROBE_BLOCK
#define PROBE_BLOCK 0
#endif
#if PROBE_MASK
#define PROBE_INIT() do { if (C.bid == PROBE_BLOCK && threadIdx.x == 0) { const unsigned long long t0_ = __builtin_amdgcn_s_memrealtime(); MISCW(C)[10] = (unsigned)t0_; MISCW(C)[11] = (unsigned)(t0_ >> 32); MISCW(C)[12] = 0u; MISCW(C)[13] = 0u; } } while (0)
#define PROBE_MARK(k) do { if (C.bid == PROBE_BLOCK && threadIdx.x == 0) { const unsigned long long n_ = __builtin_amdgcn_s_memrealtime(); const unsigned long long p_ = ((unsigned long long)MISCW(C)[11] << 32) | MISCW(C)[10]; \
    if ((PROBE_MASK >> (k)) & 1) { unsigned long long a_ = ((unsigned long long)MISCW(C)[13] << 32) | MISCW(C)[12]; a_ += n_ - p_; MISCW(C)[12] = (unsigned)a_; MISCW(C)[13] = (unsigned)(a_ >> 32); } \
    MISCW(C)[10] = (unsigned)n_; MISCW(C)[11] = (unsigned)(n_ >> 32); } } while (0)
#define PROBE_FINISH() do { if (C.bid == PROBE_BLOCK && threadIdx.x == 0) { const unsigned long long a_ = (((unsigned long long)MISCW(C)[13] << 32) | MISCW(C)[12]) * PROBE_AMP; const unsigned long long s_ = __builtin_amdgcn_s_memrealtime(); \
    while (__builtin_amdgcn_s_memrealtime() - s_ < a_) __builtin_amdgcn_s_sleep(16); } } while (0)
#else
#define PROBE_INIT() do {} while (0)
#define PROBE_MARK(k) do {} while (0)
#define PROBE_FINISH() do {} while (0)
#endif
typedef short dl_bf16x8 __attribute__((ext_vector_type(8)));
typedef short dl_s16x4 __attribute__((ext_vector_type(4)));
__device__ __forceinline__ void dilated_unit(const Ctx& C, int u) {
    PH_IDS();
    constexpr int VP = 288;
    const int g = 2 - (u >> 8), v = u & 255;
    int b, r, j, qblk, dil;
    if (g == 0) { dil = 1; b = v >> 6; r = 0; j = (v >> 4) & 3; qblk = v & 15; }
    else if (g == 1) { dil = 4; b = v >> 6; r = (v >> 4) & 3; j = (v >> 2) & 3; qblk = v & 3; }
    else { dil = 16; b = v >> 6; r = (v >> 2) & 15; j = v & 3; qblk = 0; }
    const int hh = g * 4 + j;
    const size_t rstride = (size_t)dil * PLD;
    const bf16_t* base = (const bf16_t*)(C.ws + WS_P) + ((size_t)b * SEQ + r) * PLD;
    const int qs = qblk * 256, ks0 = qs - 128;
    LAS unsigned char* Vs = C.lds;
#pragma unroll
    for (int k = 0; k < 12; ++k) { const int c = tid + 512 * k, i = c >> 4, ch = c & 15; int li = ks0 + i; li = li < 0 ? 0 : li;
        const u32x4 vv = *(const u32x4*)(base + (size_t)li * rstride + C_VB + hh * 128 + ch * 8);
        *(LAS u32x4*)(Vs + i * VP + ch * 16) = vv; }
    const int n16 = lane & 15, kq = lane >> 4;
    const int q0 = qs + 32 * wave;
    dl_bf16x8 qf[2][4];
#pragma unroll
    for (int qt = 0; qt < 2; ++qt) { const bf16_t* qp = base + (size_t)(q0 + 16 * qt + n16) * rstride + C_QB + hh * 128 + kq * 8;
#pragma unroll
        for (int s4 = 0; s4 < 4; ++s4) qf[qt][s4] = *(const dl_bf16x8*)(qp + s4 * 32); }
    pg8::f32x4 st[2][9];
    dl_bf16x8 kfa[4][4], kfb[3][4];
#define DIL_KLOAD(dst, tl_) do { int kt_ = q0 - 128 + 16 * (tl_) + n16; kt_ = kt_ < 0 ? 0 : kt_; const bf16_t* kp_ = base + (size_t)kt_ * rstride + C_KB + hh * 128 + kq * 8; \
        _Pragma("unroll") for (int s4 = 0; s4 < 4; ++s4) (dst)[s4] = *(const dl_bf16x8*)(kp_ + s4 * 32); } while (0)
#define DIL_QK(src, tl_) do { if ((tl_) <= 8) { pg8::f32x4 a_ = {0.f, 0.f, 0.f, 0.f}; _Pragma("unroll") for (int s4 = 0; s4 < 4; ++s4) a_ = __builtin_amdgcn_mfma_f32_16x16x32_bf16((src)[s4], qf[0][s4], a_, 0, 0, 0); st[0][(tl_) <= 8 ? (tl_) : 0] = a_; } \
        if ((tl_) >= 1) { pg8::f32x4 a_ = {0.f, 0.f, 0.f, 0.f}; _Pragma("unroll") for (int s4 = 0; s4 < 4; ++s4) a_ = __builtin_amdgcn_mfma_f32_16x16x32_bf16((src)[s4], qf[1][s4], a_, 0, 0, 0); st[1][(tl_) >= 1 ? (tl_) - 1 : 0] = a_; } } while (0)
#pragma unroll
    for (int t = 0; t < 4; ++t) DIL_KLOAD(kfa[t], t);
#pragma unroll
    for (int t = 0; t < 3; ++t) DIL_KLOAD(kfb[t], 4 + t);
    asm volatile("" ::: "memory");
#pragma unroll
    for (int t = 0; t < 4; ++t) DIL_QK(kfa[t], t);
#pragma unroll
    for (int t = 0; t < 3; ++t) DIL_KLOAD(kfa[t], 7 + t);
    asm volatile("" ::: "memory");
#pragma unroll
    for (int t = 0; t < 3; ++t) DIL_QK(kfb[t], 4 + t);
#pragma unroll
    for (int t = 0; t < 3; ++t) DIL_QK(kfa[t], 7 + t);
#undef DIL_KLOAD
#undef DIL_QK
    const float sc2 = 0.08838834764831845f * 1.4426950408889634f;
    float mxq[2], lsq[2];
#pragma unroll
    for (int qt = 0; qt < 2; ++qt) {
        const int q0t = q0 + 16 * qt;
        float mx = -3.0e38f;
        if (q0t >= 128) {
#pragma unroll
            for (int i = 0; i < 4; ++i) { st[qt][0][i] = (4 * kq + i >= n16) ? st[qt][0][i] : -3.0e38f; st[qt][8][i] = (4 * kq + i <= n16) ? st[qt][8][i] : -3.0e38f; }
        } else {
#pragma unroll
            for (int tt = 0; tt < 9; ++tt)
#pragma unroll
                for (int i = 0; i < 4; ++i) { const int dist = 128 + n16 - 16 * tt - 4 * kq - i; const int kidx = q0t - 128 + 16 * tt + 4 * kq + i;
                    const bool valid = (dist >= 0) && (dist <= 128) && (kidx >= 0);
                    st[qt][tt][i] = valid ? st[qt][tt][i] : -3.0e38f; }
        }
#pragma unroll
        for (int tt = 0; tt < 9; ++tt)
#pragma unroll
            for (int i = 0; i < 4; ++i) mx = fmaxf(mx, st[qt][tt][i]);
        mx = fmaxf(mx, __int_as_float(__builtin_amdgcn_ds_bpermute((lane ^ 16) << 2, __float_as_int(mx))));
        mx = fmaxf(mx, __int_as_float(__builtin_amdgcn_ds_bpermute((lane ^ 32) << 2, __float_as_int(mx))));
        float lsum = 0.f;
#pragma unroll
        for (int tt = 0; tt < 9; ++tt)
#pragma unroll
            for (int i = 0; i < 4; ++i) { const float p = (st[qt][tt][i] > -1.0e38f) ? __builtin_amdgcn_exp2f((st[qt][tt][i] - mx) * sc2) : 0.f; st[qt][tt][i] = p; lsum += p; }
        lsum += __int_as_float(__builtin_amdgcn_ds_bpermute((lane ^ 16) << 2, __float_as_int(lsum)));
        lsum += __int_as_float(__builtin_amdgcn_ds_bpermute((lane ^ 32) << 2, __float_as_int(lsum)));
        mxq[qt] = mx; lsq[qt] = lsum;
    }
    const pg8::f32x4 zero4 = {0.f, 0.f, 0.f, 0.f};
    dl_bf16x8 pa[2][5];
#pragma unroll
    for (int ks = 0; ks < 5; ++ks) {
        pa[0][ks] = pack8(st[0][2 * ks], (2 * ks + 1 <= 8) ? st[0][(2 * ks + 1 <= 8) ? 2 * ks + 1 : 8] : zero4);
        pa[1][ks] = pack8((ks > 0) ? st[1][(ks > 0) ? 2 * ks - 1 : 0] : zero4, st[1][2 * ks]);
    }
    __syncthreads();
    pg8::f32x4 o[2][8];
#pragma unroll
    for (int qt = 0; qt < 2; ++qt)
#pragma unroll
        for (int c = 0; c < 8; ++c) o[qt][c] = zero4;
    const int q4 = (lane & 15) >> 2, p4 = lane & 3;
    const LAS unsigned char* vb = Vs + (32 * wave + 4 * kq + q4) * VP + 8 * p4;
#pragma unroll
    for (int ks = 0; ks < 5; ++ks) {
#pragma unroll
        for (int c = 0; c < 8; ++c) {
            const dl_bf16x8 bfr = tr_pair(vb + (32 * ks) * VP + 32 * c, vb + (32 * ks + 16) * VP + 32 * c);
            o[0][c] = __builtin_amdgcn_mfma_f32_16x16x32_bf16(pa[0][ks], bfr, o[0][c], 0, 0, 0);
            o[1][c] = __builtin_amdgcn_mfma_f32_16x16x32_bf16(pa[1][ks], bfr, o[1][c], 0, 0, 0);
        }
    }
    bf16_t* OG = (g == 2) ? (bf16_t*)(C.ws + WS_BR) + (size_t)T * 512 : (bf16_t*)(C.ws + WS_MIXS) + (size_t)g * T * 512;
    float* LSE = (float*)(C.ws + WS_LSE) + (size_t)g * T * 4;
    const size_t trow0 = (size_t)b * SEQ + r;
#pragma unroll
    for (int qt = 0; qt < 2; ++qt) {
#pragma unroll
        for (int i = 0; i < 4; ++i) {
            const float li = __int_as_float(__builtin_amdgcn_ds_bpermute((4 * kq + i) << 2, __float_as_int(lsq[qt])));
            const float inv = __builtin_amdgcn_rcpf(li);
            bf16_t* op = OG + (trow0 + (size_t)(q0 + 16 * qt + 4 * kq + i) * dil) * 512 + j * 128 + n16;
#pragma unroll
            for (int c = 0; c < 8; ++c) op[16 * c] = (bf16_t)f2bf(o[qt][c][i] * inv);
        }
        if (kq == 0) LSE[(trow0 + (size_t)(q0 + 16 * qt + n16) * dil) * 4 + j] = mxq[qt] * 0.08838834764831845f + __logf(lsq[qt]);
    }
}

__device__ __forceinline__ void phase_mix_a(const Ctx& C, int l) {
#ifndef NO_CHAIN
    for (int u = C.bid; u < 1024; u += C.G) ssd_pass1(C, l, u);
    PROBE_MARK(18);
    for (int u = C.bid; u < 1024; u += C.G) hgrn_pass1(C, l, u);
    PROBE_MARK(19);
#endif
}
__device__ __forceinline__ void phase_mix_b(const Ctx& C, int l) {
    PH_IDS();
    unsigned* wq = (unsigned*)(C.ws + WS_CTL) + CW_WQ + 64 * (2 * l);
    unsigned* p2done = (unsigned*)(C.ws + WS_CTL) + CW_P2 + 64 * l;
#ifndef NO_CHAIN
    if (C.bid < 64) ssd_pass2(C, C.bid >> 1, wave & 3, ((C.bid & 1) << 1) | (wave >> 2));
    else if (C.bid < 192) hgrn_pass2(C, (C.bid - 64) >> 2, (C.bid - 64) & 3);
    if (C.bid < 192) { asm volatile("s_waitcnt vmcnt(0)" ::: "memory"); __syncthreads(); if (tid == 0) __hip_atomic_fetch_add(p2done, 1u, __ATOMIC_RELAXED, __HIP_MEMORY_SCOPE_AGENT); }
#endif
    PROBE_MARK(12);
    const attn_body::bf16* P = (const attn_body::bf16*)(C.ws + WS_P); attn_body::bf16* O16 = (attn_body::bf16*)(C.ws + WS_O16);
#ifndef NO_ATTN
    for (;;) {
        __syncthreads();
        if (tid == 0) MISCW(C)[4] = atomicAdd(wq, 1u);
        __syncthreads();
        const int u = (int)MISCW(C)[4]; if (u >= 1024) break;
        const int qb = 15 - (u >> 6), bh = u & 63, b = bh >> 4, hp = bh & 15, i = hp >> 1, half = hp & 1;
        const size_t r0 = (size_t)b * SEQ;
        attn_body::attn_unit<8, PLD, 1024>(qb, P + r0 * PLD + C_QC + i * 64, P + r0 * PLD + C_KC + i * 64, P + r0 * PLD + C_VC + (i >> 1) * 128 + half * 64, O16 + r0 * 1024 + hp * 64, (char*)C.lds);
    }
#endif
    PROBE_MARK(13);
#ifndef NO_DIL
    if (tid == 0) { unsigned sp = 0; while (__hip_atomic_load(p2done, __ATOMIC_RELAXED, __HIP_MEMORY_SCOPE_AGENT) < 192u) { __builtin_amdgcn_s_sleep(8); if (++sp > (1u << 22)) break; } }
    for (;;) {
        __syncthreads();
        if (tid == 0) MISCW(C)[4] = atomicAdd(wq + 64, 1u);
        __syncthreads();
        const int u = (int)MISCW(C)[4]; if (u >= 768) break;
        dilated_unit(C, u);
    }
#endif
    PROBE_MARK(14);
}

__device__ __forceinline__ void phase_comb(const Ctx& C, int l) {
    PH_IDS();
    if (tid < 64) {
        const float* dl = INP(I_DLAM) + l * 256;
        const float s1 = wave_sum(dl[lane] * dl[64 + lane]), s2 = wave_sum(dl[128 + lane] * dl[192 + lane]);
        const float lam_init = (l == 0) ? 0.2f : 0.35550907f;
        if (tid == 0) { MISCW(C)[6] = __float_as_uint(expf(s1) - expf(s2) + lam_init); MISCW(C)[7] = __float_as_uint(1.0f - lam_init); }
    }
    __syncthreads();
    const float lam = __uint_as_float(MISCW(C)[6]), oml = __uint_as_float(MISCW(C)[7]);
    const int gw = C.bid * NWAVES + wave, NGW = C.G * NWAVES;
    const bf16_t* O16 = (const bf16_t*)(C.ws + WS_O16); bf16_t* BR = (bf16_t*)(C.ws + WS_BR) + (size_t)2 * T * 512;
    float swl[8];
    { const float* sp = INP(I_SUBLN) + l * 128 + 8 * (lane & 15);
#pragma unroll
      for (int e = 0; e < 8; ++e) swl[e] = sp[e]; }
    const bf16_t* OG0 = (const bf16_t*)(C.ws + WS_MIXS); const bf16_t* OG1 = OG0 + (size_t)T * 512; bf16_t* OG2 = (bf16_t*)(C.ws + WS_BR) + (size_t)T * 512;
    const float* LSE = (const float*)(C.ws + WS_LSE);
    bf16_t* BR0 = (bf16_t*)(C.ws + WS_BR); bf16_t* BR3 = BR0 + (size_t)3 * T * 512; const bf16_t* Pp = (const bf16_t*)(C.ws + WS_P);
    float nwa[8], nwd[8];
    { const float* a = INP(I_SSDNW) + l * 512 + 8 * lane; const float* d = INP(I_HGNW) + l * 64 + 8 * (lane & 7);
#pragma unroll
      for (int e = 0; e < 8; ++e) { nwa[e] = a[e]; nwd[e] = d[e]; } }
    struct CombIn { u32x4 yv, zv, ov, gv, a, bb, cc, av, bv; float l0, l1, l2; };
    const int jj = lane >> 4, hq = lane >> 4, e0 = 8 * (lane & 15), half = e0 >> 6, ee = e0 & 63;
#define COMB_LOAD(I, row_) do { const size_t r_ = (size_t)(row_); \
        (I).yv = *(const u32x4*)(BR0 + r_ * 512 + 8 * lane); (I).zv = *(const u32x4*)(Pp + r_ * PLD + C_Z + 8 * lane); \
        (I).ov = *(const u32x4*)(BR3 + r_ * 512 + 8 * lane); (I).gv = *(const u32x4*)(Pp + r_ * PLD + C_GD + 8 * lane); \
        (I).a = *(const u32x4*)(OG0 + r_ * 512 + 8 * lane); (I).bb = *(const u32x4*)(OG1 + r_ * 512 + 8 * lane); (I).cc = *(const u32x4*)(OG2 + r_ * 512 + 8 * lane); \
        (I).av = *(const u32x4*)(O16 + r_ * 1024 + (4 * hq + half) * 64 + ee); (I).bv = *(const u32x4*)(O16 + r_ * 1024 + (4 * hq + 2 + half) * 64 + ee); \
        (I).l0 = LSE[r_ * 4 + jj]; (I).l1 = LSE[((size_t)T + r_) * 4 + jj]; (I).l2 = LSE[((size_t)2 * T + r_) * 4 + jj]; } while (0)
    CombIn cur; COMB_LOAD(cur, gw);
    for (int row = gw; row < T; row += NGW) {
        CombIn nxt; COMB_LOAD(nxt, (row + NGW < T) ? row + NGW : row);
        {
            const u32x4 yv = cur.yv, zv = cur.zv;
            float u[8];
            u[0] = lo2f(yv.x) * siluf_(lo2f(zv.x)); u[1] = hi2f(yv.x) * siluf_(hi2f(zv.x)); u[2] = lo2f(yv.y) * siluf_(lo2f(zv.y)); u[3] = hi2f(yv.y) * siluf_(hi2f(zv.y));
            u[4] = lo2f(yv.z) * siluf_(lo2f(zv.z)); u[5] = hi2f(yv.z) * siluf_(hi2f(zv.z)); u[6] = lo2f(yv.w) * siluf_(lo2f(zv.w)); u[7] = hi2f(yv.w) * siluf_(hi2f(zv.w));
            float ss = 0.f;
#pragma unroll
            for (int e = 0; e < 8; ++e) ss += u[e] * u[e];
            const float rstd = rsqrtf(wave_sum(ss) * (1.0f / 512.0f) + EPS);
            u32x4 w; w.x = pk2(u[0] * rstd * nwa[0], u[1] * rstd * nwa[1]); w.y = pk2(u[2] * rstd * nwa[2], u[3] * rstd * nwa[3]); w.z = pk2(u[4] * rstd * nwa[4], u[5] * rstd * nwa[5]); w.w = pk2(u[6] * rstd * nwa[6], u[7] * rstd * nwa[7]);
            *(u32x4*)(BR0 + (size_t)row * 512 + 8 * lane) = w;
        }
        {
            const u32x4 ov = cur.ov, gv = cur.gv;
            float o[8]; o[0] = lo2f(ov.x); o[1] = hi2f(ov.x); o[2] = lo2f(ov.y); o[3] = hi2f(ov.y); o[4] = lo2f(ov.z); o[5] = hi2f(ov.z); o[6] = lo2f(ov.w); o[7] = hi2f(ov.w);
            float ss = 0.f;
#pragma unroll
            for (int e = 0; e < 8; ++e) ss += o[e] * o[e];
            ss += __int_as_float(__builtin_amdgcn_ds_bpermute((lane ^ 1) << 2, __float_as_int(ss)));
            ss += __int_as_float(__builtin_amdgcn_ds_bpermute((lane ^ 2) << 2, __float_as_int(ss)));
            ss += __int_as_float(__builtin_amdgcn_ds_bpermute((lane ^ 4) << 2, __float_as_int(ss)));
            const float rstd = rsqrtf(ss * (1.0f / 64.0f) + EPS);
            u32x4 w;
            w.x = pk2(o[0] * rstd * nwd[0] * siluf_(lo2f(gv.x)), o[1] * rstd * nwd[1] * siluf_(hi2f(gv.x))); w.y = pk2(o[2] * rstd * nwd[2] * siluf_(lo2f(gv.y)), o[3] * rstd * nwd[3] * siluf_(hi2f(gv.y)));
            w.z = pk2(o[4] * rstd * nwd[4] * siluf_(lo2f(gv.z)), o[5] * rstd * nwd[5] * siluf_(hi2f(gv.z))); w.w = pk2(o[6] * rstd * nwd[6] * siluf_(lo2f(gv.w)), o[7] * rstd * nwd[7] * siluf_(hi2f(gv.w)));
            *(u32x4*)(BR3 + (size_t)row * 512 + 8 * lane) = w;
        }
        {
            const float l0 = cur.l0, l1 = cur.l1, l2 = cur.l2;
            const float M = fmaxf(fmaxf(l0, l1), l2); const float x0 = __expf(l0 - M), x1 = __expf(l1 - M), x2 = __expf(l2 - M); const float inv = __builtin_amdgcn_rcpf(x0 + x1 + x2);
            const float c0 = x0 * inv, c1 = x1 * inv, c2 = x2 * inv;
            const u32x4 a = cur.a, bb = cur.bb, cc = cur.cc;
            u32x4 w;
            w.x = pk2(c0 * lo2f(a.x) + c1 * lo2f(bb.x) + c2 * lo2f(cc.x), c0 * hi2f(a.x) + c1 * hi2f(bb.x) + c2 * hi2f(cc.x));
            w.y = pk2(c0 * lo2f(a.y) + c1 * lo2f(bb.y) + c2 * lo2f(cc.y), c0 * hi2f(a.y) + c1 * hi2f(bb.y) + c2 * hi2f(cc.y));
            w.z = pk2(c0 * lo2f(a.z) + c1 * lo2f(bb.z) + c2 * lo2f(cc.z), c0 * hi2f(a.z) + c1 * hi2f(bb.z) + c2 * hi2f(cc.z));
            w.w = pk2(c0 * lo2f(a.w) + c1 * lo2f(bb.w) + c2 * lo2f(cc.w), c0 * hi2f(a.w) + c1 * hi2f(bb.w) + c2 * hi2f(cc.w));
            *(u32x4*)(OG2 + (size_t)row * 512 + 8 * lane) = w;
        }
        {
            const u32x4 av = cur.av, bv = cur.bv;
            float d[8];
            d[0] = lo2f(av.x) - lam * lo2f(bv.x); d[1] = hi2f(av.x) - lam * hi2f(bv.x); d[2] = lo2f(av.y) - lam * lo2f(bv.y); d[3] = hi2f(av.y) - lam * hi2f(bv.y);
            d[4] = lo2f(av.z) - lam * lo2f(bv.z); d[5] = hi2f(av.z) - lam * hi2f(bv.z); d[6] = lo2f(av.w) - lam * lo2f(bv.w); d[7] = hi2f(av.w) - lam * hi2f(bv.w);
            float ss = 0.f;
#pragma unroll
            for (int e = 0; e < 8; ++e) ss += d[e] * d[e];
            ss += __int_as_float(__builtin_amdgcn_ds_bpermute((lane ^ 1) << 2, __float_as_int(ss)));
            ss += __int_as_float(__builtin_amdgcn_ds_bpermute((lane ^ 2) << 2, __float_as_int(ss)));
            ss += __int_as_float(__builtin_amdgcn_ds_bpermute((lane ^ 4) << 2, __float_as_int(ss)));
            ss += __int_as_float(__builtin_amdgcn_ds_bpermute((lane ^ 8) << 2, __float_as_int(ss)));
            const float rstd = rsqrtf(ss * (1.0f / 128.0f) + EPS) * oml;
            u32x4 w; w.x = pk2(d[0] * rstd * swl[0], d[1] * rstd * swl[1]); w.y = pk2(d[2] * rstd * swl[2], d[3] * rstd * swl[3]); w.z = pk2(d[4] * rstd * swl[4], d[5] * rstd * swl[5]); w.w = pk2(d[6] * rstd * swl[6], d[7] * rstd * swl[7]);
            *(u32x4*)(BR + (size_t)row * 512 + hq * 128 + e0) = w;
        }
        cur = nxt;
    }
#undef COMB_LOAD
}

using pg8::Unit; using pg8::HALF; using pg8::BM;
struct EpiMerge {
    static constexpr bool PERM = true, AFTER_DRAIN = false;
    const bf16_t* P; bf16_t* MS;
    __device__ __forceinline__ void operator()(const pg8::f32x4 (&acc)[2][2][4][2], const Unit& u, int wr, int wc, int fr, int fq) const {
        const int n = u.pn >> 2, pn = u.pn & 3, pm = u.pm & 63;
        const int row0 = pm * BM + wr * 64 + fr, col0 = pn * BM + wc * 32 + 8 * fq;
        u32x4 gl[2][2][2], pv[2][2][2];
#define MERGE_LOAD(B, Q) do { _Pragma("unroll") for (int m2 = 0; m2 < 2; ++m2) _Pragma("unroll") for (int bj = 0; bj < 2; ++bj) { \
            const unsigned row_ = (unsigned)(row0 + ((Q) >> 1) * HALF + (((Q) & 1) * 2 + m2) * 16), col_ = (unsigned)(col0 + bj * HALF); \
            gl[B][m2][bj] = *(const u32x4*)(P + (row_ * (unsigned)PLD + C_GATE + n * 1024 + col_)); \
            pv[B][m2][bj] = (n > 0) ? *(const u32x4*)(MS + (row_ * DM + col_)) : (u32x4){0u, 0u, 0u, 0u}; } } while (0)
#define MERGE_CALC(B, Q) do { _Pragma("unroll") for (int m2 = 0; m2 < 2; ++m2) _Pragma("unroll") for (int bj = 0; bj < 2; ++bj) { \
            const int ai_ = (Q) >> 1, m_ = ((Q) & 1) * 2 + m2; const unsigned row_ = (unsigned)(row0 + ai_ * HALF + m_ * 16), col_ = (unsigned)(col0 + bj * HALF); \
            const pg8::f32x4 v0 = acc[ai_][bj][m_][0], v1 = acc[ai_][bj][m_][1]; const u32x4 g = gl[B][m2][bj], p = pv[B][m2][bj]; \
            float r[8]; \
            r[0] = sigmoidf_(lo2f(g.x)) * v0[0] + lo2f(p.x); r[1] = sigmoidf_(hi2f(g.x)) * v0[1] + hi2f(p.x); r[2] = sigmoidf_(lo2f(g.y)) * v0[2] + lo2f(p.y); r[3] = sigmoidf_(hi2f(g.y)) * v0[3] + hi2f(p.y); \
            r[4] = sigmoidf_(lo2f(g.z)) * v1[0] + lo2f(p.z); r[5] = sigmoidf_(hi2f(g.z)) * v1[1] + hi2f(p.z); r[6] = sigmoidf_(lo2f(g.w)) * v1[2] + lo2f(p.w); r[7] = sigmoidf_(hi2f(g.w)) * v1[3] + hi2f(p.w); \
            u32x4 w; w.x = pk2(r[0], r[1]); w.y = pk2(r[2], r[3]); w.z = pk2(r[4], r[5]); w.w = pk2(r[6], r[7]); \
            *(u32x4*)(MS + (row_ * DM + col_)) = w; } } while (0)
        MERGE_LOAD(0, 0); MERGE_LOAD(1, 1);
        MERGE_CALC(0, 0); MERGE_LOAD(0, 2);
        MERGE_CALC(1, 1); MERGE_LOAD(1, 3);
        MERGE_CALC(0, 2);
        MERGE_CALC(1, 3);
#undef MERGE_LOAD
#undef MERGE_CALC
    }
};
struct OrderMerge { int G, c;
    __device__ __forceinline__ bool next(int i, Unit& u) const { const int L = (i >> 2) * G + c; if (L >= 256) return false; const int n = i & 3; u.pm = n * 64 + (L >> 2); u.pn = n * 4 + (L & 3); return true; }
    __device__ __forceinline__ void a_ready(const Unit&) const {}
    __device__ __forceinline__ void done(const Unit&) const {}
};
struct EpiWout {
    static constexpr bool PERM = false, AFTER_DRAIN = false;
    const float* xin; float* xout; const float* g1;
    __device__ __forceinline__ void operator()(const pg8::f32x4 (&acc)[2][2][4][2], const Unit& u, int wr, int wc, int fr, int fq) const {
        const int row0 = u.pm * BM + wr * 64 + fr, col0 = u.pn * BM + wc * 32 + 4 * fq;
        const float* g = g1 + (size_t)(row0 >> 12) * 6144;
        pg8::f32x4 gv[2][2];
#pragma unroll
        for (int bj = 0; bj < 2; ++bj)
#pragma unroll
            for (int n = 0; n < 2; ++n) gv[bj][n] = *(const pg8::f32x4*)(g + col0 + bj * HALF + n * 16);
#pragma unroll
        for (int am = 0; am < 4; ++am) { const int ai = am >> 1, m0 = (am & 1) * 2;
            pg8::f32x4 xv[2][2][2];
#pragma unroll
            for (int m = 0; m < 2; ++m)
#pragma unroll
                for (int bj = 0; bj < 2; ++bj)
#pragma unroll
                    for (int n = 0; n < 2; ++n) xv[m][bj][n] = *(const pg8::f32x4*)(xin + ((unsigned)(row0 + ai * HALF + (m0 + m) * 16) * DM + col0 + bj * HALF + n * 16));
#pragma unroll
            for (int m = 0; m < 2; ++m)
#pragma unroll
                for (int bj = 0; bj < 2; ++bj)
#pragma unroll
                    for (int n = 0; n < 2; ++n) *(pg8::f32x4*)(xout + ((unsigned)(row0 + ai * HALF + (m0 + m) * 16) * DM + col0 + bj * HALF + n * 16)) = xv[m][bj][n] + gv[bj][n] * acc[ai][bj][m0 + m][n];
        }
    }
};
struct EpiMoe1 {
    static constexpr bool PERM = true, AFTER_DRAIN = false;
    bf16_t* HID;
    __device__ __forceinline__ void operator()(const pg8::f32x4 (&acc)[2][2][4][2], const Unit& u, int wr, int wc, int fr, int fq) const {
        const int j = u.pn & 1, row0 = u.pm * BM + wr * 64 + fr, c0 = 128 * j + 16 * wc + 4 * fq;
#pragma unroll
        for (int ai = 0; ai < 2; ++ai)
#pragma unroll
            for (int m = 0; m < 4; ++m) { bf16_t* rp = HID + ((unsigned)(row0 + ai * HALF + m * 16) * 256u + c0);
#pragma unroll
                for (int bj = 0; bj < 2; ++bj) { const pg8::f32x4 g = acc[ai][bj][m][0], up = acc[ai][bj][m][1];
                    u32x2 w; w.x = pk2(siluf_(g[0]) * up[0], siluf_(g[1]) * up[1]); w.y = pk2(siluf_(g[2]) * up[2], siluf_(g[3]) * up[3]);
                    *(u32x2*)(rp + 64 * bj) = w; } }
    }
};
struct EpiMoe2 {
    static constexpr bool PERM = true, AFTER_DRAIN = false;
    bf16_t* Y;
    __device__ __forceinline__ void operator()(const pg8::f32x4 (&acc)[2][2][4][2], const Unit& u, int wr, int wc, int fr, int fq) const {
        const int j = u.pn & 3, row0 = u.pm * BM + wr * 64 + fr, c0 = 256 * j + 32 * wc + 8 * fq;
#pragma unroll
        for (int ai = 0; ai < 2; ++ai)
#pragma unroll
            for (int m = 0; m < 4; ++m) { const unsigned ro = (unsigned)(row0 + ai * HALF + m * 16) * DM + c0; bf16_t* rp = Y + ro;
#pragma unroll
                for (int bj = 0; bj < 2; ++bj) { const pg8::f32x4 v0 = acc[ai][bj][m][0], v1 = acc[ai][bj][m][1];
                    u32x4 w; w.x = pk2(v0[0], v0[1]); w.y = pk2(v0[2], v0[3]); w.z = pk2(v1[0], v1[1]); w.w = pk2(v1[2], v1[3]);
                    *(u32x4*)(rp + HALF * bj) = w; } }
    }
};
struct OrderList { const LAS int* lst;
    __device__ __forceinline__ bool next(int i, Unit& u) const { if (i >= lst[0]) return false; const int v = lst[1 + i]; u.pm = v >> 8; u.pn = v & 255; return true; }
    __device__ __forceinline__ void a_ready(const Unit&) const {}
    __device__ __forceinline__ void done(const Unit&) const {}
};
template <int SH> struct OrderMoe { int G, c, nunits; const LAS unsigned char* blk_e;
    __device__ __forceinline__ bool next(int i, Unit& u) const { const int L = i * G + c; if (L >= nunits) return false; u.pm = L >> SH; u.pn = ((int)blk_e[L >> SH] << SH) + (L & ((1 << SH) - 1)); return true; }
    __device__ __forceinline__ void a_ready(const Unit&) const {}
    __device__ __forceinline__ void done(const Unit&) const {}
};

struct Args { const float* in[25]; float* out; unsigned char* ws; };
__global__ void __launch_bounds__(NTHR, 2) mega_fwd(Args args) {
    extern __shared__ __attribute__((aligned(16))) unsigned char lds_raw[];
    Ctx C;
    C.out = args.out; C.ws = args.ws;
    C.lds = (LAS unsigned char*)lds_raw; C.G = gridDim.x; C.bid = blockIdx.x;
    { const int tid0 = threadIdx.x;
      for (int i = tid0; i < (LDS_BYTES - MISC_OFF) / 4; i += NTHR) MISCW(C)[i] = 0u;
      __syncthreads();
      if (tid0 < 25) { const unsigned long long p = (unsigned long long)args.in[tid0]; LAS unsigned* t = (LAS unsigned*)(C.lds + MISC_OFF + 1024) + 2 * tid0; t[0] = (unsigned)p; t[1] = (unsigned)(p >> 32); }
      __syncthreads(); }
    XcdBarrier bar = xcd_barrier_post((unsigned*)(C.ws + WS_CTL) + CW_BAR, MISCW(C));
    LAS unsigned char* stage = C.lds;
#define WSP(T_, off) ((T_*)(C.ws + (off)))

    PROBE_INIT();
#ifndef NO_PRO
    pro_mods(C);
#endif
    xcd_barrier(bar);
    PROBE_MARK(0);
    for (int l = 0; l < DEPTH; ++l) {
#ifndef NO_N1
        if (l == 0) phase_rows<0, false, true>(C, 0); else phase_rows<0, true, false>(C, l);
#endif
        xcd_barrier(bar); PROBE_MARK(1);
#ifndef NO_G1
        { pg8::Gemm g{WSP(const bf16_t, WS_H), WSP(const bf16_t, WS_WIN), T, PLD, 1024}; pg8::StaticOrder S; S.init(T, PLD, C.G, C.bid);
          pg8::EpiBf16<0> E{WSP(bf16_t, WS_P), PLD, nullptr, 0, 0};
          pg8::gemm_phase<pg8::EpiBf16<0>, pg8::StaticOrder, false>(stage, g, S, E, nullptr); }
#endif
        xcd_barrier(bar); PROBE_MARK(2);
#ifndef NO_MIX
        phase_mix_a(C, l);
        xcd_barrier(bar); PROBE_MARK(15);
        phase_mix_b(C, l);
#endif
        xcd_barrier(bar); PROBE_MARK(3);
#ifndef NO_COMB
        phase_comb(C, l);
#endif
        xcd_barrier(bar); PROBE_MARK(4);
#ifndef NO_MERGE
        { pg8::Gemm g{WSP(const bf16_t, WS_BR), WSP(const bf16_t, WS_WMG), 4 * T, 4096, 512}; OrderMerge S{C.G, C.bid};
          EpiMerge E{WSP(const bf16_t, WS_P), WSP(bf16_t, WS_MIXS)};
          pg8::gemm_phase<EpiMerge, OrderMerge, false>(stage, g, S, E, nullptr); }
#endif
        xcd_barrier(bar); PROBE_MARK(5);
#ifndef NO_WOUT
        { pg8::Gemm g{WSP(const bf16_t, WS_MIXS), WSP(const bf16_t, WS_WOUT), T, 1024, 1024}; pg8::StaticOrder S; S.init(T, 1024, C.G, C.bid);
          EpiWout E{l == 0 ? INP(I_X) : (const float*)C.out, C.out, WSP(const float, WS_MOD) + (size_t)l * 4 * 6144 + 2048};
          pg8::gemm_phase<EpiWout, pg8::StaticOrder, false>(stage, g, S, E, nullptr); }
#endif
        xcd_barrier(bar); PROBE_MARK(6);
#ifndef NO_N2
        phase_n2(C, l, l + 1 < DEPTH); PROBE_MARK(16);
#endif
        xcd_barrier(bar); PROBE_MARK(7);
#ifndef NO_SCAT
        phase_scatter(C, l);
#endif
        xcd_barrier(bar); PROBE_MARK(8);
#ifndef NO_MOE1
        { const int nblk = (int)MISCW(C)[5];
          const LAS int* m1 = (const LAS int*)(C.lds + MISC_OFF + 2048); LAS int* rowl = (LAS int*)(C.lds + MISC_OFF + 4096);
          { const int* ROWTOK = (const int*)(C.ws + WS_ROWTOK); const int nu = m1[0] < 12 ? m1[0] : 12; int t0 = threadIdx.x; asm volatile("" : "+v"(t0));
            for (int i = 0; i < nu; ++i) if (t0 < 256) rowl[i * 256 + t0] = ROWTOK[(m1[1 + i] >> 8) * 256 + t0];
            __syncthreads(); }
          pg8::Gemm g{(const bf16_t*)(C.ws + WS_H), (const bf16_t*)(C.ws + WS_E1), MAXROWS, 64 * 512, 1024}; OrderList S{m1}; (void)nblk;
          EpiMoe1 E{(bf16_t*)(C.ws + WS_HID)};
          pg8::gemm_phase<EpiMoe1, OrderList, false, true>(stage, g, S, E, nullptr, rowl); }
#endif
        xcd_barrier(bar); PROBE_MARK(9);
#ifndef NO_MOE2
        { const int nblk = (int)MISCW(C)[5];
          pg8::Gemm g{(const bf16_t*)(C.ws + WS_HID), (const bf16_t*)(C.ws + WS_E2), MAXROWS, 64 * 1024, 256}; OrderList S{(const LAS int*)(C.lds + MISC_OFF + 2048) + 64}; (void)nblk;
          EpiMoe2 E{(bf16_t*)(C.ws + WS_Y)};
          pg8::gemm_phase<EpiMoe2, OrderList, false>(stage, g, S, E, nullptr); }
#endif
        xcd_barrier(bar); PROBE_MARK(10);
    }
#ifndef NO_FIN
    phase_rows<1, true, false>(C, DEPTH);
#endif
    PROBE_MARK(11);
    PROBE_FINISH();
}

extern "C" void kernel_launch(void* const* d_in, const int* in_sizes, int n_in, void* d_out, int out_size, void* d_ws, size_t ws_size, hipStream_t stream) {
    static int grid = 0;
    if (grid == 0) {
        if (n_in != 25 || out_size != T * DM || ws_size < WS_END) { fprintf(stderr, "kernel_launch: unexpected sizes (n_in %d out %d ws %zu need %zu)\n", n_in, out_size, ws_size, (size_t)WS_END); grid = -1; return; }
        int dev = 0, cus = 0, per_cu = 0;
        if (hipGetDevice(&dev) != hipSuccess || hipDeviceGetAttribute(&cus, hipDeviceAttributeMultiprocessorCount, dev) != hipSuccess) { grid = -1; return; }
        if (hipFuncSetAttribute((const void*)mega_fwd, hipFuncAttributeMaxDynamicSharedMemorySize, LDS_BYTES) != hipSuccess) { fprintf(stderr, "kernel_launch: hipFuncSetAttribute failed\n"); grid = -1; return; }
        if (hipOccupancyMaxActiveBlocksPerMultiprocessor(&per_cu, (const void*)mega_fwd, NTHR, LDS_BYTES) != hipSuccess || per_cu < 1) { fprintf(stderr, "kernel_launch: occupancy query says %d\n", per_cu); (void)hipGetLastError(); grid = -1; return; }
        grid = cus;
    }
    if (grid < 0) return;
    if (hipMemsetAsync((char*)d_ws + WS_CTL, 0, CTL_ZERO_BYTES, stream) != hipSuccess) return;
    Args a{};
    for (int i = 0; i < 25; ++i) a.in[i] = (const float*)d_in[i];
    a.out = (float*)d_out; a.ws = (unsigned char*)d_ws;
    hipLaunchKernelGGL(mega_fwd, dim3(grid), dim3(NTHR), LDS_BYTES, stream, a);
}
```

```cpp
#include <hip/hip_runtime.h>
#include <hip/hip_bf16.h>
#include <cstdio>
#include <cstdint>
namespace pg8 {
#define PG8_LAS __attribute__((address_space(3)))
typedef unsigned short bf16_t;
typedef short bf16x8 __attribute__((ext_vector_type(8)));
typedef float f32x4 __attribute__((ext_vector_type(4)));
typedef unsigned u32x4 __attribute__((ext_vector_type(4)));
constexpr int BM = 256, BK = 64, HALF = 128, HTB = HALF * BK * 2  , STAGE_BYTES = 8 * HTB, NXCD = 8, WGM = 8;

__host__ __device__ __forceinline__ int lds_byte(int r, int c) { const int st = (r >> 4) * 2 + (c >> 5), rr = r & 15, cc = c & 31, ob = rr * 64 + cc * 2; return st * 1024 + (ob ^ (((ob >> 9) & 1) << 5)); }
__host__ __device__ __forceinline__ void stage_rc(int b, int& R, int& C) { const int st = b / 1024, sb = b % 1024, swz = sb ^ (((sb >> 9) & 1) << 5); R = (st >> 1) * 16 + swz / 64; C = (st & 1) * 32 + (swz % 64) / 2; }
__host__ __device__ __forceinline__ int perm32(int rho) { const int n = rho >> 4, i = rho & 15; return 8 * (i >> 2) + 4 * n + (i & 3); }

struct Unit { int pm, pn; };
struct Gemm { const bf16_t* A; const bf16_t* Bt; int M, N, K; };

struct StaticOrder {
    int nM, nN, nwg, G, c;
    __host__ __device__ void init(int M, int N, int G_, int c_) { nM = M / BM; nN = N / BM; nwg = nM * nN; G = G_; c = c_; }
    __host__ __device__ bool next(int i, Unit& u) const {
        const long L = (long)i * G + c; if (L >= nwg) return false;
        int wgid = (int)L; { const int q = nwg / NXCD, r = nwg % NXCD, xcd = wgid % NXCD, off = wgid / NXCD; wgid = (xcd < r ? xcd * (q + 1) : r * (q + 1) + (xcd - r) * q) + off; }
        const int nig = WGM * nN, gid = wgid / nig, fm = gid * WGM, gsz = (nM - fm) < WGM ? (nM - fm) : WGM;
        u.pm = fm + ((wgid % nig) % gsz); u.pn = (wgid % nig) / gsz; return true;
    }
    __device__ __forceinline__ void a_ready(const Unit&) const {}
    __device__ __forceinline__ void done(const Unit&) const {}
};
__device__ __forceinline__ unsigned cvt_pk_bf16(float lo, float hi) { unsigned r; asm volatile("v_cvt_pk_bf16_f32 %0, %1, %2" : "=v"(r) : "v"(lo), "v"(hi)); return r; }
template <int ACT  > struct EpiBf16 {
    static constexpr bool PERM = true, AFTER_DRAIN = false;
    bf16_t* O; int ldc; const float* bias; int split_cols; size_t split_stride;
    __device__ __forceinline__ void operator()(const f32x4 (&acc)[2][2][4][2], const Unit& u, int wr, int wc, int fr, int fq) const {
        const int row0 = u.pm * BM + wr * 64 + fr; int colt = u.pn * BM; bf16_t* base = O;
        if (split_cols) { const int t = colt / split_cols; base += (size_t)t * split_stride; colt -= t * split_cols; }
        const int col0 = colt + wc * 32 + 8 * fq, bcol0 = u.pn * BM + wc * 32 + 8 * fq;
        f32x4 bv[2][2];
#pragma unroll
        for (int bj = 0; bj < 2; ++bj)
#pragma unroll
            for (int n = 0; n < 2; ++n) bv[bj][n] = bias ? *(const f32x4*)(bias + bcol0 + bj * HALF + 4 * n) : (f32x4){0.f, 0.f, 0.f, 0.f};
#pragma unroll
        for (int ai = 0; ai < 2; ++ai)
#pragma unroll
            for (int m = 0; m < 4; ++m) { bf16_t* rowp = base + (size_t)(row0 + ai * HALF + m * 16) * ldc + col0;
#pragma unroll
                for (int bj = 0; bj < 2; ++bj) { f32x4 v0 = acc[ai][bj][m][0] + bv[bj][0], v1 = acc[ai][bj][m][1] + bv[bj][1];
                    u32x4 w; w.x = cvt_pk_bf16(v0[0], v0[1]); w.y = cvt_pk_bf16(v0[2], v0[3]); w.z = cvt_pk_bf16(v1[0], v1[1]); w.w = cvt_pk_bf16(v1[2], v1[3]);
                    *(u32x4*)(rowp + bj * HALF) = w; } }
    }
};

template <class Epi, class Sched, bool STAMP = false, bool GATHER = false>
__device__ __forceinline__ void gemm_phase(PG8_LAS unsigned char* lds, const Gemm g, const Sched& S, const Epi& E, unsigned long long* stamps, const PG8_LAS int* rowl = nullptr) {
    int tid_ = threadIdx.x; asm volatile("" : "+v"(tid_));
    const int tid = tid_, wid = __builtin_amdgcn_readfirstlane(tid >> 6), lane = tid & 63, wr = wid >> 2, wc = wid & 3, fr = lane & 15, fq = lane >> 4;
    const int K = g.K, nt = K / BK;
    int ts_lo = 0, ts_hi = 0, nts = 0; const unsigned long long rt_entry = STAMP ? (unsigned long long)wall_clock64() : 0ull;
#define PG8_STAMP() do { if (STAMP && wid == 0 && nts < 64) { const unsigned long long _c = (unsigned long long)clock64(); \
        ts_lo = (lane == nts) ? (int)(unsigned)_c : ts_lo; ts_hi = (lane == nts) ? (int)(unsigned)(_c >> 32) : ts_hi; ++nts; } } while (0)
    PG8_STAMP();
    unsigned voffA[2], voffB[2];
#pragma unroll
    for (int i = 0; i < 2; ++i) { int R, C; stage_rc(tid * 16 + i * 8192, R, C); const int Rb = Epi::PERM ? ((R & ~31) + perm32(R & 31)) : R;
        voffA[i] = (unsigned)(R * K + C) * 2u; voffB[i] = (unsigned)(Rb * K + C) * 2u; }
    unsigned vA0[2], vA1[2], nA0[2], nA1[2];
#define PG8_GOFF(d0, d1, u_) do { _Pragma("unroll") for (int _i = 0; _i < 2; ++_i) { int R_, C_; stage_rc(tid * 16 + _i * 8192, R_, C_);     \
        (d0)[_i] = (unsigned)rowl[256 * (u_) + R_] * (unsigned)(K * 2) + (unsigned)C_ * 2u; (d1)[_i] = (unsigned)rowl[256 * (u_) + 128 + R_] * (unsigned)(K * 2) + (unsigned)C_ * 2u; } } while (0)
    const size_t kstep = (size_t)(BK * 2);
    const size_t hstep = (size_t)HALF * K * 2;
    const size_t tstep = 2 * hstep;
    const unsigned ldsw = (unsigned)wid * 1024u;
    const int aoff = lds_byte(wr * 64 + fr, fq * 8), boff = lds_byte(wc * 32 + fr, fq * 8);
#define PG8_SA(b, h) (((b) * 2 + (h)) * HTB)
#define PG8_SB(b, h) ((4 + (b) * 2 + (h)) * HTB)
#define PG8_STAGE(bufoff, gbase, voff) do { _Pragma("unroll") for (int _i = 0; _i < 2; ++_i) \
        __builtin_amdgcn_global_load_lds((const unsigned*)((const char*)(gbase) + (voff)[_i]), (PG8_LAS unsigned*)(lds + (bufoff) + ldsw + _i * 8192), 16, 0, 0); } while (0)
#define PG8_LDA(dst, b, h) do { _Pragma("unroll") for (int m = 0; m < 4; ++m) _Pragma("unroll") for (int k = 0; k < 2; ++k) dst[m][k] = *(const PG8_LAS bf16x8*)(lds + PG8_SA(b, h) + aoff + m * 2048 + k * 1024); } while (0)
#define PG8_LDB(dst, b, h) do { _Pragma("unroll") for (int n = 0; n < 2; ++n) _Pragma("unroll") for (int k = 0; k < 2; ++k) dst[n][k] = *(const PG8_LAS bf16x8*)(lds + PG8_SB(b, h) + boff + n * 2048 + k * 1024); } while (0)
#define PG8_MMA(ai, bj, At, Bt) do { __builtin_amdgcn_s_setprio(1); _Pragma("unroll") for (int m = 0; m < 4; ++m) _Pragma("unroll") for (int n = 0; n < 2; ++n) _Pragma("unroll") for (int k = 0; k < 2; ++k) \
        acc[ai][bj][m][n] = __builtin_amdgcn_mfma_f32_16x16x32_bf16(Bt[n][k], At[m][k], acc[ai][bj][m][n], 0, 0, 0); __builtin_amdgcn_s_setprio(0); } while (0)
#define PG8_WAIT_V(n) asm volatile("s_waitcnt vmcnt(" #n ")" ::: "memory")
#define PG8_WAIT_L(n) asm volatile("s_waitcnt lgkmcnt(" #n ")" ::: "memory")
#define PG8_BAR __builtin_amdgcn_s_barrier()
#define PG8_SCHED __builtin_amdgcn_sched_barrier(0)
    Unit cur, nxt; int ui = 0;
    if (!S.next(0, cur)) return;
    f32x4 acc[2][2][4][2];
#pragma unroll
    for (int a = 0; a < 2; ++a)
#pragma unroll
        for (int b = 0; b < 2; ++b)
#pragma unroll
            for (int m = 0; m < 4; ++m)
#pragma unroll
                for (int n = 0; n < 2; ++n) acc[a][b][m][n] = (f32x4){0.f, 0.f, 0.f, 0.f};
    bf16x8 At[4][2], B0[2][2], B1[2][2];
    const char* cA = GATHER ? (const char*)g.A : (const char*)g.A + (size_t)cur.pm * tstep; const char* cB = (const char*)g.Bt + (size_t)cur.pn * tstep;
    if constexpr (GATHER) { PG8_GOFF(vA0, vA1, 0); }
    S.a_ready(cur);
    PG8_STAGE(PG8_SB(0, 0), cB, voffB); if constexpr (GATHER) PG8_STAGE(PG8_SA(0, 0), cA, vA0); else PG8_STAGE(PG8_SA(0, 0), cA, voffA); PG8_STAGE(PG8_SB(0, 1), cB + hstep, voffB); if constexpr (GATHER) PG8_STAGE(PG8_SA(0, 1), cA, vA1); else PG8_STAGE(PG8_SA(0, 1), cA + hstep, voffA);
    if (wr == 1) PG8_BAR;
    PG8_WAIT_V(4); PG8_BAR;
    PG8_STAGE(PG8_SB(1, 0), cB + kstep, voffB); if constexpr (GATHER) PG8_STAGE(PG8_SA(1, 0), cA + kstep, vA0); else PG8_STAGE(PG8_SA(1, 0), cA + kstep, voffA); PG8_STAGE(PG8_SB(1, 1), cB + hstep + kstep, voffB);
    PG8_WAIT_V(6); PG8_BAR;
    PG8_STAMP();
    for (;;) {
        const bool has_next = S.next(ui + 1, nxt);
        const char* nA = GATHER ? cA : (has_next ? (const char*)g.A + (size_t)nxt.pm * tstep : cA); const char* nB = has_next ? (const char*)g.Bt + (size_t)nxt.pn * tstep : cB;
        if constexpr (GATHER) { if (has_next) { PG8_GOFF(nA0, nA1, ui + 1); } else { nA0[0] = vA0[0]; nA0[1] = vA0[1]; nA1[0] = vA1[0]; nA1[1] = vA1[1]; } }
#pragma unroll 1
        for (int t = 0; t < nt; t += 2) {
            const bool last = (t == nt - 2);
            const char* a1 = cA + (size_t)(t + 1) * kstep;
            const char* a2 = last ? nA : cA + (size_t)(t + 2) * kstep; const char* b2 = last ? nB : cB + (size_t)(t + 2) * kstep;
            const char* a3 = a2 + kstep; const char* b3 = b2 + kstep;
            if (last && has_next) S.a_ready(nxt);
            unsigned sA0[2], sA1[2];
            if constexpr (GATHER) { sA0[0] = last ? nA0[0] : vA0[0]; sA0[1] = last ? nA0[1] : vA0[1]; sA1[0] = last ? nA1[0] : vA1[0]; sA1[1] = last ? nA1[1] : vA1[1]; }
            PG8_LDB(B0, 0, 0); PG8_SCHED; PG8_LDA(At, 0, 0); if constexpr (GATHER) PG8_STAGE(PG8_SA(1, 1), a1, vA1); else PG8_STAGE(PG8_SA(1, 1), a1 + hstep, voffA);
            PG8_WAIT_L(8); PG8_BAR; PG8_WAIT_L(0); PG8_MMA(0, 0, At, B0); PG8_BAR; PG8_SCHED;
            PG8_LDB(B1, 0, 1); PG8_STAGE(PG8_SB(0, 0), b2, voffB);
            PG8_BAR; PG8_WAIT_L(0); PG8_MMA(0, 1, At, B1); PG8_BAR;
            PG8_LDA(At, 0, 1); if constexpr (GATHER) PG8_STAGE(PG8_SA(0, 0), a2, sA0); else PG8_STAGE(PG8_SA(0, 0), a2, voffA);
            PG8_BAR; PG8_WAIT_L(0); PG8_MMA(1, 0, At, B0); PG8_BAR; PG8_SCHED;
            PG8_STAGE(PG8_SB(0, 1), b2 + hstep, voffB);
            PG8_WAIT_V(6); PG8_BAR; PG8_MMA(1, 1, At, B1); PG8_BAR;
            PG8_LDB(B0, 1, 0); PG8_SCHED; PG8_LDA(At, 1, 0); if constexpr (GATHER) PG8_STAGE(PG8_SA(0, 1), a2, sA1); else PG8_STAGE(PG8_SA(0, 1), a2 + hstep, voffA);
            PG8_WAIT_L(8); PG8_BAR; PG8_WAIT_L(0); PG8_MMA(0, 0, At, B0); PG8_BAR; PG8_SCHED;
            PG8_LDB(B1, 1, 1); PG8_STAGE(PG8_SB(1, 0), b3, voffB);
            PG8_BAR; PG8_WAIT_L(0); PG8_MMA(0, 1, At, B1); PG8_BAR;
            PG8_LDA(At, 1, 1); if constexpr (GATHER) PG8_STAGE(PG8_SA(1, 0), a3, sA0); else PG8_STAGE(PG8_SA(1, 0), a3, voffA);
            PG8_BAR; PG8_WAIT_L(0); PG8_MMA(1, 0, At, B0); PG8_BAR; PG8_SCHED;
            PG8_STAGE(PG8_SB(1, 1), b3 + hstep, voffB);
            PG8_WAIT_V(6); PG8_BAR; PG8_MMA(1, 1, At, B1); PG8_BAR;
        }
        PG8_STAMP();
        if constexpr (!Epi::AFTER_DRAIN) { E(acc, cur, wr, wc, fr, fq); S.done(cur); }
        PG8_STAMP();
        if (!has_next) break;
#pragma unroll
        for (int a = 0; a < 2; ++a)
#pragma unroll
            for (int b = 0; b < 2; ++b)
#pragma unroll
                for (int m = 0; m < 4; ++m)
#pragma unroll
                    for (int n = 0; n < 2; ++n) acc[a][b][m][n] = (f32x4){0.f, 0.f, 0.f, 0.f};
        cur = nxt; cA = nA; cB = nB; ++ui;
        if constexpr (GATHER) { vA0[0] = nA0[0]; vA0[1] = nA0[1]; vA1[0] = nA1[0]; vA1[1] = nA1[1]; }
    }
    PG8_WAIT_V(0);
    if (wr == 0) PG8_BAR;
    PG8_BAR;
    if constexpr (Epi::AFTER_DRAIN) { E.fused(acc, cur, wr, wc, fr, fq, lds, wid, lane); S.done(cur); }
    PG8_STAMP();
    if (STAMP && wid == 0) { stamps[lane] = lane < nts ? (((unsigned long long)(unsigned)ts_hi << 32) | (unsigned)ts_lo) : 0ull;
        if (lane == 62) stamps[62] = rt_entry; if (lane == 63) stamps[63] = (unsigned long long)wall_clock64(); }
#undef PG8_STAMP
#undef PG8_SA
#undef PG8_SB
#undef PG8_STAGE
#undef PG8_GOFF
#undef PG8_LDA
#undef PG8_LDB
#undef PG8_MMA
#undef PG8_WAIT_V
#undef PG8_WAIT_L
#undef PG8_BAR
#undef PG8_SCHED
}
}

namespace attn_body {
using bf16=__hip_bfloat16;
using bf16x8=__attribute__((ext_vector_type(8)))short;
using s16x4=__attribute__((ext_vector_type(4)))short;
using f32x16=__attribute__((ext_vector_type(16)))float;
using u32x4=__attribute__((ext_vector_type(4)))unsigned;
constexpr int D=64;
constexpr int NW=8,QBLK=32,QB=QBLK*NW,KVBLK=64;
__device__ __forceinline__ int crow(int r,int hi){return (r&3)+8*(r>>2)+4*hi;}
#define SBAR() __builtin_amdgcn_sched_barrier(0)
__device__ __forceinline__ void cmask(f32x16&p0,f32x16&p1,int jb,int qrel,int hi){
  const float NEG=-INFINITY; int kb=64*jb+4*hi;
  #pragma unroll
  for(int r=0;r<16;++r){int kv=kb+(r&3)+8*(r>>2); if(kv>qrel)p0[r]=NEG; if(kv+32>qrel)p1[r]=NEG;}
}

constexpr int NSLOT=3, SLOTB=8192;
constexpr int LDS_K=0, LDS_V=NSLOT*SLOTB, LDS_WS=2*NSLOT*SLOTB, LDS_OST=LDS_WS+NW*64*4, LDS_BYTES=LDS_OST+NW*4096;
constexpr float C2=0.125f*1.4426950408889634f;
__device__ __forceinline__ void glds16(const void*gsrc,unsigned lds_dst){unsigned keep;
  asm volatile("s_mov_b32 %0, m0\n\ts_mov_b32 m0, %2\n\ts_nop 0\n\tglobal_load_lds_dwordx4 %1, off\n\ts_mov_b32 m0, %0":"=&s"(keep):"v"(gsrc),"s"(lds_dst):"memory");}
__device__ __forceinline__ float max3f(float a,float b,float c){float r;asm("v_max3_f32 %0, %1, %2, %3":"=v"(r):"v"(a),"v"(b),"v"(c));return r;}
__device__ __forceinline__ float max2f(float a,float b){float r;asm("v_max_f32_e32 %0, %1, %2":"=v"(r):"v"(a),"v"(b));return r;}
__device__ __forceinline__ float fadd_s(float a,float b){float r;asm("v_add_f32_e32 %0, %1, %2":"=v"(r):"v"(a),"v"(b));return r;}
__device__ __forceinline__ float fsub_s(float a,float b){float r;asm("v_sub_f32_e32 %0, %1, %2":"=v"(r):"v"(a),"v"(b));return r;}
typedef float f32x2_t __attribute__((ext_vector_type(2))); typedef __bf16 bf16x2_t __attribute__((ext_vector_type(2)));
__device__ __forceinline__ unsigned cvtpk_s(float lo,float hi){f32x2_t v={lo,hi};bf16x2_t b=__builtin_convertvector(v,bf16x2_t);return __builtin_bit_cast(unsigned,b);}
#define WAIT_BAR(N) asm volatile("s_waitcnt vmcnt(" #N ") lgkmcnt(0)\n\ts_barrier":::"memory")

__device__ __forceinline__ void qkt(f32x16&p0,f32x16&p1,const char*Kslot,const bf16x8*qr,const f32x16&negm,int r32,int hi){
  const char*kb=Kslot+hi*1024+r32*16;
  #pragma unroll
  for(int d0=0;d0<4;++d0){
    const bf16x8 b0=*reinterpret_cast<const bf16x8*>(kb+d0*2048);
    const bf16x8 b1=*reinterpret_cast<const bf16x8*>(kb+d0*2048+512);
    if(d0==0){p0=__builtin_amdgcn_mfma_f32_32x32x16_bf16(b0,qr[0],negm,0,0,0);p1=__builtin_amdgcn_mfma_f32_32x32x16_bf16(b1,qr[0],negm,0,0,0);}
    else{p0=__builtin_amdgcn_mfma_f32_32x32x16_bf16(b0,qr[d0],p0,0,0,0);p1=__builtin_amdgcn_mfma_f32_32x32x16_bf16(b1,qr[d0],p1,0,0,0);}}
}
typedef __attribute__((address_space(3))) const char* lds_cptr;
typedef short v4i16_t __attribute__((ext_vector_type(4)));
__device__ __forceinline__ void kload8(bf16x8*kf,lds_cptr kp){
  kf[0]=*(const __attribute__((address_space(3))) bf16x8*)(kp);      kf[1]=*(const __attribute__((address_space(3))) bf16x8*)(kp+512);
  kf[2]=*(const __attribute__((address_space(3))) bf16x8*)(kp+2048); kf[3]=*(const __attribute__((address_space(3))) bf16x8*)(kp+2560);
  kf[4]=*(const __attribute__((address_space(3))) bf16x8*)(kp+4096); kf[5]=*(const __attribute__((address_space(3))) bf16x8*)(kp+4608);
  kf[6]=*(const __attribute__((address_space(3))) bf16x8*)(kp+6144); kf[7]=*(const __attribute__((address_space(3))) bf16x8*)(kp+6656);
}
__device__ __forceinline__ void kload2(bf16x8*kf,lds_cptr kp,int j){ kf[2*j]=*(const __attribute__((address_space(3))) bf16x8*)(kp+j*2048); kf[2*j+1]=*(const __attribute__((address_space(3))) bf16x8*)(kp+j*2048+512); }
__device__ __forceinline__ s16x4 vtr(lds_cptr p){ return __builtin_bit_cast(s16x4,__builtin_amdgcn_ds_read_tr16_b64_v4i16((__attribute__((address_space(3))) v4i16_t*)p)); }
__device__ __forceinline__ float rowmax(const f32x16&p0,const f32x16&p1){
  float a=max3f(p0[0],p0[1],p1[0]),b=max3f(p0[2],p0[3],p1[1]);a=max3f(a,p1[2],p1[3]);
  #pragma unroll
  for(int r=4;r<16;r+=4){a=max3f(a,p0[r],p0[r+1]);b=max3f(b,p0[r+2],p0[r+3]);a=max3f(a,p1[r],p1[r+1]);b=max3f(b,p1[r+2],p1[r+3]);}
  const float m=max2f(a,b);
  auto rr=__builtin_amdgcn_permlane32_swap(__float_as_uint(m),__float_as_uint(m),false,false);
  return max2f(__uint_as_float(rr[0]),__uint_as_float(rr[1]));
}
__device__ __forceinline__ void pv(f32x16*o,int vb,bf16x8 pa0,bf16x8 pa1,bf16x8 pa2,bf16x8 pa3){
  #pragma unroll
  for(int d0=0;d0<2;++d0){s16x4 lo[4],hi[4];
    #pragma unroll
    for(int ks=0;ks<4;++ks){
      asm volatile("ds_read_b64_tr_b16 %0,%1 offset:%c2":"=&v"(lo[ks]):"v"(vb),"i"(d0*4096+ks*1024):"memory");
      asm volatile("ds_read_b64_tr_b16 %0,%1 offset:%c2":"=&v"(hi[ks]):"v"(vb),"i"(d0*4096+ks*1024+512):"memory");}
    asm volatile("s_waitcnt lgkmcnt(0)":::"memory");SBAR();
    #define PK(k) (bf16x8){lo[k][0],lo[k][1],lo[k][2],lo[k][3],hi[k][0],hi[k][1],hi[k][2],hi[k][3]}
    o[d0]=__builtin_amdgcn_mfma_f32_32x32x16_bf16(pa0,PK(0),o[d0],0,0,0);
    o[d0]=__builtin_amdgcn_mfma_f32_32x32x16_bf16(pa1,PK(1),o[d0],0,0,0);
    o[d0]=__builtin_amdgcn_mfma_f32_32x32x16_bf16(pa2,PK(2),o[d0],0,0,0);
    o[d0]=__builtin_amdgcn_mfma_f32_32x32x16_bf16(pa3,PK(3),o[d0],0,0,0);
    #undef PK
  }
}

#ifndef ATTN_STORE16
#define ATTN_STORE16(p,v) (*(u32x4*)(p)=(v))
#endif
template<int THRL,int PQ,int PO> __device__ __forceinline__ void attn_unit(int qb,const bf16*Qh,const bf16*__restrict__ Kh,const bf16*__restrict__ Vh,bf16*Oh,char*shm){
  int tid_=threadIdx.x; asm volatile("":"+v"(tid_)); const int tid=tid_,lane=tid&63,r32=lane&31,hi=lane>>5; const int wid=__builtin_amdgcn_readfirstlane(tid>>6);
  const int q0=qb*QB;
  const bf16*Qw=Qh+(long)(q0+wid*QBLK)*PQ;
  const unsigned lds0=(unsigned)(uintptr_t)shm;
  float*wsf=(float*)(shm+LDS_WS)+wid*64;
  const bf16*ksrc=Kh+(long)lane*PQ+wid*8;
  const bf16*vsrc=Vh+(long)(16*(wid&3)+(lane>>2))*PQ+(wid>>2)*32+(lane&3)*8;
  const unsigned kdst=lds0+LDS_K+wid*1024, vdst=lds0+LDS_V+wid*1024;
  #define DMA_K(t,slot) glds16(ksrc+(long)(t)*KVBLK*PQ,(unsigned)__builtin_amdgcn_readfirstlane(kdst+(slot)))
  #define DMA_V(t,slot) glds16(vsrc+(long)(t)*KVBLK*PQ,(unsigned)__builtin_amdgcn_readfirstlane(vdst+(slot)))
  const int vb0=(int)(lds0+LDS_V)+((lane>>4)&1)*32+(lane&3)*8+(4*hi+((lane&15)>>2))*64;
  const char*Kbase=shm+LDS_K; bf16x8 kf[8];
  const lds_cptr shm3=(lds_cptr)shm; const lds_cptr kp0=shm3+LDS_K+hi*1024+r32*16; const lds_cptr vp0=shm3+LDS_V+((lane>>4)&1)*32+(lane&3)*8+(4*hi+((lane&15)>>2))*64;
  const int NT=(q0+QB)/KVBLK;
  DMA_K(0,0);DMA_V(0,0);DMA_K(1,SLOTB);
  bf16x8 qr[4];
  #pragma unroll
  for(int d0=0;d0<4;++d0)qr[d0]=*reinterpret_cast<const bf16x8*>(&Qw[(long)r32*PQ+d0*16+hi*8]);
  float mhat=0.f,l_reg=0.f;f32x16 o[2];o[0]=f32x16{};o[1]=f32x16{};f32x16 negm=f32x16{};asm volatile("":"+v"(negm));
  const int qrel=wid*QBLK+r32;
  #define CMASK(P0,P1,t) do{int jb_=(t)-(NT-4); if(jb_>=0)cmask(P0,P1,jb_,qrel,hi);}while(0)
  bool resc=false;
  #define START(P0,P1) do{ const float rm=rowmax(P0,P1); resc=false; \
    { const float dl=rm; mhat=fadd_s(mhat,dl); \
      _Pragma("unroll") for(int r=0;r<16;++r){P0[r]=fsub_s(P0[r],dl);P1[r]=fsub_s(P1[r],dl);} \
      _Pragma("unroll") for(int r=0;r<16;++r)negm[r]=-mhat; asm volatile("":"+v"(negm)); } \
    _Pragma("unroll") for(int r=0;r<16;++r)P0[r]=__builtin_amdgcn_exp2f(P0[r]); }while(0)
  #define RESC() do{ if(resc){ asm volatile("s_waitcnt lgkmcnt(0)":::"memory"); \
      _Pragma("unroll") for(int d_=0;d_<2;++d_) _Pragma("unroll") for(int r=0;r<16;++r)o[d_][r]*=wsf[crow(r,hi)]; } }while(0)
  f32x16 pA0,pA1,pB0,pB1;
  int sl_prev=0,sl_cur=0,sl_next=SLOTB;
  #define ROT() do{sl_prev=sl_cur;sl_cur=sl_next;sl_next=(sl_next==(NSLOT-1)*SLOTB)?0:sl_next+SLOTB;}while(0)
  DMA_K(2,2*SLOTB);
  WAIT_BAR(3);
  qkt(pA0,pA1,Kbase,qr,negm,r32,hi);asm volatile("s_nop 15\n\ts_nop 7":"+v"(pA0),"+v"(pA1));CMASK(pA0,pA1,0);
  START(pA0,pA1);
  _Pragma("unroll") for(int r=0;r<16;++r)pA1[r]=__builtin_amdgcn_exp2f(pA1[r]);
  WAIT_BAR(0);
  DMA_K(3,0);DMA_V(1,SLOTB);
  ROT();
  kload8(kf,kp0+sl_cur);
  WAIT_BAR(2);
  s16x4 vlo[8],vhi[8]; u32x4 pw0,pw1,pw2,pw3;
  #define PKW(P,B) cvtpk_s(P[B],P[B+1])
  #define PAF(k) __builtin_bit_cast(bf16x8,pw##k)
  #define VFR(i) (bf16x8){vlo[i][0],vlo[i][1],vlo[i][2],vlo[i][3],vhi[i][0],vhi[i][1],vhi[i][2],vhi[i][3]}
  #define PIN(x) asm volatile("":"+v"(x))
  #define MX3(a,b,c) __builtin_fmaxf(__builtin_fmaxf((a),(b)),(c))
  #define GAPA(MF,A0,A1,A2,A3,W0,W1,PW) do{ MF; sacc+=A0; sacc+=A1; sacc+=A2; sacc+=A3; PIN(sacc); W0; W1; PIN(PW); SBAR(); }while(0)
  #define EX(v) __builtin_amdgcn_exp2f(v)
  #define GAPB(MF,X,B) do{ MF; X[B]=EX(X[B]); X[B+1]=EX(X[B+1]); X[B+2]=EX(X[B+2]); X[B+3]=EX(X[B+3]); PIN(X); SBAR(); }while(0)
  #define VRD(i) do{ vlo[i]=vtr(vp_+(((i)>>2)*4096+((i)&3)*1024)); vhi[i]=vtr(vp_+(((i)>>2)*4096+((i)&3)*1024+512)); }while(0)
  #define KRD(G,j) do{ if(G){ kload2(kf,kp0+sl_next,j); SBAR(); } }while(0)
  #define STEP(C0,C1,P0,P1,t,GK,GV,GL) do{ SBAR(); \
    const lds_cptr vp_=vp0+sl_prev; \
    VRD(0); SBAR(); float sacc=(P0[0]+P0[1]); \
    GAPA(C0=__builtin_amdgcn_mfma_f32_32x32x16_bf16(kf[0],qr[0],negm,0,0,0), P0[2],P0[3],P0[4],P0[5],     pw0[0]=PKW(P0,0), pw0[1]=PKW(P0,2), pw0); \
    VRD(4); SBAR(); GAPA(C1=__builtin_amdgcn_mfma_f32_32x32x16_bf16(kf[1],qr[0],negm,0,0,0), P0[6],P0[7],P0[8],P0[9],     pw0[2]=PKW(P0,4), pw0[3]=PKW(P0,6), pw0); \
    VRD(1); SBAR(); GAPA(C0=__builtin_amdgcn_mfma_f32_32x32x16_bf16(kf[2],qr[1],C0,0,0,0),   P0[10],P0[11],P0[12],P0[13], pw1[0]=PKW(P0,8), pw1[1]=PKW(P0,10), pw1); \
    VRD(5); SBAR(); GAPA(C1=__builtin_amdgcn_mfma_f32_32x32x16_bf16(kf[3],qr[1],C1,0,0,0),   P0[14],P0[15],P1[0],P1[1],   pw1[2]=PKW(P0,12),pw1[3]=PKW(P0,14), pw1); \
    VRD(2); SBAR(); GAPA(C0=__builtin_amdgcn_mfma_f32_32x32x16_bf16(kf[4],qr[2],C0,0,0,0),   P1[2],P1[3],P1[4],P1[5],     pw2[0]=PKW(P1,0), pw2[1]=PKW(P1,2), pw2); \
    VRD(6); SBAR(); GAPA(C1=__builtin_amdgcn_mfma_f32_32x32x16_bf16(kf[5],qr[2],C1,0,0,0),   P1[6],P1[7],P1[8],P1[9],     pw2[2]=PKW(P1,4), pw2[3]=PKW(P1,6), pw2); \
    VRD(3); SBAR(); GAPA(C0=__builtin_amdgcn_mfma_f32_32x32x16_bf16(kf[6],qr[3],C0,0,0,0),   P1[10],P1[11],P1[12],P1[13], pw3[0]=PKW(P1,8), pw3[1]=PKW(P1,10), pw3); \
    VRD(7); SBAR(); GAPA(C1=__builtin_amdgcn_mfma_f32_32x32x16_bf16(kf[7],qr[3],C1,0,0,0),   P1[14],P1[15],0.f,0.f,       pw3[2]=PKW(P1,12),pw3[3]=PKW(P1,14), pw3); \
    l_reg+=sacc; \
    if(GK){DMA_K((t)+3,sl_cur);} if(GV){DMA_V((t)+1,sl_next);} \
    CMASK(C0,C1,t); \
    { float a=MX3(C0[0],C0[1],C1[0]),b=MX3(C0[2],C0[3],C1[1]); a=MX3(a,C1[2],C1[3]); \
      _Pragma("unroll") for(int r=4;r<16;r+=4){a=MX3(a,C0[r],C0[r+1]);b=MX3(b,C0[r+2],C0[r+3]);a=MX3(a,C1[r],C1[r+1]);b=MX3(b,C1[r+2],C1[r+3]);} \
      float rm=__builtin_fmaxf(a,b); { auto rr=__builtin_amdgcn_permlane32_swap(__float_as_uint(rm),__float_as_uint(rm),false,false); rm=__builtin_fmaxf(__uint_as_float(rr[0]),__uint_as_float(rr[1])); } \
      resc=false; \
      if(__builtin_expect(__any(rm>(float)THRL),0)){ const float dl=__builtin_fmaxf(rm,0.f); mhat+=dl; \
        _Pragma("unroll") for(int r=0;r<16;++r){C0[r]-=dl;C1[r]-=dl;} \
        _Pragma("unroll") for(int r=0;r<16;++r)negm[r]=-mhat; asm volatile("":"+v"(negm)); \
        const float f=__builtin_amdgcn_exp2f(-dl); l_reg*=f; if(hi==0)wsf[r32]=f; resc=true; } } \
    SBAR(); \
    GAPB(o[0]=__builtin_amdgcn_mfma_f32_32x32x16_bf16(PAF(0),VFR(0),o[0],0,0,0), C0,0); \
    GAPB(o[1]=__builtin_amdgcn_mfma_f32_32x32x16_bf16(PAF(0),VFR(4),o[1],0,0,0), C0,4); \
    KRD(GL,0); GAPB(o[0]=__builtin_amdgcn_mfma_f32_32x32x16_bf16(PAF(1),VFR(1),o[0],0,0,0), C0,8); \
    KRD(GL,1); GAPB(o[1]=__builtin_amdgcn_mfma_f32_32x32x16_bf16(PAF(1),VFR(5),o[1],0,0,0), C0,12); \
    KRD(GL,2); GAPB(o[0]=__builtin_amdgcn_mfma_f32_32x32x16_bf16(PAF(2),VFR(2),o[0],0,0,0), C1,0); \
    KRD(GL,3); GAPB(o[1]=__builtin_amdgcn_mfma_f32_32x32x16_bf16(PAF(2),VFR(6),o[1],0,0,0), C1,4); \
    GAPB(o[0]=__builtin_amdgcn_mfma_f32_32x32x16_bf16(PAF(3),VFR(3),o[0],0,0,0), C1,8); \
    GAPB(o[1]=__builtin_amdgcn_mfma_f32_32x32x16_bf16(PAF(3),VFR(7),o[1],0,0,0), C1,12); \
    }while(0)
  int t=1;
  #undef CMASK
  #define CMASK(P0,P1,t) do{}while(0)
  for(;t+5<NT;t+=2){
    STEP(pB0,pB1,pA0,pA1,t,true,true,true);     WAIT_BAR(2); RESC(); ROT();
    STEP(pA0,pA1,pB0,pB1,t+1,true,true,true);   WAIT_BAR(2); RESC(); ROT();
  }
  #undef CMASK
  #define CMASK(P0,P1,t) do{int jb_=(t)-(NT-4); if(jb_>=0)cmask(P0,P1,jb_,qrel,hi);}while(0)
  #define ENDW(tt) do{ if((tt)+3<NT){WAIT_BAR(2);} else if((tt)+2<NT){WAIT_BAR(1);} else {WAIT_BAR(0);} }while(0)
  for(;t+1<NT;t+=2){
    STEP(pB0,pB1,pA0,pA1,t,(t+3<NT),(t+1<NT),(t+1<NT));       ENDW(t);   RESC(); ROT();
    STEP(pA0,pA1,pB0,pB1,t+1,(t+4<NT),(t+2<NT),(t+2<NT));     ENDW(t+1); RESC(); ROT();
  }
  STEP(pB0,pB1,pA0,pA1,NT-1,false,false,false); RESC();
  { float sacc=pB0[0]+pB0[1]; _Pragma("unroll") for(int r=2;r<16;++r)sacc+=pB0[r]; _Pragma("unroll") for(int r=0;r<16;++r)sacc+=pB1[r]; l_reg+=sacc;
    pw0=(u32x4){PKW(pB0,0),PKW(pB0,2),PKW(pB0,4),PKW(pB0,6)};pw1=(u32x4){PKW(pB0,8),PKW(pB0,10),PKW(pB0,12),PKW(pB0,14)};pw2=(u32x4){PKW(pB1,0),PKW(pB1,2),PKW(pB1,4),PKW(pB1,6)};pw3=(u32x4){PKW(pB1,8),PKW(pB1,10),PKW(pB1,12),PKW(pB1,14)};
    SBAR(); pv(o,vb0+sl_cur,PAF(0),PAF(1),PAF(2),PAF(3)); }
  #undef PKW
  #undef PAF
  #undef VFR
  #undef PIN
  #undef MX3
  #undef GAPA
  #undef GAPB
  #undef EX
  #undef VRD
  #undef KRD
  #undef STEP
  #undef ENDW
  {auto rr=__builtin_amdgcn_permlane32_swap(__float_as_uint(l_reg),__float_as_uint(l_reg),false,false);l_reg=__uint_as_float(rr[0])+__uint_as_float(rr[1]);}
  if(hi==0)wsf[32+r32]=l_reg;asm volatile("s_waitcnt lgkmcnt(0)":::"memory");
  float rli[16];
  #pragma unroll
  for(int r=0;r<16;++r)rli[r]=__builtin_amdgcn_rcpf(wsf[32+crow(r,hi)]);
  bf16*Ow=Oh+(long)(q0+wid*QBLK)*PO;
  { bf16*stg=(bf16*)(shm+LDS_OST)+wid*2048;
    #pragma unroll
    for(int r=0;r<16;++r){const int orow=crow(r,hi);
      #pragma unroll
      for(int d0=0;d0<2;++d0)stg[orow*64+d0*32+r32]=__float2bfloat16(o[d0][r]*rli[r]);}
    asm volatile("s_waitcnt lgkmcnt(0)":::"memory");
    #pragma unroll
    for(int i=0;i<4;++i){const int row=i*8+(lane>>3),ch=lane&7; const u32x4 v=*(const u32x4*)(stg+row*64+ch*8); ATTN_STORE16(Ow+(long)row*PO+ch*8,v);} }
  asm volatile("s_waitcnt lgkmcnt(0)\n\ts_barrier":::"memory");
  #undef DMA_K
  #undef DMA_V
  #undef CMASK
  #undef START
  #undef RESC
  #undef ROT
}
constexpr int ATTN_LDS_BYTES=LDS_BYTES;
#undef SBAR
#undef WAIT_BAR
}

#define XB_TMO      128
#define XB_XCNT(j)  (256  + 64 * (j))
#define XB_XSUB(j)  (1280 + 64 * (j))
#define XB_XGEN(j)  (2304 + 64 * (j))
#define XB_TOP      3328
#define XB_TOPGEN   3392
#define XCD_BAR_WORDS 3456
#define XB_SPIN_CAP (1u << 22)
#define LAS __attribute__((address_space(3)))

__device__ __forceinline__ unsigned xb_ld(unsigned* p)              { return __hip_atomic_load(p, __ATOMIC_RELAXED, __HIP_MEMORY_SCOPE_AGENT); }
__device__ __forceinline__ unsigned xb_add(unsigned* p, unsigned v) { return __hip_atomic_fetch_add(p, v, __ATOMIC_RELAXED, __HIP_MEMORY_SCOPE_AGENT); }
__device__ __forceinline__ unsigned xb_xcc_id() { return (unsigned)__builtin_amdgcn_s_getreg((3 << 11) | 20) & 0xFu; }
#define XB_SPIN(cond, bar) do { unsigned _sp = 0; while (cond) { __builtin_amdgcn_s_sleep(1); \
    if ((++_sp & 255u) == 0u) { if (xb_ld(&(bar)[XB_TMO])) break; if (_sp > XB_SPIN_CAP) { atomicAdd(&(bar)[XB_TMO], 1u); break; } } } } while (0)

struct XcdBarrier {
    unsigned* bar; unsigned x;
    volatile LAS unsigned* st;
};

__device__ __forceinline__ XcdBarrier xcd_barrier_post(unsigned* bar, volatile LAS unsigned* st) {
    XcdBarrier b; b.bar = bar; b.x = xb_xcc_id(); b.st = st;
    if (threadIdx.x == 0) (void)xb_add(&bar[XB_XCNT(b.x)], 1u);
    return b;
}
__device__ __forceinline__ void xcd_barrier_complete(unsigned* bar, unsigned x, unsigned& nloc, unsigned& nx) {
    const unsigned G = gridDim.x * gridDim.y * gridDim.z;
    unsigned sum, cnt, mine, sp = 0u;
    for (;;) {
        sum = 0u; cnt = 0u; mine = 0u;
#pragma unroll
        for (unsigned j = 0; j < 16; ++j) { const unsigned c = xb_ld(&bar[XB_XCNT(j)]); sum += c; cnt += (c > 0u) ? 1u : 0u; mine = (j == x) ? c : mine; }
        if (sum == G) break;
        __builtin_amdgcn_s_sleep(1);
        if ((++sp & 255u) == 0u) { if (xb_ld(&bar[XB_TMO])) break; if (sp > XB_SPIN_CAP) { atomicAdd(&bar[XB_TMO], 1u); break; } }
    }
    nloc = mine > 0u ? mine : 1u; nx = cnt > 0u ? cnt : 1u;
}

__device__ __forceinline__ void xcd_barrier(const XcdBarrier& b) {
    asm volatile("s_waitcnt vmcnt(0)" ::: "memory");
    __syncthreads();
    if (threadIdx.x == 0) {
        unsigned* bar = b.bar; unsigned bx = b.x; asm volatile("" : "+s"(bx));
        __builtin_amdgcn_s_waitcnt(0);
        unsigned nloc = b.st[0], nx = b.st[1];
        if (nloc == 0u) { xcd_barrier_complete(bar, bx, nloc, nx); b.st[0] = nloc; b.st[1] = nx; }
        const unsigned old = xb_add(&bar[XB_XSUB(bx)], 1u);
        const unsigned gen = old / nloc;
        if (old + 1u == (gen + 1u) * nloc) {
            __builtin_amdgcn_fence(__ATOMIC_RELEASE, "agent");
            asm volatile("s_waitcnt vmcnt(0)" ::: "memory");
            const unsigned og = xb_add(&bar[XB_TOP], 1u);
            const unsigned tg = og / nx;
            if (og + 1u == (tg + 1u) * nx) xb_add(&bar[XB_TOPGEN], 1u);
            else XB_SPIN(xb_ld(&bar[XB_TOPGEN]) == tg, bar);
            __builtin_amdgcn_fence(__ATOMIC_ACQUIRE, "agent");
            xb_add(&bar[XB_XGEN(bx)], 1u);
            asm volatile("s_waitcnt vmcnt(0)" ::: "memory");
        } else {
            XB_SPIN(xb_ld(&bar[XB_XGEN(bx)]) == gen, bar);
            __builtin_amdgcn_fence(__ATOMIC_ACQUIRE, "agent");
            asm volatile("s_waitcnt vmcnt(0)" ::: "memory");
        }
    }
    __syncthreads();
}


#define LAS __attribute__((address_space(3)))
typedef unsigned short bf16_t;
typedef float f32x4 __attribute__((ext_vector_type(4)));
typedef unsigned u32x4 __attribute__((ext_vector_type(4)));
typedef unsigned u32x2 __attribute__((ext_vector_type(2)));

constexpr int T = 16384, DM = 1024, SEQ = 4096, NB = 4, DEPTH = 2;
constexpr int PLD = 13568;
constexpr int C_Z = 0, C_X = 512, C_QB = 1280, C_KB = 2816, C_VB = 4352, C_QC = 5888, C_KC = 6400, C_VC = 6912,
              C_QD = 7424, C_FD = 7936, C_ID = 8448, C_GD = 8960, C_GATE = 9472;
constexpr int WIN_LD = 13576;
constexpr float EPS = 1e-6f;
constexpr int NWAVES = 8, NTHR = 512;
constexpr int MAXROWS = 49152;

constexpr size_t MiB = 1u << 20, KiB = 1u << 10;
constexpr size_t WS_CTL = 0, CTL_ZERO_BYTES = 1 * MiB;
constexpr int CW_BAR = 4096;
constexpr int CW_WQ = 8192;
constexpr int CW_ECNT = 9216;
constexpr size_t WS_SSQ = 3 * MiB + 256 * KiB;
constexpr size_t WS_MOD = 1 * MiB;
constexpr size_t WS_DT = 1 * MiB + 256 * KiB;
constexpr size_t WS_RE = 2 * MiB, WS_RS = WS_RE + 128 * KiB, WS_RW = WS_RE + 256 * KiB, WS_POS = WS_RE + 384 * KiB;
constexpr size_t WS_ROWTOK = 3 * MiB + 512 * KiB;
constexpr size_t WS_CNT = 3 * MiB + 256 * KiB;
constexpr size_t WS_LSE = WS_RE + 512 * KiB;
constexpr size_t WS_WIN = 4 * MiB;
constexpr size_t WS_WMG = 31 * MiB;
constexpr size_t WS_WOUT = 35 * MiB;
constexpr size_t WS_H = 38 * MiB;
constexpr size_t WS_MIXS = 70 * MiB;
constexpr size_t WS_BR = 102 * MiB;
constexpr size_t WS_P = 166 * MiB;
constexpr size_t WS_E1 = WS_P, WS_E2 = WS_P + 64 * MiB, WS_XS = WS_P + 96 * MiB, WS_HID = WS_P + 192 * MiB, WS_Y = WS_P + 216 * MiB;
constexpr size_t WS_O16 = 590 * MiB;
constexpr size_t WS_END = 622 * MiB;
constexpr size_t WS_CT = WS_H, WS_VT = WS_H + 16 * MiB;
constexpr size_t WS_QG = WS_MIXS, WS_KHT = WS_MIXS + 16 * MiB;
constexpr size_t WS_HL = WS_WIN, WS_DG = WS_WIN + 16 * MiB, WS_DEC = WS_WIN + 17 * MiB;
constexpr int CW_P2 = 9472;
static_assert(WS_Y + (size_t)MAXROWS * 1024 * 2 <= WS_END && WS_P + (size_t)T * PLD * 2 <= WS_END, "ws map");
static_assert(WS_WIN + (size_t)PLD * 1024 * 2 <= WS_WMG, "ws map");

constexpr int SCR_BYTES = 131072, MISC_OFF = SCR_BYTES, LDS_BYTES = 147456;

__device__ __forceinline__ float bf2f(bf16_t v) { return __uint_as_float(((unsigned)v) << 16); }
typedef float pk_f32x2 __attribute__((ext_vector_type(2))); typedef __bf16 pk_bf16x2 __attribute__((ext_vector_type(2)));
__device__ __forceinline__ unsigned pk2(float lo, float hi) { const pk_f32x2 v = {lo, hi}; return __builtin_bit_cast(unsigned, __builtin_convertvector(v, pk_bf16x2)); }
__device__ __forceinline__ unsigned f2bf(float f) { return pk2(f, 0.f) & 0xffffu; }
__device__ __forceinline__ float lo2f(unsigned w) { return __uint_as_float(w << 16); }
__device__ __forceinline__ float hi2f(unsigned w) { return __uint_as_float(w & 0xffff0000u); }
#define wave_sum(v) wave_sum_(v, lane)
#define wave_max(v) wave_max_(v, lane)
__device__ __forceinline__ float wave_sum_(float v, int lane) {
#pragma unroll
    for (int o = 32; o >= 1; o >>= 1) v += __int_as_float(__builtin_amdgcn_ds_bpermute((lane ^ o) << 2, __float_as_int(v)));
    return v; }
__device__ __forceinline__ float wave_max_(float v, int lane) {
#pragma unroll
    for (int o = 32; o >= 1; o >>= 1) v = fmaxf(v, __int_as_float(__builtin_amdgcn_ds_bpermute((lane ^ o) << 2, __float_as_int(v))));
    return v; }
__device__ __forceinline__ float sigmoidf_(float x) { return __builtin_amdgcn_rcpf(1.0f + __expf(-x)); }
__device__ __forceinline__ float siluf_(float x) { return x * __builtin_amdgcn_rcpf(1.0f + __expf(-x)); }
__device__ __forceinline__ float softplusf_(float x) { return x > 20.f ? x : log1pf(__expf(x)); }

struct Ctx {
    float* out; unsigned char* ws;
    LAS unsigned char* lds;
    int G, bid;
};
#define PH_IDS() int tid = threadIdx.x; asm volatile("" : "+v"(tid)); const int lane = tid & 63; const int wave = __builtin_amdgcn_readfirstlane(tid >> 6); (void)lane; (void)wave
__device__ __forceinline__ const float* inp_ptr(const Ctx& C, int k) {
    unsigned ta = MISC_OFF + 1024 + 8 * k; asm volatile("" : "+s"(ta));
    const LAS unsigned* t = (const LAS unsigned*)(LAS unsigned char*)(size_t)0 + 0; t = (const LAS unsigned*)(C.lds + ta);
    const unsigned lo = __builtin_amdgcn_readfirstlane(t[0]), hi = __builtin_amdgcn_readfirstlane(t[1]);
    return (const float*)(((unsigned long long)hi << 32) | lo);
}
#define INP(k) inp_ptr(C, k)
#define MISCW(C) ((volatile LAS unsigned*)((C).lds + MISC_OFF))
enum { I_X = 0, I_C, I_WADA, I_BADA, I_NMIX, I_NFFN, I_WIN, I_CONVW, I_CONVB, I_DTB, I_ALOG, I_SSDD, I_SSDNW, I_DLAM, I_SUBLN, I_LBL, I_HGNW, I_WMG, I_WOUT, I_WR, I_RB, I_EG, I_EU, I_ED, I_FNW };

__device__ __forceinline__ void pro_mods(const Ctx& C) {
    PH_IDS();
    LAS float* cact = (LAS float*)C.lds;
    LAS float* red = cact + 4096;
    for (int i = tid; i < 4096; i += NTHR) cact[i] = siluf_(INP(I_C)[i]);
    __syncthreads();
    float* mod = (float*)(C.ws + WS_MOD);
    for (int u = C.bid; u < 2 * 96; u += C.G) {
        const int l = u / 96, col0 = (u % 96) * 64;
        const float* w = INP(I_WADA) + (size_t)l * 1024 * 6144 + col0 + lane;
        float a0 = 0.f, a1 = 0.f, a2 = 0.f, a3 = 0.f;
        const int kb = wave * 128;
#pragma unroll 32
        for (int kk = 0; kk < 128; ++kk) { const int k = kb + kk; const float wv = w[(size_t)k * 6144];
            a0 += cact[k] * wv; a1 += cact[1024 + k] * wv; a2 += cact[2048 + k] * wv; a3 += cact[3072 + k] * wv; }
        red[(wave * 4 + 0) * 64 + lane] = a0; red[(wave * 4 + 1) * 64 + lane] = a1; red[(wave * 4 + 2) * 64 + lane] = a2; red[(wave * 4 + 3) * 64 + lane] = a3;
        __syncthreads();
        if (tid < 256) { const int b = tid >> 6, cl = tid & 63; float s = 0.f;
#pragma unroll
            for (int wv = 0; wv < 8; ++wv) s += red[(wv * 4 + b) * 64 + cl];
            mod[((size_t)l * 4 + b) * 6144 + col0 + cl] = s + INP(I_BADA)[l * 6144 + col0 + cl]; }
        __syncthreads();
    }
}

template <class Map> __device__ __forceinline__ void transpose_tile(const float* src, int ld, int k0, int n0, bf16_t* dst, int K, const Map& mp, LAS float* scr, int lane) {
    const int nn_l = lane & 31, kh = lane >> 5;
    float tv[32];
    { const float* sp = src + (size_t)(k0 + kh) * ld + mp.scol(n0 + nn_l);
#pragma unroll
      for (int i = 0; i < 32; ++i) tv[i] = sp[(size_t)(2 * i) * ld]; }
#pragma unroll
    for (int i = 0; i < 32; ++i) scr[(2 * i + kh) * 33 + nn_l] = tv[i];
    asm volatile("s_waitcnt vmcnt(0) lgkmcnt(0)" ::: "memory");
    const int kp = lane & 31;
#pragma unroll 4
    for (int j = 0; j < 16; ++j) { const int nn = 2 * j + kh; const float sc = mp.scale(n0 + nn);
        const float v0 = scr[(2 * kp) * 33 + nn] * sc, v1 = scr[(2 * kp + 1) * 33 + nn] * sc;
        *(unsigned*)(dst + (size_t)mp.drow(n0 + nn) * K + k0 + 2 * kp) = pk2(v0, v1); }
    asm volatile("s_waitcnt lgkmcnt(0)" ::: "memory");
}
struct MapWin {
    __device__ __forceinline__ int scol(int n) const { return n < 1280 ? n : n + 8; }
    __device__ __forceinline__ int drow(int n) const { return n; }
    __device__ __forceinline__ float scale(int n) const { return (n >= C_QC && n < C_QC + 512) ? 0.125f * 1.4426950408889634f : 1.0f; }
};
struct MapPlain { int roff;
    __device__ __forceinline__ int scol(int n) const { return n; }
    __device__ __forceinline__ int drow(int n) const { return roff + n; }
    __device__ __forceinline__ float scale(int) const { return 1.0f; }
};
struct MapGU { int roff, up;
    __device__ __forceinline__ int scol(int n) const { return n; }
    __device__ __forceinline__ int drow(int j) const { return roff + (j >> 7) * 256 + ((j & 127) >> 2) * 8 + (j & 3) + 4 * up; }
    __device__ __forceinline__ float scale(int) const { return 1.0f; }
};
__device__ __forceinline__ void convert_main(const Ctx& C, int l) {
    PH_IDS();
    LAS float* scr = (LAS float*)C.lds + wave * (64 * 33);
    const int gw = C.bid * NWAVES + wave, NGW = C.G * NWAVES;
    constexpr int I_A = 16 * (PLD / 32), I_B = 4 * 8 * 32, I_C2 = 16 * 32;
    bf16_t* WIN = (bf16_t*)(C.ws + WS_WIN); bf16_t* WMG = (bf16_t*)(C.ws + WS_WMG); bf16_t* WO = (bf16_t*)(C.ws + WS_WOUT);
    for (int it = gw; it < I_A + I_B + I_C2; it += NGW) {
        int r = it;
        if (r < I_A) { const int kt = r & 15, nt = r >> 4; transpose_tile(INP(I_WIN) + (size_t)l * 1024 * WIN_LD, WIN_LD, kt * 64, nt * 32, WIN, 1024, MapWin{}, scr, lane); continue; }
        r -= I_A;
        if (r < I_B) { const int n = r >> 8, q = r & 255, kt = q & 7, nt = q >> 3;
            transpose_tile(INP(I_WMG) + ((size_t)l * 4 + n) * 512 * 1024, 1024, kt * 64, nt * 32, WMG, 512, MapPlain{n * 1024}, scr, lane); continue; }
        r -= I_B;
        { const int kt = r & 15, nt = r >> 4; transpose_tile(INP(I_WOUT) + (size_t)l * 1024 * 1024, 1024, kt * 64, nt * 32, WO, 1024, MapPlain{0}, scr, lane); }
    }
}
__device__ __forceinline__ void convert_experts(const Ctx& C, int l) {
    PH_IDS();
    LAS float* scr = (LAS float*)C.lds + wave * (64 * 33);
    const int gw = C.bid * NWAVES + wave, NGW = C.G * NWAVES;
    bf16_t* E1 = (bf16_t*)(C.ws + WS_E1); bf16_t* E2 = (bf16_t*)(C.ws + WS_E2);
    for (int it = gw; it < 64 * 384; it += NGW) {
        const int e = it / 384, r = it % 384, m = r >> 7, q = r & 127;
        if (m < 2) { const int kt = q & 15, nt = q >> 4;
            transpose_tile(INP(m == 0 ? I_EG : I_EU) + ((size_t)l * 64 + e) * 1024 * 256, 256, kt * 64, nt * 32, E1, 1024, MapGU{e * 512, m}, scr, lane); }
        else { const int kt = q & 3, nt = q >> 2;
            transpose_tile(INP(I_ED) + ((size_t)l * 64 + e) * 256 * 1024, 1024, kt * 64, nt * 32, E2, 256, MapPlain{e * 1024}, scr, lane); }
    }
}

struct ConvItem { const float* src; bf16_t* dst; int ld, k0, n0, K, kind, roff, up; };
__device__ __forceinline__ bool conv_item(const Ctx& C, int l, int idx, bool with_main, ConvItem& it) {
    if (idx < 64 * 384) { const int e = idx / 384, r = idx % 384, m = r >> 7, q = r & 127;
        if (m < 2) { it.src = INP(m == 0 ? I_EG : I_EU) + ((size_t)l * 64 + e) * 1024 * 256; it.ld = 256; it.k0 = (q & 15) * 64; it.n0 = (q >> 4) * 32; it.dst = (bf16_t*)(C.ws + WS_E1); it.K = 1024; it.kind = 2; it.roff = e * 512; it.up = m; }
        else { it.src = INP(I_ED) + ((size_t)l * 64 + e) * 256 * 1024; it.ld = 1024; it.k0 = (q & 3) * 64; it.n0 = (q >> 2) * 32; it.dst = (bf16_t*)(C.ws + WS_E2); it.K = 256; it.kind = 1; it.roff = e * 1024; it.up = 0; }
        return true; }
    if (!with_main) return false;
    int r = idx - 64 * 384; constexpr int I_A = 16 * (PLD / 32), I_B = 4 * 8 * 32, I_C2 = 16 * 32;
    if (r >= I_A + I_B + I_C2) return false;
    it.up = 0;
    if (r < I_A) { it.src = INP(I_WIN) + (size_t)(l + 1) * 1024 * WIN_LD; it.ld = WIN_LD; it.k0 = (r & 15) * 64; it.n0 = (r >> 4) * 32; it.dst = (bf16_t*)(C.ws + WS_WIN); it.K = 1024; it.kind = 0; it.roff = 0; return true; }
    r -= I_A;
    if (r < I_B) { const int n = r >> 8, q = r & 255; it.src = INP(I_WMG) + ((size_t)(l + 1) * 4 + n) * 512 * 1024; it.ld = 1024; it.k0 = (q & 7) * 64; it.n0 = (q >> 3) * 32; it.dst = (bf16_t*)(C.ws + WS_WMG); it.K = 512; it.kind = 1; it.roff = n * 1024; return true; }
    r -= I_B;
    it.src = INP(I_WOUT) + (size_t)(l + 1) * 1024 * 1024; it.ld = 1024; it.k0 = (r & 15) * 64; it.n0 = (r >> 4) * 32; it.dst = (bf16_t*)(C.ws + WS_WOUT); it.K = 1024; it.kind = 1; it.roff = 0; return true;
}
__device__ __forceinline__ void conv_load(const ConvItem& it, float (&tv)[32], int lane) {
    const int nn = it.n0 + (lane & 31), kh = lane >> 5; const int scol = (it.kind == 0 && nn >= 1280) ? nn + 8 : nn;
    const float* sp = it.src + (size_t)(it.k0 + kh) * it.ld + scol;
#pragma unroll
    for (int i = 0; i < 32; ++i) tv[i] = sp[(size_t)(2 * i) * it.ld];
}
__device__ __forceinline__ void conv_store(const ConvItem& it, const float (&tv)[32], LAS float* scr, int lane) {
    const int nn_l = lane & 31, kh = lane >> 5, kp = lane & 31;
#pragma unroll
    for (int i = 0; i < 32; ++i) scr[(2 * i + kh) * 33 + nn_l] = tv[i];
    asm volatile("s_waitcnt lgkmcnt(0)" ::: "memory");
#pragma unroll 4
    for (int j = 0; j < 16; ++j) { const int n = it.n0 + 2 * j + kh;
        const float sc = (it.kind == 0 && n >= C_QC && n < C_QC + 512) ? 0.125f * 1.4426950408889634f : 1.0f;
        const int drow = (it.kind == 2) ? it.roff + (n >> 7) * 256 + ((n & 127) >> 2) * 8 + (n & 3) + 4 * it.up : it.roff + n;
        const float v0 = scr[(2 * kp) * 33 + 2 * j + kh] * sc, v1 = scr[(2 * kp + 1) * 33 + 2 * j + kh] * sc;
        *(unsigned*)(it.dst + (size_t)drow * it.K + it.k0 + 2 * kp) = pk2(v0, v1); }
    asm volatile("s_waitcnt lgkmcnt(0)" ::: "memory");
}

template <int MODE> __device__ __forceinline__ void phase_rows(const Ctx& C, int l, bool combine) {
    PH_IDS();
    LAS float* wdt = (LAS float*)C.lds;
    if (MODE == 0) {
        const float* w = INP(I_WIN) + (size_t)l * 1024 * WIN_LD + 1280;
        for (int i = tid; i < 8192; i += NTHR) { const int k = i >> 3, j = i & 7; wdt[j * 1024 + k] = w[(size_t)k * WIN_LD + j]; }
        __syncthreads();
    }
    const int gw = C.bid * NWAVES + wave, NGW = C.G * NWAVES;
    const float* mod = (const float*)(C.ws + WS_MOD);
    float* xres = C.out; bf16_t* hb = (bf16_t*)(C.ws + WS_H); float* dtraw = (float*)(C.ws + WS_DT);
    const int* pos = (const int*)(C.ws + WS_POS); const bf16_t* Y = (const bf16_t*)(C.ws + WS_Y);
    const float* rwt = (const float*)(C.ws + WS_RW);
    const float* xsrc = (l == 0 && MODE == 0) ? INP(I_X) : xres;
    constexpr int RB = 2;
    int p0n[RB], p1n[RB]; float rw0n[RB], rw1n[RB];
#define ROWS_LOAD1(R0) do { _Pragma("unroll") for (int q = 0; q < RB; ++q) { \
        if (combine) { p0n[q] = pos[((R0) + q) * 2]; p1n[q] = pos[((R0) + q) * 2 + 1]; rw0n[q] = rwt[((R0) + q) * 2]; rw1n[q] = rwt[((R0) + q) * 2 + 1]; } else { p0n[q] = 0; p1n[q] = 0; rw0n[q] = 0.f; rw1n[q] = 0.f; } } } while (0)
    ROWS_LOAD1(gw * RB);
    for (int r0 = gw * RB; r0 < T; r0 += NGW * RB) {
        const int b = r0 >> 12;
        f32x4 v[RB][4]; int p0[RB], p1[RB]; float rw0[RB], rw1[RB];
#pragma unroll
        for (int q = 0; q < RB; ++q) { p0[q] = p0n[q]; p1[q] = p1n[q]; rw0[q] = rw0n[q]; rw1[q] = rw1n[q];
#pragma unroll
            for (int j = 0; j < 4; ++j) v[q][j] = *(const f32x4*)(xsrc + (size_t)(r0 + q) * DM + 4 * lane + 256 * j); }
        { const int rn = (r0 + NGW * RB < T) ? r0 + NGW * RB : r0; ROWS_LOAD1(rn); }
        f32x4 nwv[4], scv[4], shv[4];
        if (MODE == 0) { const float* nw = INP(I_NMIX) + l * DM; const float* sh = mod + ((size_t)l * 4 + b) * 6144; const float* sc = sh + 1024;
#pragma unroll
            for (int j = 0; j < 4; ++j) { const int col = 4 * lane + 256 * j; nwv[j] = *(const f32x4*)(nw + col); scv[j] = *(const f32x4*)(sc + col); shv[j] = *(const f32x4*)(sh + col); } }
        if (combine) {
            const float* g2 = mod + ((size_t)(l - 1) * 4 + b) * 6144 + 5120;
            f32x4 g2v[4];
#pragma unroll
            for (int j = 0; j < 4; ++j) g2v[j] = *(const f32x4*)(g2 + 4 * lane + 256 * j);
            u32x2 ya[RB][4], yb[RB][4];
#pragma unroll
            for (int q = 0; q < RB; ++q)
#pragma unroll
                for (int j = 0; j < 4; ++j) { const int col = 4 * lane + 256 * j; ya[q][j] = *(const u32x2*)(Y + (size_t)p0[q] * DM + col); yb[q][j] = *(const u32x2*)(Y + (size_t)p1[q] * DM + col); }
#pragma unroll
            for (int j = 0; j < 4; ++j) { const int col = 4 * lane + 256 * j; const f32x4 g = g2v[j];
#pragma unroll
                for (int q = 0; q < RB; ++q) {
                    v[q][j].x += g.x * (rw0[q] * lo2f(ya[q][j].x) + rw1[q] * lo2f(yb[q][j].x)); v[q][j].y += g.y * (rw0[q] * hi2f(ya[q][j].x) + rw1[q] * hi2f(yb[q][j].x));
                    v[q][j].z += g.z * (rw0[q] * lo2f(ya[q][j].y) + rw1[q] * lo2f(yb[q][j].y)); v[q][j].w += g.w * (rw0[q] * hi2f(ya[q][j].y) + rw1[q] * hi2f(yb[q][j].y));
                    if (MODE == 0) *(f32x4*)(xres + (size_t)(r0 + q) * DM + col) = v[q][j]; } }
        }
        float rstd[RB];
#pragma unroll
        for (int q = 0; q < RB; ++q) { float ss = 0.f;
#pragma unroll
            for (int j = 0; j < 4; ++j) ss += (v[q][j].x * v[q][j].x + v[q][j].y * v[q][j].y) + (v[q][j].z * v[q][j].z + v[q][j].w * v[q][j].w);
            rstd[q] = rsqrtf(wave_sum(ss) * (1.0f / DM) + EPS); }
        if (MODE == 1) {
#pragma unroll
            for (int j = 0; j < 4; ++j) { const int col = 4 * lane + 256 * j; const f32x4 w = *(const f32x4*)(INP(I_FNW) + col);
#pragma unroll
                for (int q = 0; q < RB; ++q) *(f32x4*)(C.out + (size_t)(r0 + q) * DM + col) = v[q][j] * rstd[q] * w; }
        } else {
            float da[RB][8];
#pragma unroll
            for (int q = 0; q < RB; ++q)
#pragma unroll
                for (int i = 0; i < 8; ++i) da[q][i] = 0.f;
#pragma unroll
            for (int j = 0; j < 4; ++j) { const int col = 4 * lane + 256 * j;
                const f32x4 w = nwv[j], s1 = scv[j], s0 = shv[j];
                f32x4 hv[RB];
#pragma unroll
                for (int q = 0; q < RB; ++q) { hv[q] = v[q][j] * rstd[q] * w * (s1 + 1.0f) + s0;
                    u32x2 o; o.x = pk2(hv[q].x, hv[q].y); o.y = pk2(hv[q].z, hv[q].w);
                    *(u32x2*)(hb + (size_t)(r0 + q) * DM + col) = o; }
#pragma unroll
                for (int i = 0; i < 8; ++i) { const f32x4 wd = *(const LAS f32x4*)(wdt + i * 1024 + col);
#pragma unroll
                    for (int q = 0; q < RB; ++q) da[q][i] += (hv[q].x * wd.x + hv[q].y * wd.y) + (hv[q].z * wd.z + hv[q].w * wd.w); } }
#pragma unroll
            for (int q = 0; q < RB; ++q) {
#pragma unroll
                for (int i = 0; i < 8; ++i) da[q][i] = wave_sum(da[q][i]);
                if (lane == 0) { *(f32x4*)(dtraw + (size_t)(r0 + q) * 8) = (f32x4){da[q][0], da[q][1], da[q][2], da[q][3]}; *(f32x4*)(dtraw + (size_t)(r0 + q) * 8 + 4) = (f32x4){da[q][4], da[q][5], da[q][6], da[q][7]}; } }
        }
    }
}

typedef float n2_f32x16 __attribute__((ext_vector_type(16)));
__device__ __forceinline__ void phase_n2(const Ctx& C, int l, bool with_main) {
    PH_IDS();
    constexpr int HP = 129;
    LAS float* hsl = (LAS float*)C.lds;
    LAS float* wsl = hsl + 8320;
    LAS float* Pl = hsl;
    LAS float* cscr = (wave < 7) ? (LAS float*)(C.lds + 66048 + wave * 8448) : (LAS float*)(C.lds + MISC_OFF + 4096);
    const int cgw = C.bid * NWAVES + wave, CNGW = C.G * NWAVES;
    const int ctotal = 64 * 384 + (with_main ? (16 * (PLD / 32) + 4 * 8 * 32 + 16 * 32) : 0);
    int cj = 0;
    const float* mod = (const float*)(C.ws + WS_MOD);
    const float* xres = C.out; bf16_t* hb = (bf16_t*)(C.ws + WS_H);
    int* r_e = (int*)(C.ws + WS_RE); int* r_s = (int*)(C.ws + WS_RS); float* r_w = (float*)(C.ws + WS_RW);
    const float* wr = INP(I_WR); const float rbias = INP(I_RB)[lane];
    const float* nw = INP(I_NFFN) + l * DM;
    const int n32 = lane & 31, hi = lane >> 5, et = wave & 1, rt = (wave >> 1) & 1, kh = wave >> 2;
    for (int rb = C.bid; rb < T / 64; rb += C.G) {
        const int rbase = rb * 64 + wave * 8, b = (rb * 64) >> 12;
        const float* sh = mod + ((size_t)l * 4 + b) * 6144 + 3072; const float* sc = sh + 1024;
        float rstd[8];
#pragma unroll
        for (int r = 0; r < 8; ++r) { float ss = 0.f;
#pragma unroll
            for (int jj = 0; jj < 4; ++jj) { const f32x4 v = *(const f32x4*)(xres + (size_t)(rbase + r) * DM + 4 * lane + 256 * jj); ss += (v.x * v.x + v.y * v.y) + (v.z * v.z + v.w * v.w); }
            rstd[r] = rsqrtf(wave_sum(ss) * (1.0f / DM) + EPS); }
        const int sr = lane >> 3, c16 = lane & 7;
        float myrs = rstd[0];
#pragma unroll
        for (int r = 1; r < 8; ++r) myrs = (sr == r) ? rstd[r] : myrs;
        n2_f32x16 acc;
#pragma unroll
        for (int r = 0; r < 16; ++r) acc[r] = 0.f;
        f32x4 xv[4], nwv[4], scv[4], shv[4], wv4[4];
#define N2_LOAD(S8) do { const int col0_ = 128 * (S8) + 16 * c16; const size_t row_ = (size_t)(rbase + sr); \
            _Pragma("unroll") for (int q = 0; q < 4; ++q) { xv[q] = *(const f32x4*)(xres + row_ * DM + col0_ + 4 * q); nwv[q] = *(const f32x4*)(nw + col0_ + 4 * q); scv[q] = *(const f32x4*)(sc + col0_ + 4 * q); shv[q] = *(const f32x4*)(sh + col0_ + 4 * q); \
                wv4[q] = *(const f32x4*)(wr + (size_t)128 * 64 * (S8) + 4 * (tid + 512 * q)); } } while (0)
        N2_LOAD(0);
        for (int s8 = 0; s8 < 8; ++s8) {
            __syncthreads();
            { const int col0 = 128 * s8 + 16 * c16; const size_t row = (size_t)(rbase + sr);
#pragma unroll
              for (int q = 0; q < 4; ++q) { const int col = col0 + 4 * q;
                  const f32x4 hv = xv[q] * myrs * nwv[q] * (scv[q] + 1.0f) + shv[q];
                  u32x2 o; o.x = pk2(hv.x, hv.y); o.y = pk2(hv.z, hv.w);
                  *(u32x2*)(hb + row * DM + col) = o;
                  LAS float* hp = hsl + (8 * wave + sr) * HP + 16 * c16 + 4 * q; hp[0] = hv.x; hp[1] = hv.y; hp[2] = hv.z; hp[3] = hv.w; } }
#pragma unroll
            for (int i = 0; i < 4; ++i) *(LAS f32x4*)(wsl + 4 * (tid + 512 * i)) = wv4[i];
            if (s8 + 1 < 8) N2_LOAD(s8 + 1);
            ConvItem ci0; float tv0[32];
            const bool cv0 = (cgw + cj * CNGW < ctotal) && conv_item(C, l, cgw + cj * CNGW, with_main, ci0); ++cj;
            if (cv0) conv_load(ci0, tv0, lane);
            __syncthreads();
            const LAS float* ap = wsl + (64 * kh + hi) * 64 + 32 * et + n32; const LAS float* bp = hsl + (32 * rt + n32) * HP + 64 * kh + hi;
#pragma unroll 8
            for (int ks = 0; ks < 32; ++ks) acc = __builtin_amdgcn_mfma_f32_32x32x2f32(ap[ks * 128], bp[ks * 2], acc, 0, 0, 0);
            if (cv0) conv_store(ci0, tv0, cscr, lane);
        }
#undef N2_LOAD
        __syncthreads();
#pragma unroll
        for (int r = 0; r < 16; ++r) Pl[(kh * 64 + 32 * rt + n32) * 64 + 32 * et + (r & 3) + 8 * (r >> 2) + 4 * hi] = acc[r];
        __syncthreads();
        LAS float* sw = wsl + wave * 1024; LAS int* pick = (LAS int*)(hsl + 8192);
#pragma unroll
        for (int r = 0; r < 8; ++r) { const float lg = Pl[(8 * wave + r) * 64 + lane] + Pl[(64 + 8 * wave + r) * 64 + lane]; const float sg = sigmoidf_(lg); sw[r * 64 + lane] = sg + rbias; sw[512 + r * 64 + lane] = sg; }
        asm volatile("s_waitcnt lgkmcnt(0)" ::: "memory");
        if (lane < 8) {
            const LAS float* sel = sw + lane * 64; const LAS float* sco = sw + 512 + lane * 64;
            int best = 0; float bestv = -3.0e38f;
            for (int g = 0; g < 8; ++g) { float m1 = -3.0e38f, m2 = -3.0e38f;
                for (int i = 0; i < 8; ++i) { const float x = sel[g * 8 + i]; if (x > m1) { m2 = m1; m1 = x; } else if (x > m2) m2 = x; }
                const float gs = m1 + m2; if (gs > bestv) { bestv = gs; best = g; } }
            int i0 = 0; float v0 = -3.0e38f;
            for (int i = 0; i < 8; ++i) { const float x = sel[best * 8 + i]; if (x > v0) { v0 = x; i0 = i; } }
            int i1 = 0; float v1 = -3.0e38f;
            for (int i = 0; i < 8; ++i) { if (i == i0) continue; const float x = sel[best * 8 + i]; if (x > v1) { v1 = x; i1 = i; } }
            const int e0 = best * 8 + i0, e1 = best * 8 + i1; const float s0 = sco[e0], s1 = sco[e1], inv = 1.0f / (s0 + s1);
            const int row = rbase + lane;
            r_e[row * 2] = e0; r_e[row * 2 + 1] = e1; r_w[row * 2] = s0 * inv; r_w[row * 2 + 1] = s1 * inv;
            pick[(wave * 8 + lane) * 2] = e0; pick[(wave * 8 + lane) * 2 + 1] = e1;
        }
        __syncthreads();
        if (tid < 64) { int cnt = 0;
            for (int i = 0; i < 128; ++i) if (pick[i] == tid) { r_s[rb * 128 + i] = cnt; ++cnt; }
            ((int*)(C.ws + WS_CNT))[rb * 64 + tid] = cnt; }
    }
    { ConvItem ca; float ta[32]; bool va = (cgw + cj * CNGW < ctotal) && conv_item(C, l, cgw + cj * CNGW, with_main, ca); if (va) conv_load(ca, ta, lane);
      while (va) { ++cj;
          ConvItem cb; float tb[32]; const bool vb = (cgw + cj * CNGW < ctotal) && conv_item(C, l, cgw + cj * CNGW, with_main, cb); if (vb) conv_load(cb, tb, lane);
          conv_store(ca, ta, cscr, lane);
          ca = cb; va = vb;
#pragma unroll
          for (int i = 0; i < 32; ++i) ta[i] = tb[i]; } }
}

__device__ __forceinline__ void phase_scatter(const Ctx& C, int l) {
    PH_IDS();
    LAS unsigned char* blk_e = C.lds + MISC_OFF + 64; LAS int* blk0 = (LAS int*)(C.lds + MISC_OFF + 512);
    LAS int* basel = (LAS int*)C.lds; LAS int* totl = basel + 64; LAS int* parts = basel + 128;
    const int* CNT = (const int*)(C.ws + WS_CNT);
    const int* r_e = (const int*)(C.ws + WS_RE); const int* r_s = (const int*)(C.ws + WS_RS);
    int* pos = (int*)(C.ws + WS_POS); int* ROWTOK = (int*)(C.ws + WS_ROWTOK);
    bool first = true;
    for (int rb = C.bid; rb < T / 64 || first; rb += C.G) {
        __syncthreads();
        { const int e = tid & 63, part = tid >> 6; int base = 0, tot = 0; int cv[32];
#pragma unroll
          for (int w = 0; w < 32; ++w) cv[w] = CNT[(part * 32 + w) * 64 + e];
#pragma unroll
          for (int w = 0; w < 32; ++w) { base += (part * 32 + w < rb) ? cv[w] : 0; tot += cv[w]; }
          parts[part * 64 + e] = base; parts[512 + part * 64 + e] = tot; }
        __syncthreads();
        if (tid < 64) { int base = 0, tot = 0;
#pragma unroll
            for (int p = 0; p < 8; ++p) { base += parts[p * 64 + tid]; tot += parts[512 + p * 64 + tid]; }
            basel[tid] = base; totl[tid] = tot; }
        __syncthreads();
        if (first && tid == 0) { int nb = 0;
            for (int e = 0; e < 64; ++e) { const int k = (totl[e] + 255) >> 8; blk0[e] = nb;
                for (int i = 0; i < k && nb + i < 192; ++i) blk_e[nb + i] = (unsigned char)e; nb += k; }
            blk0[64] = nb; MISCW(C)[5] = (unsigned)(nb > 192 ? 192 : nb);
            LAS int* m1 = (LAS int*)(C.lds + MISC_OFF + 2048); LAS int* m2 = m1 + 64;
            const int x8 = C.bid & 7, y = C.bid >> 3, ny = (C.G + 7 - x8) >> 3;
            int n1 = 0, n2 = 0, c1 = 0, c2 = 0;
            for (int e = x8; e < 64; e += 8) for (int pb = blk0[e]; pb < blk0[e + 1] && pb < 192; ++pb) {
                for (int jj = 0; jj < 2; ++jj) { if (n1 % ny == y && c1 < 12) m1[1 + c1++] = (pb << 8) | (2 * e + jj); ++n1; }
                for (int jj = 0; jj < 4; ++jj) { if (n2 % ny == y && c2 < 62) m2[1 + c2++] = (pb << 8) | (4 * e + jj); ++n2; } }
            m1[0] = c1; m2[0] = c2; }
        __syncthreads();
        if (first && C.bid < 64 && tid < 256) { const int e = C.bid; const int r = blk0[e] * 256 + totl[e] + tid; if (r < blk0[e + 1] * 256 && r < MAXROWS) ROWTOK[r] = 0; }
        first = false;
        if (rb < T / 64) {
            if (lane < 16) { const int it = rb * 128 + wave * 16 + lane; const int e = r_e[it]; const int row = blk0[e] * 256 + basel[e] + r_s[it];
                pos[it] = row; ROWTOK[row] = it >> 1; }
        }
    }
}

typedef short ch_bf16x8 __attribute__((ext_vector_type(8)));
typedef short ch_s16x4 __attribute__((ext_vector_type(4)));
constexpr int IMG_P = 144;
__device__ __forceinline__ int kperm(int k) { const int kt = k >> 4; return 32 * (kt >> 1) + 8 * ((k >> 2) & 3) + 4 * (kt & 1) + (k & 3); }
__device__ __forceinline__ ch_bf16x8 tr_pair(const LAS unsigned char* a0, const LAS unsigned char* a1) {
    const ch_s16x4 lo = __builtin_bit_cast(ch_s16x4, __builtin_amdgcn_ds_read_tr16_b64_v4i16((LAS ch_s16x4*)a0));
    const ch_s16x4 hi = __builtin_bit_cast(ch_s16x4, __builtin_amdgcn_ds_read_tr16_b64_v4i16((LAS ch_s16x4*)a1));
    return (ch_bf16x8){lo[0], lo[1], lo[2], lo[3], hi[0], hi[1], hi[2], hi[3]};
}
__device__ __forceinline__ ch_bf16x8 pack8(const pg8::f32x4& a, const pg8::f32x4& b) { u32x4 w; w.x = pk2(a[0], a[1]); w.y = pk2(a[2], a[3]); w.z = pk2(b[0], b[1]); w.w = pk2(b[2], b[3]); return __builtin_bit_cast(ch_bf16x8, w); }

__device__ __forceinline__ void ssd_pass1(const Ctx& C, int l, int unit) {
    PH_IDS();
    const int c = unit & 31, head = (unit >> 5) & 7, b = unit >> 8, grp = head >> 2;
    const size_t row0 = (size_t)b * SEQ + (size_t)c * 128;
    LAS unsigned char* XD = C.lds; LAS unsigned char* BW = XD + 128 * IMG_P; LAS unsigned char* BB = BW + 128 * IMG_P; LAS unsigned char* CC = BB + 128 * IMG_P;
    LAS float* acs = (LAS float*)(CC + 128 * IMG_P); LAS float* dtv = acs + 128;
    const bf16_t* P = (const bf16_t*)(C.ws + WS_P);
    const float a_h = -__expf(INP(I_ALOG)[l * 8 + head]);
    if (wave < 2) {
        const float* dtraw = (const float*)(C.ws + WS_DT); const float dtb = INP(I_DTB)[l * 8 + head];
        const float d0 = softplusf_(dtraw[(row0 + lane) * 8 + head] + dtb);
        float dmine = d0, pre = 0.f;
        if (wave == 1) { dmine = softplusf_(dtraw[(row0 + 64 + lane) * 8 + head] + dtb); pre = wave_sum(d0 * a_h); }
        float sc = dmine * a_h;
#pragma unroll
        for (int o = 1; o < 64; o <<= 1) { const float t = __int_as_float(__builtin_amdgcn_ds_bpermute((lane - o) << 2, __float_as_int(sc))); if (lane >= o) sc += t; }
        acs[wave * 64 + lane] = sc + pre; dtv[wave * 64 + lane] = dmine;
    }
    const int cg = tid % 24, rb = tid / 24;
    const int ch0 = (cg < 8) ? head * 64 + 8 * cg : (cg < 16 ? 512 + grp * 64 + 8 * (cg - 8) : 640 + grp * 64 + 8 * (cg - 16));
    u32x4 raw[11];
    if (tid < 384) {
#pragma unroll
        for (int j = 0; j < 11; ++j) { const int t = c * 128 + 8 * rb - 3 + j;
            raw[j] = (t >= 0) ? *(const u32x4*)(P + ((size_t)b * SEQ + t) * PLD + C_X + ch0) : (u32x4){0u, 0u, 0u, 0u}; }
    }
    float wj[4][8], bs[8];
    if (tid < 384) {
        { const float* cw = INP(I_CONVW) + (size_t)l * 4 * 768 + ch0; const float* cb = INP(I_CONVB) + l * 768 + ch0;
#pragma unroll
          for (int j = 0; j < 4; ++j) { const f32x4 a = *(const f32x4*)(cw + j * 768), bq = *(const f32x4*)(cw + j * 768 + 4); wj[j][0] = a.x; wj[j][1] = a.y; wj[j][2] = a.z; wj[j][3] = a.w; wj[j][4] = bq.x; wj[j][5] = bq.y; wj[j][6] = bq.z; wj[j][7] = bq.w; }
          const f32x4 a = *(const f32x4*)cb, bq = *(const f32x4*)(cb + 4); bs[0] = a.x; bs[1] = a.y; bs[2] = a.z; bs[3] = a.w; bs[4] = bq.x; bs[5] = bq.y; bs[6] = bq.z; bs[7] = bq.w; }
    }
    __syncthreads();
    if (tid < 384) {
        const float acl = acs[127];
        bf16_t* CT = (bf16_t*)(C.ws + WS_CT);
#pragma unroll
        for (int r = 0; r < 8; ++r) {
            const int lr = 8 * rb + r;
            float v[8];
#pragma unroll
            for (int e = 0; e < 8; ++e) v[e] = bs[e];
#pragma unroll
            for (int j = 0; j < 4; ++j) { const u32x4 q = raw[r + j];
                v[0] += wj[j][0] * lo2f(q.x); v[1] += wj[j][1] * hi2f(q.x); v[2] += wj[j][2] * lo2f(q.y); v[3] += wj[j][3] * hi2f(q.y);
                v[4] += wj[j][4] * lo2f(q.z); v[5] += wj[j][5] * hi2f(q.z); v[6] += wj[j][6] * lo2f(q.w); v[7] += wj[j][7] * hi2f(q.w); }
#pragma unroll
            for (int e = 0; e < 8; ++e) v[e] = siluf_(v[e]);
            if (cg < 8) { const float d = dtv[lr];
                u32x4 w; w.x = pk2(v[0] * d, v[1] * d); w.y = pk2(v[2] * d, v[3] * d); w.z = pk2(v[4] * d, v[5] * d); w.w = pk2(v[6] * d, v[7] * d);
                *(LAS u32x4*)(XD + lr * IMG_P + 16 * cg) = w;
            } else if (cg < 16) { const float wd = __expf(acl - acs[lr]);
                u32x4 w; w.x = pk2(v[0], v[1]); w.y = pk2(v[2], v[3]); w.z = pk2(v[4], v[5]); w.w = pk2(v[6], v[7]);
                *(LAS u32x4*)(BB + lr * IMG_P + 16 * (cg - 8)) = w;
                w.x = pk2(v[0] * wd, v[1] * wd); w.y = pk2(v[2] * wd, v[3] * wd); w.z = pk2(v[4] * wd, v[5] * wd); w.w = pk2(v[6] * wd, v[7] * wd);
                *(LAS u32x4*)(BW + lr * IMG_P + 16 * (cg - 8)) = w;
            } else { const float ea = __expf(acs[lr]); const int n0 = 8 * (cg - 16);
                u32x4 w; w.x = pk2(v[0], v[1]); w.y = pk2(v[2], v[3]); w.z = pk2(v[4], v[5]); w.w = pk2(v[6], v[7]);
                *(LAS u32x4*)(CC + lr * IMG_P + 16 * (cg - 16)) = w;
                bf16_t* cp = CT + (row0 + lr) * 512 + head * 64;
                u32x2 wa; wa.x = pk2(v[0] * ea, v[1] * ea); wa.y = pk2(v[2] * ea, v[3] * ea); *(u32x2*)(cp + kperm(n0)) = wa;
                u32x2 wb; wb.x = pk2(v[4] * ea, v[5] * ea); wb.y = pk2(v[6] * ea, v[7] * ea); *(u32x2*)(cp + kperm(n0 + 4)) = wb;
            }
        }
    }
    __syncthreads();
    const int n16 = lane & 15, kq = lane >> 4, q4 = n16 >> 2, p4 = lane & 3;
    const float dsk = INP(I_SSDD)[l * 8 + head];
    ch_bf16x8 cf[2];
#pragma unroll
    for (int ks = 0; ks < 2; ++ks) cf[ks] = *(const LAS ch_bf16x8*)(CC + (16 * wave + n16) * IMG_P + 64 * ks + 16 * kq);
    const float acl_l = acs[16 * wave + n16];
    const float dskd = dsk / dtv[16 * wave + n16];
    ch_bf16x8 pa[4];
#pragma unroll
    for (int kp = 0; kp < 4; ++kp) {
        pg8::f32x4 g2[2];
#pragma unroll
        for (int h2 = 0; h2 < 2; ++h2) {
            const int ts = 2 * kp + h2;
            pg8::f32x4 a = {0.f, 0.f, 0.f, 0.f};
            if (ts <= wave) {
#pragma unroll
                for (int ks = 0; ks < 2; ++ks) { const ch_bf16x8 bf = *(const LAS ch_bf16x8*)(BB + (16 * ts + n16) * IMG_P + 64 * ks + 16 * kq); a = __builtin_amdgcn_mfma_f32_16x16x32_bf16(bf, cf[ks], a, 0, 0, 0); }
                const f32x4 as4 = *(const LAS f32x4*)(acs + 16 * ts + 4 * kq);
                const int ll = 16 * wave + n16, s0 = 16 * ts + 4 * kq;
                a[0] = (s0 + 0 <= ll) ? a[0] * __expf(acl_l - as4.x) : 0.f; a[1] = (s0 + 1 <= ll) ? a[1] * __expf(acl_l - as4.y) : 0.f;
                a[2] = (s0 + 2 <= ll) ? a[2] * __expf(acl_l - as4.z) : 0.f; a[3] = (s0 + 3 <= ll) ? a[3] * __expf(acl_l - as4.w) : 0.f;
                if (s0 + 0 == ll) a[0] += dskd; if (s0 + 1 == ll) a[1] += dskd; if (s0 + 2 == ll) a[2] += dskd; if (s0 + 3 == ll) a[3] += dskd;
            }
            g2[h2] = a;
        }
        pa[kp] = pack8(g2[0], g2[1]);
    }
    pg8::f32x4 o[4];
#pragma unroll
    for (int pt = 0; pt < 4; ++pt) o[pt] = (pg8::f32x4){0.f, 0.f, 0.f, 0.f};
#pragma unroll
    for (int kp = 0; kp < 4; ++kp) if (2 * kp <= wave) {
        const LAS unsigned char* xb = XD + (32 * kp + 4 * kq + q4) * IMG_P + 8 * p4;
#pragma unroll
        for (int pt = 0; pt < 4; ++pt) o[pt] = __builtin_amdgcn_mfma_f32_16x16x32_bf16(tr_pair(xb + 32 * pt, xb + 16 * IMG_P + 32 * pt), pa[kp], o[pt], 0, 0, 0);
    }
    { bf16_t* yb = (bf16_t*)(C.ws + WS_BR) + (row0 + 16 * wave + n16) * 512 + head * 64 + 4 * kq;
#pragma unroll
      for (int pt = 0; pt < 4; ++pt) { u32x2 w; w.x = pk2(o[pt][0], o[pt][1]); w.y = pk2(o[pt][2], o[pt][3]); *(u32x2*)(yb + 16 * pt) = w; } }
    { f32x4* HL = (f32x4*)(C.ws + WS_HL) + (size_t)unit * 16 * 64;
#pragma unroll
      for (int h2 = 0; h2 < 2; ++h2) { const int id = 2 * wave + h2, nt = id >> 2, pt = id & 3;
          pg8::f32x4 a = {0.f, 0.f, 0.f, 0.f};
#pragma unroll
          for (int ks = 0; ks < 4; ++ks) { const int rowa = 32 * ks + 8 * kq + q4;
              const ch_bf16x8 af = tr_pair(BW + rowa * IMG_P + 32 * nt + 8 * p4, BW + (rowa + 4) * IMG_P + 32 * nt + 8 * p4);
              const ch_bf16x8 bf = tr_pair(XD + rowa * IMG_P + 32 * pt + 8 * p4, XD + (rowa + 4) * IMG_P + 32 * pt + 8 * p4);
              a = __builtin_amdgcn_mfma_f32_16x16x32_bf16(af, bf, a, 0, 0, 0); }
          HL[id * 64 + lane] = (f32x4){a[0], a[1], a[2], a[3]}; } }
    if (tid == 0) ((float*)(C.ws + WS_DEC))[unit] = __expf(acs[127]);
    __syncthreads();
}
struct Ssd2Ops { f32x4 hl[4]; float dec; ch_bf16x8 cf[2][2]; u32x2 yv[2]; };
__device__ __forceinline__ void ssd2_load(Ssd2Ops& o, const bf16_t* CT, const f32x4* HL, const float* DEC, const bf16_t* Y, int chain, int c, int wv, int lq, int head, int b, int lane) {
    const int n16 = lane & 15, kq = lane >> 4;
    const int unit = chain * 32 + c; const size_t row0 = (size_t)b * SEQ + (size_t)c * 128 + 32 * lq;
#pragma unroll
    for (int nt = 0; nt < 4; ++nt) o.hl[nt] = HL[((size_t)unit * 16 + nt * 4 + wv) * 64 + lane];
    o.dec = DEC[unit];
#pragma unroll
    for (int lt = 0; lt < 2; ++lt) { const bf16_t* cp = CT + (row0 + 16 * lt + n16) * 512 + head * 64 + 8 * kq; o.cf[lt][0] = *(const ch_bf16x8*)cp; o.cf[lt][1] = *(const ch_bf16x8*)(cp + 32);
        o.yv[lt] = *(const u32x2*)(Y + (row0 + 16 * lt + n16) * 512 + head * 64 + 16 * wv + 4 * kq); }
}
__device__ __forceinline__ void ssd_pass2(const Ctx& C, int chain, int wv, int lq) {
    PH_IDS();
    const int n16 = lane & 15, kq = lane >> 4;
    const int head = chain & 7, b = chain >> 3;
    const bf16_t* CT = (const bf16_t*)(C.ws + WS_CT); const f32x4* HL = (const f32x4*)(C.ws + WS_HL); const float* DEC = (const float*)(C.ws + WS_DEC);
    bf16_t* Y = (bf16_t*)(C.ws + WS_BR);
    pg8::f32x4 H[4];
#pragma unroll
    for (int nt = 0; nt < 4; ++nt) H[nt] = (pg8::f32x4){0.f, 0.f, 0.f, 0.f};
    Ssd2Ops cur, nx1; ssd2_load(cur, CT, HL, DEC, Y, chain, 0, wv, lq, head, b, lane); ssd2_load(nx1, CT, HL, DEC, Y, chain, 1, wv, lq, head, b, lane);
    for (int c = 0; c < 32; ++c) {
        Ssd2Ops nxt; ssd2_load(nxt, CT, HL, DEC, Y, chain, c + 2 < 32 ? c + 2 : 31, wv, lq, head, b, lane);
        if (c > 0) {
            const ch_bf16x8 hb0 = pack8(H[0], H[1]), hb1 = pack8(H[2], H[3]);
            const size_t row0 = (size_t)b * SEQ + (size_t)c * 128 + 32 * lq;
#pragma unroll
            for (int lt = 0; lt < 2; ++lt) {
                pg8::f32x4 a = {0.f, 0.f, 0.f, 0.f};
                a = __builtin_amdgcn_mfma_f32_16x16x32_bf16(hb0, cur.cf[lt][0], a, 0, 0, 0);
                a = __builtin_amdgcn_mfma_f32_16x16x32_bf16(hb1, cur.cf[lt][1], a, 0, 0, 0);
                u32x2 w; w.x = pk2(lo2f(cur.yv[lt].x) + a[0], hi2f(cur.yv[lt].x) + a[1]); w.y = pk2(lo2f(cur.yv[lt].y) + a[2], hi2f(cur.yv[lt].y) + a[3]);
                *(u32x2*)(Y + (row0 + 16 * lt + n16) * 512 + head * 64 + 16 * wv + 4 * kq) = w;
            }
        }
#pragma unroll
        for (int nt = 0; nt < 4; ++nt) { H[nt][0] = cur.dec * H[nt][0] + cur.hl[nt].x; H[nt][1] = cur.dec * H[nt][1] + cur.hl[nt].y; H[nt][2] = cur.dec * H[nt][2] + cur.hl[nt].z; H[nt][3] = cur.dec * H[nt][3] + cur.hl[nt].w; }
        cur = nx1; nx1 = nxt;
    }
}
__device__ __forceinline__ void hgrn_pass1(const Ctx& C, int l, int unit) {
    PH_IDS();
    const int blk = unit & 31, head = (unit >> 5) & 7, b = unit >> 8;
    const size_t row0 = (size_t)b * SEQ + (size_t)blk * 128;
    LAS unsigned char* QT = C.lds; LAS unsigned char* KT = QT + 128 * IMG_P; LAS unsigned char* VV = KT + 128 * IMG_P;
    const bf16_t* P = (const bf16_t*)(C.ws + WS_P);
    { u32x4 rq[2], rf[2], rv[2];
#pragma unroll
      for (int h2 = 0; h2 < 2; ++h2) { const int r = (tid >> 3) + 64 * h2, ch = tid & 7; const bf16_t* pr = P + (row0 + r) * PLD + head * 64 + ch * 8;
          rq[h2] = *(const u32x4*)(pr + C_QD); rf[h2] = *(const u32x4*)(pr + C_FD); rv[h2] = *(const u32x4*)(pr + C_ID); }
#pragma unroll
      for (int h2 = 0; h2 < 2; ++h2) { const int r = (tid >> 3) + 64 * h2, ch = tid & 7;
          *(LAS u32x4*)(QT + r * IMG_P + 16 * ch) = rq[h2]; *(LAS u32x4*)(KT + r * IMG_P + 16 * ch) = rf[h2]; *(LAS u32x4*)(VV + r * IMG_P + 16 * ch) = rv[h2]; } }
    __syncthreads();
    const int c4 = (tid >> 6) & 3;
    const size_t cgi = ((size_t)(b * 8 + head) * 128 + blk * 4 + c4);
    if (tid < 256) {
        const int k = lane;
        float lb = 0.f; if (l > 0) lb = sigmoidf_(INP(I_LBL)[512 + head * 64 + k] - INP(I_LBL)[head * 64 + k]);
        float G = 0.f; float kt[32];
#pragma unroll
        for (int t = 0; t < 32; ++t) {
            LAS bf16_t* pq = (LAS bf16_t*)(QT + (32 * c4 + t) * IMG_P + 2 * k); LAS bf16_t* pf = (LAS bf16_t*)(KT + (32 * c4 + t) * IMG_P + 2 * k);
            const float f = lb + (1.0f - lb) * sigmoidf_(bf2f(*pf)); const float q = siluf_(bf2f(*pq));
            G += __logf(f);
            const float qt = q * __expf(G), ktv = (1.0f - f) * __expf(-fmaxf(G, -80.0f));
            kt[t] = ktv;
            *pq = (bf16_t)f2bf(qt); *pf = (bf16_t)f2bf(ktv);
        }
        const float eg = __expf(G);
        ((float*)(C.ws + WS_DG))[cgi * 64 + k] = eg;
        u32x4* kh = (u32x4*)((bf16_t*)(C.ws + WS_KHT) + (cgi * 64 + k) * 32);
#pragma unroll
        for (int q = 0; q < 4; ++q) { u32x4 w; w.x = pk2(kt[8 * q] * eg, kt[8 * q + 1] * eg); w.y = pk2(kt[8 * q + 2] * eg, kt[8 * q + 3] * eg); w.z = pk2(kt[8 * q + 4] * eg, kt[8 * q + 5] * eg); w.w = pk2(kt[8 * q + 6] * eg, kt[8 * q + 7] * eg); kh[q] = w; }
    } else {
        const int v = lane;
        unsigned short vv[32];
#pragma unroll
        for (int t = 0; t < 32; ++t) vv[t] = *(const LAS bf16_t*)(VV + (32 * c4 + t) * IMG_P + 2 * v);
        u32x4* vt = (u32x4*)((bf16_t*)(C.ws + WS_VT) + (cgi * 64 + v) * 32);
#pragma unroll
        for (int q = 0; q < 4; ++q) { u32x4 w; w.x = vv[8 * q] | ((unsigned)vv[8 * q + 1] << 16); w.y = vv[8 * q + 2] | ((unsigned)vv[8 * q + 3] << 16); w.z = vv[8 * q + 4] | ((unsigned)vv[8 * q + 5] << 16); w.w = vv[8 * q + 6] | ((unsigned)vv[8 * q + 7] << 16); vt[q] = w; }
    }
    __syncthreads();
    { bf16_t* QG = (bf16_t*)(C.ws + WS_QG);
#pragma unroll
      for (int i = 0; i < 4; ++i) { const int idx = tid + 512 * i, r = idx >> 4, g4 = idx & 15;
          const u32x2 w = *(const LAS u32x2*)(QT + r * IMG_P + 8 * g4);
          *(u32x2*)(QG + (row0 + r) * 512 + head * 64 + kperm(4 * g4)) = w; } }
    { const int n16 = lane & 15, kq = lane >> 4, q4 = n16 >> 2, p4 = lane & 3;
      const int cw = wave >> 1, it = wave & 1;
      ch_bf16x8 qf[2];
#pragma unroll
      for (int ks = 0; ks < 2; ++ks) qf[ks] = *(const LAS ch_bf16x8*)(QT + (32 * cw + 16 * it + n16) * IMG_P + 64 * ks + 16 * kq);
      pg8::f32x4 at[2];
#pragma unroll
      for (int jt = 0; jt < 2; ++jt) { pg8::f32x4 a = {0.f, 0.f, 0.f, 0.f};
          if (jt <= it) {
#pragma unroll
              for (int ks = 0; ks < 2; ++ks) { const ch_bf16x8 kf = *(const LAS ch_bf16x8*)(KT + (32 * cw + 16 * jt + n16) * IMG_P + 64 * ks + 16 * kq); a = __builtin_amdgcn_mfma_f32_16x16x32_bf16(kf, qf[ks], a, 0, 0, 0); }
              const int ii = 16 * it + n16, j0 = 16 * jt + 4 * kq;
              a[0] = (j0 + 0 <= ii) ? a[0] : 0.f; a[1] = (j0 + 1 <= ii) ? a[1] : 0.f; a[2] = (j0 + 2 <= ii) ? a[2] : 0.f; a[3] = (j0 + 3 <= ii) ? a[3] : 0.f; }
          at[jt] = a; }
      const ch_bf16x8 pa = pack8(at[0], at[1]);
      const LAS unsigned char* vb = VV + (32 * cw + 4 * kq + q4) * IMG_P + 8 * p4;
      bf16_t* ob = (bf16_t*)(C.ws + WS_BR) + (size_t)3 * T * 512 + (row0 + 32 * cw + 16 * it + n16) * 512 + head * 64 + 4 * kq;
#pragma unroll
      for (int vt = 0; vt < 4; ++vt) { pg8::f32x4 o = {0.f, 0.f, 0.f, 0.f};
          o = __builtin_amdgcn_mfma_f32_16x16x32_bf16(tr_pair(vb + 32 * vt, vb + 16 * IMG_P + 32 * vt), pa, o, 0, 0, 0);
          u32x2 w; w.x = pk2(o[0], o[1]); w.y = pk2(o[2], o[3]); *(u32x2*)(ob + 16 * vt) = w; } }
    __syncthreads();
}
struct Hg2A { ch_bf16x8 vtf; ch_bf16x8 khf[4]; f32x4 dd[4]; };
__device__ __forceinline__ void hg2a_load(Hg2A& o, const bf16_t* KHT, const bf16_t* VT, const float* DG, size_t cgi, int wv, int lane) {
    const int n16 = lane & 15, kq = lane >> 4;
    o.vtf = *(const ch_bf16x8*)(VT + (cgi * 64 + 16 * wv + n16) * 32 + 8 * kq);
#pragma unroll
    for (int kt = 0; kt < 4; ++kt) { o.khf[kt] = *(const ch_bf16x8*)(KHT + (cgi * 64 + 16 * kt + n16) * 32 + 8 * kq); o.dd[kt] = *(const f32x4*)(DG + cgi * 64 + 16 * kt + 4 * kq); }
}
struct Hg2B { ch_bf16x8 qf[2][2]; u32x2 ov[2]; };
__device__ __forceinline__ void hg2b_load(Hg2B& o, const bf16_t* QG, const bf16_t* O, size_t crow, int wv, int head, int lane) {
    const int n16 = lane & 15, kq = lane >> 4;
#pragma unroll
    for (int it = 0; it < 2; ++it) { const bf16_t* qp = QG + (crow + 16 * it + n16) * 512 + head * 64 + 8 * kq; o.qf[it][0] = *(const ch_bf16x8*)qp; o.qf[it][1] = *(const ch_bf16x8*)(qp + 32);
        o.ov[it] = *(const u32x2*)(O + (crow + 16 * it + n16) * 512 + head * 64 + 16 * wv + 4 * kq); }
}
__device__ __forceinline__ void hgrn_pass2(const Ctx& C, int chain, int wv) {
    PH_IDS();
    const int n16 = lane & 15, kq = lane >> 4;
    const int head = chain & 7, b = chain >> 3, grp = wave;
    const bf16_t* QG = (const bf16_t*)(C.ws + WS_QG); const bf16_t* KHT = (const bf16_t*)(C.ws + WS_KHT); const bf16_t* VT = (const bf16_t*)(C.ws + WS_VT); const float* DG = (const float*)(C.ws + WS_DG);
    bf16_t* O = (bf16_t*)(C.ws + WS_BR) + (size_t)3 * T * 512;
    LAS f32x4* X = (LAS f32x4*)C.lds;
    pg8::f32x4 S[4], Dp[4];
#pragma unroll
    for (int kt = 0; kt < 4; ++kt) { S[kt] = (pg8::f32x4){0.f, 0.f, 0.f, 0.f}; Dp[kt] = (pg8::f32x4){1.f, 1.f, 1.f, 1.f}; }
    const size_t cg0 = (size_t)chain * 128 + 16 * grp;
    { Hg2A cur, nx1; hg2a_load(cur, KHT, VT, DG, cg0, wv, lane); hg2a_load(nx1, KHT, VT, DG, cg0 + 1, wv, lane);
      for (int c = 0; c < 16; ++c) {
          Hg2A nxt; hg2a_load(nxt, KHT, VT, DG, cg0 + (c + 2 < 16 ? c + 2 : 15), wv, lane);
#pragma unroll
          for (int kt = 0; kt < 4; ++kt) { pg8::f32x4 sl = {0.f, 0.f, 0.f, 0.f};
              sl = __builtin_amdgcn_mfma_f32_16x16x32_bf16(cur.khf[kt], cur.vtf, sl, 0, 0, 0);
              S[kt][0] = cur.dd[kt].x * S[kt][0] + sl[0]; S[kt][1] = cur.dd[kt].y * S[kt][1] + sl[1]; S[kt][2] = cur.dd[kt].z * S[kt][2] + sl[2]; S[kt][3] = cur.dd[kt].w * S[kt][3] + sl[3];
              Dp[kt][0] *= cur.dd[kt].x; Dp[kt][1] *= cur.dd[kt].y; Dp[kt][2] *= cur.dd[kt].z; Dp[kt][3] *= cur.dd[kt].w; }
          cur = nx1; nx1 = nxt;
      } }
#pragma unroll
    for (int kt = 0; kt < 4; ++kt) { X[(grp * 8 + kt) * 64 + lane] = (f32x4){Dp[kt][0], Dp[kt][1], Dp[kt][2], Dp[kt][3]}; X[(grp * 8 + 4 + kt) * 64 + lane] = (f32x4){S[kt][0], S[kt][1], S[kt][2], S[kt][3]}; }
    __syncthreads();
#pragma unroll
    for (int kt = 0; kt < 4; ++kt) S[kt] = (pg8::f32x4){0.f, 0.f, 0.f, 0.f};
    for (int g = 0; g < grp; ++g) {
#pragma unroll
        for (int kt = 0; kt < 4; ++kt) { const f32x4 d = X[(g * 8 + kt) * 64 + lane], lq = X[(g * 8 + 4 + kt) * 64 + lane];
            S[kt][0] = d.x * S[kt][0] + lq.x; S[kt][1] = d.y * S[kt][1] + lq.y; S[kt][2] = d.z * S[kt][2] + lq.z; S[kt][3] = d.w * S[kt][3] + lq.w; }
    }
    { Hg2A cur, na1; hg2a_load(cur, KHT, VT, DG, cg0, wv, lane); hg2a_load(na1, KHT, VT, DG, cg0 + 1, wv, lane);
      Hg2B cub, nb1; hg2b_load(cub, QG, O, (size_t)b * SEQ + (size_t)(16 * grp) * 32, wv, head, lane); hg2b_load(nb1, QG, O, (size_t)b * SEQ + (size_t)(16 * grp + 1) * 32, wv, head, lane);
      for (int c = 0; c < 16; ++c) {
          const int cn = (c + 2 < 16 ? c + 2 : 15);
          Hg2A nxt; hg2a_load(nxt, KHT, VT, DG, cg0 + cn, wv, lane);
          Hg2B nxb; hg2b_load(nxb, QG, O, (size_t)b * SEQ + (size_t)(16 * grp + cn) * 32, wv, head, lane);
          if (grp > 0 || c > 0) {
              const ch_bf16x8 sb0 = pack8(S[0], S[1]), sb1 = pack8(S[2], S[3]);
              const size_t crow = (size_t)b * SEQ + (size_t)(16 * grp + c) * 32;
#pragma unroll
              for (int it = 0; it < 2; ++it) {
                  pg8::f32x4 a = {0.f, 0.f, 0.f, 0.f};
                  a = __builtin_amdgcn_mfma_f32_16x16x32_bf16(sb0, cub.qf[it][0], a, 0, 0, 0);
                  a = __builtin_amdgcn_mfma_f32_16x16x32_bf16(sb1, cub.qf[it][1], a, 0, 0, 0);
                  u32x2 w; w.x = pk2(lo2f(cub.ov[it].x) + a[0], hi2f(cub.ov[it].x) + a[1]); w.y = pk2(lo2f(cub.ov[it].y) + a[2], hi2f(cub.ov[it].y) + a[3]);
                  *(u32x2*)(O + (crow + 16 * it + n16) * 512 + head * 64 + 16 * wv + 4 * kq) = w;
              }
          }
#pragma unroll
          for (int kt = 0; kt < 4; ++kt) { pg8::f32x4 sl = {0.f, 0.f, 0.f, 0.f};
              sl = __builtin_amdgcn_mfma_f32_16x16x32_bf16(cur.khf[kt], cur.vtf, sl, 0, 0, 0);
              S[kt][0] = cur.dd[kt].x * S[kt][0] + sl[0]; S[kt][1] = cur.dd[kt].y * S[kt][1] + sl[1]; S[kt][2] = cur.dd[kt].z * S[kt][2] + sl[2]; S[kt][3] = cur.dd[kt].w * S[kt][3] + sl[3]; }
          cur = na1; na1 = nxt; cub = nb1; nb1 = nxb;
      } }
}

#ifndef PROBE_MASK
#define PROBE_MASK 0
#endif
#ifndef PROBE_AMP
#define PROBE_AMP 1
#endif
#ifndef PROBE_BLOCK
#define PROBE_BLOCK 0
#endif
#if PROBE_MASK
#define PROBE_INIT() do { if (C.bid == PROBE_BLOCK && threadIdx.x == 0) { const unsigned long long t0_ = __builtin_amdgcn_s_memrealtime(); MISCW(C)[10] = (unsigned)t0_; MISCW(C)[11] = (unsigned)(t0_ >> 32); MISCW(C)[12] = 0u; MISCW(C)[13] = 0u; } } while (0)
#define PROBE_MARK(k) do { if (C.bid == PROBE_BLOCK && threadIdx.x == 0) { const unsigned long long n_ = __builtin_amdgcn_s_memrealtime(); const unsigned long long p_ = ((unsigned long long)MISCW(C)[11] << 32) | MISCW(C)[10]; \
    if ((PROBE_MASK >> (k)) & 1) { unsigned long long a_ = ((unsigned long long)MISCW(C)[13] << 32) | MISCW(C)[12]; a_ += n_ - p_; MISCW(C)[12] = (unsigned)a_; MISCW(C)[13] = (unsigned)(a_ >> 32); } \
    MISCW(C)[10] = (unsigned)n_; MISCW(C)[11] = (unsigned)(n_ >> 32); } } while (0)
#define PROBE_FINISH() do { if (C.bid == PROBE_BLOCK && threadIdx.x == 0) { const unsigned long long a_ = (((unsigned long long)MISCW(C)[13] << 32) | MISCW(C)[12]) * PROBE_AMP; const unsigned long long s_ = __builtin_amdgcn_s_memrealtime(); \
    while (__builtin_amdgcn_s_memrealtime() - s_ < a_) __builtin_amdgcn_s_sleep(16); } } while (0)
#else
#define PROBE_INIT() do {} while (0)
#define PROBE_MARK(k) do {} while (0)
#define PROBE_FINISH() do {} while (0)
#endif
typedef short dl_bf16x8 __attribute__((ext_vector_type(8)));
typedef short dl_s16x4 __attribute__((ext_vector_type(4)));
__device__ __forceinline__ void dilated_unit(const Ctx& C, int u) {
    PH_IDS();
    constexpr int VP = 288;
    const int g = 2 - (u >> 8), v = u & 255;
    int b, r, j, qblk, dil;
    if (g == 0) { dil = 1; b = v >> 6; r = 0; j = (v >> 4) & 3; qblk = v & 15; }
    else if (g == 1) { dil = 4; b = v >> 6; r = (v >> 4) & 3; j = (v >> 2) & 3; qblk = v & 3; }
    else { dil = 16; b = v >> 6; r = (v >> 2) & 15; j = v & 3; qblk = 0; }
    const int hh = g * 4 + j;
    const size_t rstride = (size_t)dil * PLD;
    const bf16_t* base = (const bf16_t*)(C.ws + WS_P) + ((size_t)b * SEQ + r) * PLD;
    const int qs = qblk * 256, ks0 = qs - 128;
    LAS unsigned char* Vs = C.lds;
#pragma unroll
    for (int k = 0; k < 12; ++k) { const int c = tid + 512 * k, i = c >> 4, ch = c & 15; int li = ks0 + i; li = li < 0 ? 0 : li;
        const u32x4 vv = *(const u32x4*)(base + (size_t)li * rstride + C_VB + hh * 128 + ch * 8);
        *(LAS u32x4*)(Vs + i * VP + ch * 16) = vv; }
    const int n16 = lane & 15, kq = lane >> 4;
    const int q0 = qs + 32 * wave;
    dl_bf16x8 qf[2][4];
#pragma unroll
    for (int qt = 0; qt < 2; ++qt) { const bf16_t* qp = base + (size_t)(q0 + 16 * qt + n16) * rstride + C_QB + hh * 128 + kq * 8;
#pragma unroll
        for (int s4 = 0; s4 < 4; ++s4) qf[qt][s4] = *(const dl_bf16x8*)(qp + s4 * 32); }
    pg8::f32x4 st[2][9];
    dl_bf16x8 kfa[4][4], kfb[3][4];
#define DIL_KLOAD(dst, tl_) do { int kt_ = q0 - 128 + 16 * (tl_) + n16; kt_ = kt_ < 0 ? 0 : kt_; const bf16_t* kp_ = base + (size_t)kt_ * rstride + C_KB + hh * 128 + kq * 8; \
        _Pragma("unroll") for (int s4 = 0; s4 < 4; ++s4) (dst)[s4] = *(const dl_bf16x8*)(kp_ + s4 * 32); } while (0)
#define DIL_QK(src, tl_) do { if ((tl_) <= 8) { pg8::f32x4 a_ = {0.f, 0.f, 0.f, 0.f}; _Pragma("unroll") for (int s4 = 0; s4 < 4; ++s4) a_ = __builtin_amdgcn_mfma_f32_16x16x32_bf16((src)[s4], qf[0][s4], a_, 0, 0, 0); st[0][(tl_) <= 8 ? (tl_) : 0] = a_; } \
        if ((tl_) >= 1) { pg8::f32x4 a_ = {0.f, 0.f, 0.f, 0.f}; _Pragma("unroll") for (int s4 = 0; s4 < 4; ++s4) a_ = __builtin_amdgcn_mfma_f32_16x16x32_bf16((src)[s4], qf[1][s4], a_, 0, 0, 0); st[1][(tl_) >= 1 ? (tl_) - 1 : 0] = a_; } } while (0)
#pragma unroll
    for (int t = 0; t < 4; ++t) DIL_KLOAD(kfa[t], t);
#pragma unroll
    for (int t = 0; t < 3; ++t) DIL_KLOAD(kfb[t], 4 + t);
    asm volatile("" ::: "memory");
#pragma unroll
    for (int t = 0; t < 4; ++t) DIL_QK(kfa[t], t);
#pragma unroll
    for (int t = 0; t < 3; ++t) DIL_KLOAD(kfa[t], 7 + t);
    asm volatile("" ::: "memory");
#pragma unroll
    for (int t = 0; t < 3; ++t) DIL_QK(kfb[t], 4 + t);
#pragma unroll
    for (int t = 0; t < 3; ++t) DIL_QK(kfa[t], 7 + t);
#undef DIL_KLOAD
#undef DIL_QK
    const float sc2 = 0.08838834764831845f * 1.4426950408889634f;
    float mxq[2], lsq[2];
#pragma unroll
    for (int qt = 0; qt < 2; ++qt) {
        const int q0t = q0 + 16 * qt;
        float mx = -3.0e38f;
        if (q0t >= 128) {
#pragma unroll
            for (int i = 0; i < 4; ++i) { st[qt][0][i] = (4 * kq + i >= n16) ? st[qt][0][i] : -3.0e38f; st[qt][8][i] = (4 * kq + i <= n16) ? st[qt][8][i] : -3.0e38f; }
        } else {
#pragma unroll
            for (int tt = 0; tt < 9; ++tt)
#pragma unroll
                for (int i = 0; i < 4; ++i) { const int dist = 128 + n16 - 16 * tt - 4 * kq - i; const int kidx = q0t - 128 + 16 * tt + 4 * kq + i;
                    const bool valid = (dist >= 0) && (dist <= 128) && (kidx >= 0);
                    st[qt][tt][i] = valid ? st[qt][tt][i] : -3.0e38f; }
        }
#pragma unroll
        for (int tt = 0; tt < 9; ++tt)
#pragma unroll
            for (int i = 0; i < 4; ++i) mx = fmaxf(mx, st[qt][tt][i]);
        mx = fmaxf(mx, __int_as_float(__builtin_amdgcn_ds_bpermute((lane ^ 16) << 2, __float_as_int(mx))));
        mx = fmaxf(mx, __int_as_float(__builtin_amdgcn_ds_bpermute((lane ^ 32) << 2, __float_as_int(mx))));
        float lsum = 0.f;
#pragma unroll
        for (int tt = 0; tt < 9; ++tt)
#pragma unroll
            for (int i = 0; i < 4; ++i) { const float p = (st[qt][tt][i] > -1.0e38f) ? __builtin_amdgcn_exp2f((st[qt][tt][i] - mx) * sc2) : 0.f; st[qt][tt][i] = p; lsum += p; }
        lsum += __int_as_float(__builtin_amdgcn_ds_bpermute((lane ^ 16) << 2, __float_as_int(lsum)));
        lsum += __int_as_float(__builtin_amdgcn_ds_bpermute((lane ^ 32) << 2, __float_as_int(lsum)));
        mxq[qt] = mx; lsq[qt] = lsum;
    }
    const pg8::f32x4 zero4 = {0.f, 0.f, 0.f, 0.f};
    dl_bf16x8 pa[2][5];
#pragma unroll
    for (int ks = 0; ks < 5; ++ks) {
        pa[0][ks] = pack8(st[0][2 * ks], (2 * ks + 1 <= 8) ? st[0][(2 * ks + 1 <= 8) ? 2 * ks + 1 : 8] : zero4);
        pa[1][ks] = pack8((ks > 0) ? st[1][(ks > 0) ? 2 * ks - 1 : 0] : zero4, st[1][2 * ks]);
    }
    __syncthreads();
    pg8::f32x4 o[2][8];
#pragma unroll
    for (int qt = 0; qt < 2; ++qt)
#pragma unroll
        for (int c = 0; c < 8; ++c) o[qt][c] = zero4;
    const int q4 = (lane & 15) >> 2, p4 = lane & 3;
    const LAS unsigned char* vb = Vs + (32 * wave + 4 * kq + q4) * VP + 8 * p4;
#pragma unroll
    for (int ks = 0; ks < 5; ++ks) {
#pragma unroll
        for (int c = 0; c < 8; ++c) {
            const dl_bf16x8 bfr = tr_pair(vb + (32 * ks) * VP + 32 * c, vb + (32 * ks + 16) * VP + 32 * c);
            o[0][c] = __builtin_amdgcn_mfma_f32_16x16x32_bf16(bfr, pa[0][ks], o[0][c], 0, 0, 0);
            o[1][c] = __builtin_amdgcn_mfma_f32_16x16x32_bf16(bfr, pa[1][ks], o[1][c], 0, 0, 0);
        }
    }
    bf16_t* OG = (g == 2) ? (bf16_t*)(C.ws + WS_BR) + (size_t)T * 512 : (bf16_t*)(C.ws + WS_MIXS) + (size_t)g * T * 512;
    float* LSE = (float*)(C.ws + WS_LSE) + (size_t)g * T * 4;
    const size_t trow0 = (size_t)b * SEQ + r;
#pragma unroll
    for (int qt = 0; qt < 2; ++qt) {
        const float inv = __builtin_amdgcn_rcpf(lsq[qt]);
        bf16_t* op = OG + (trow0 + (size_t)(q0 + 16 * qt + n16) * dil) * 512 + j * 128 + 4 * kq;
#pragma unroll
        for (int c = 0; c < 8; ++c) { u32x2 w; w.x = pk2(o[qt][c][0] * inv, o[qt][c][1] * inv); w.y = pk2(o[qt][c][2] * inv, o[qt][c][3] * inv); *(u32x2*)(op + 16 * c) = w; }
        if (kq == 0) LSE[(trow0 + (size_t)(q0 + 16 * qt + n16) * dil) * 4 + j] = mxq[qt] * 0.08838834764831845f + __logf(lsq[qt]);
    }
}

__device__ __forceinline__ void phase_mix_a(const Ctx& C, int l) {
#ifndef NO_CHAIN
    for (int u = C.bid; u < 1024; u += C.G) ssd_pass1(C, l, u);
    PROBE_MARK(18);
    for (int u = C.bid; u < 1024; u += C.G) hgrn_pass1(C, l, u);
    PROBE_MARK(19);
#endif
}
__device__ __forceinline__ void phase_mix_b(const Ctx& C, int l) {
    PH_IDS();
    unsigned* wq = (unsigned*)(C.ws + WS_CTL) + CW_WQ + 64 * (2 * l);
    unsigned* p2done = (unsigned*)(C.ws + WS_CTL) + CW_P2 + 64 * l;
#ifndef NO_CHAIN
    if (C.bid < 64) ssd_pass2(C, C.bid >> 1, wave & 3, ((C.bid & 1) << 1) | (wave >> 2));
    else if (C.bid < 192) hgrn_pass2(C, (C.bid - 64) >> 2, (C.bid - 64) & 3);
    if (C.bid < 192) { asm volatile("s_waitcnt vmcnt(0)" ::: "memory"); __syncthreads(); if (tid == 0) __hip_atomic_fetch_add(p2done, 1u, __ATOMIC_RELAXED, __HIP_MEMORY_SCOPE_AGENT); }
#endif
    PROBE_MARK(12);
    const attn_body::bf16* P = (const attn_body::bf16*)(C.ws + WS_P); attn_body::bf16* O16 = (attn_body::bf16*)(C.ws + WS_O16);
#ifndef NO_ATTN
    for (;;) {
        __syncthreads();
        if (tid == 0) MISCW(C)[4] = atomicAdd(wq, 1u);
        __syncthreads();
        const int u = (int)MISCW(C)[4]; if (u >= 1024) break;
        const int qb = 15 - (u >> 6), bh = u & 63, b = bh >> 4, hp = bh & 15, i = hp >> 1, half = hp & 1;
        const size_t r0 = (size_t)b * SEQ;
        attn_body::attn_unit<8, PLD, 1024>(qb, P + r0 * PLD + C_QC + i * 64, P + r0 * PLD + C_KC + i * 64, P + r0 * PLD + C_VC + (i >> 1) * 128 + half * 64, O16 + r0 * 1024 + hp * 64, (char*)C.lds);
    }
#endif
    PROBE_MARK(13);
#ifndef NO_DIL
    if (tid == 0) { unsigned sp = 0; while (__hip_atomic_load(p2done, __ATOMIC_RELAXED, __HIP_MEMORY_SCOPE_AGENT) < 192u) { __builtin_amdgcn_s_sleep(8); if (++sp > (1u << 22)) break; } }
    for (;;) {
        __syncthreads();
        if (tid == 0) MISCW(C)[4] = atomicAdd(wq + 64, 1u);
        __syncthreads();
        const int u = (int)MISCW(C)[4]; if (u >= 768) break;
        dilated_unit(C, u);
    }
#endif
    PROBE_MARK(14);
}

__device__ __forceinline__ void phase_comb(const Ctx& C, int l) {
    PH_IDS();
    if (tid < 64) {
        const float* dl = INP(I_DLAM) + l * 256;
        const float s1 = wave_sum(dl[lane] * dl[64 + lane]), s2 = wave_sum(dl[128 + lane] * dl[192 + lane]);
        const float lam_init = (l == 0) ? 0.2f : 0.35550907f;
        if (tid == 0) { MISCW(C)[6] = __float_as_uint(expf(s1) - expf(s2) + lam_init); MISCW(C)[7] = __float_as_uint(1.0f - lam_init); }
    }
    __syncthreads();
    const float lam = __uint_as_float(MISCW(C)[6]), oml = __uint_as_float(MISCW(C)[7]);
    const int gw = C.bid * NWAVES + wave, NGW = C.G * NWAVES;
    const bf16_t* O16 = (const bf16_t*)(C.ws + WS_O16); bf16_t* BR = (bf16_t*)(C.ws + WS_BR) + (size_t)2 * T * 512;
    float swl[8];
    { const float* sp = INP(I_SUBLN) + l * 128 + 8 * (lane & 15);
#pragma unroll
      for (int e = 0; e < 8; ++e) swl[e] = sp[e]; }
    const bf16_t* OG0 = (const bf16_t*)(C.ws + WS_MIXS); const bf16_t* OG1 = OG0 + (size_t)T * 512; bf16_t* OG2 = (bf16_t*)(C.ws + WS_BR) + (size_t)T * 512;
    const float* LSE = (const float*)(C.ws + WS_LSE);
    bf16_t* BR0 = (bf16_t*)(C.ws + WS_BR); bf16_t* BR3 = BR0 + (size_t)3 * T * 512; const bf16_t* Pp = (const bf16_t*)(C.ws + WS_P);
    float nwa[8], nwd[8];
    { const float* a = INP(I_SSDNW) + l * 512 + 8 * lane; const float* d = INP(I_HGNW) + l * 64 + 8 * (lane & 7);
#pragma unroll
      for (int e = 0; e < 8; ++e) { nwa[e] = a[e]; nwd[e] = d[e]; } }
    struct CombIn { u32x4 yv, zv, ov, gv, a, bb, cc, av, bv; float l0, l1, l2; };
    const int jj = lane >> 4, hq = lane >> 4, e0 = 8 * (lane & 15), half = e0 >> 6, ee = e0 & 63;
#define COMB_LOAD(I, row_) do { const size_t r_ = (size_t)(row_); \
        (I).yv = *(const u32x4*)(BR0 + r_ * 512 + 8 * lane); (I).zv = *(const u32x4*)(Pp + r_ * PLD + C_Z + 8 * lane); \
        (I).ov = *(const u32x4*)(BR3 + r_ * 512 + 8 * lane); (I).gv = *(const u32x4*)(Pp + r_ * PLD + C_GD + 8 * lane); \
        (I).a = *(const u32x4*)(OG0 + r_ * 512 + 8 * lane); (I).bb = *(const u32x4*)(OG1 + r_ * 512 + 8 * lane); (I).cc = *(const u32x4*)(OG2 + r_ * 512 + 8 * lane); \
        (I).av = *(const u32x4*)(O16 + r_ * 1024 + (4 * hq + half) * 64 + ee); (I).bv = *(const u32x4*)(O16 + r_ * 1024 + (4 * hq + 2 + half) * 64 + ee); \
        (I).l0 = LSE[r_ * 4 + jj]; (I).l1 = LSE[((size_t)T + r_) * 4 + jj]; (I).l2 = LSE[((size_t)2 * T + r_) * 4 + jj]; } while (0)
    CombIn cur; COMB_LOAD(cur, gw);
    for (int row = gw; row < T; row += NGW) {
        CombIn nxt; COMB_LOAD(nxt, (row + NGW < T) ? row + NGW : row);
        {
            const u32x4 yv = cur.yv, zv = cur.zv;
            float u[8];
            u[0] = lo2f(yv.x) * siluf_(lo2f(zv.x)); u[1] = hi2f(yv.x) * siluf_(hi2f(zv.x)); u[2] = lo2f(yv.y) * siluf_(lo2f(zv.y)); u[3] = hi2f(yv.y) * siluf_(hi2f(zv.y));
            u[4] = lo2f(yv.z) * siluf_(lo2f(zv.z)); u[5] = hi2f(yv.z) * siluf_(hi2f(zv.z)); u[6] = lo2f(yv.w) * siluf_(lo2f(zv.w)); u[7] = hi2f(yv.w) * siluf_(hi2f(zv.w));
            float ss = 0.f;
#pragma unroll
            for (int e = 0; e < 8; ++e) ss += u[e] * u[e];
            const float rstd = rsqrtf(wave_sum(ss) * (1.0f / 512.0f) + EPS);
            u32x4 w; w.x = pk2(u[0] * rstd * nwa[0], u[1] * rstd * nwa[1]); w.y = pk2(u[2] * rstd * nwa[2], u[3] * rstd * nwa[3]); w.z = pk2(u[4] * rstd * nwa[4], u[5] * rstd * nwa[5]); w.w = pk2(u[6] * rstd * nwa[6], u[7] * rstd * nwa[7]);
            *(u32x4*)(BR0 + (size_t)row * 512 + 8 * lane) = w;
        }
        {
            const u32x4 ov = cur.ov, gv = cur.gv;
            float o[8]; o[0] = lo2f(ov.x); o[1] = hi2f(ov.x); o[2] = lo2f(ov.y); o[3] = hi2f(ov.y); o[4] = lo2f(ov.z); o[5] = hi2f(ov.z); o[6] = lo2f(ov.w); o[7] = hi2f(ov.w);
            float ss = 0.f;
#pragma unroll
            for (int e = 0; e < 8; ++e) ss += o[e] * o[e];
            ss += __int_as_float(__builtin_amdgcn_ds_bpermute((lane ^ 1) << 2, __float_as_int(ss)));
            ss += __int_as_float(__builtin_amdgcn_ds_bpermute((lane ^ 2) << 2, __float_as_int(ss)));
            ss += __int_as_float(__builtin_amdgcn_ds_bpermute((lane ^ 4) << 2, __float_as_int(ss)));
            const float rstd = rsqrtf(ss * (1.0f / 64.0f) + EPS);
            u32x4 w;
            w.x = pk2(o[0] * rstd * nwd[0] * siluf_(lo2f(gv.x)), o[1] * rstd * nwd[1] * siluf_(hi2f(gv.x))); w.y = pk2(o[2] * rstd * nwd[2] * siluf_(lo2f(gv.y)), o[3] * rstd * nwd[3] * siluf_(hi2f(gv.y)));
            w.z = pk2(o[4] * rstd * nwd[4] * siluf_(lo2f(gv.z)), o[5] * rstd * nwd[5] * siluf_(hi2f(gv.z))); w.w = pk2(o[6] * rstd * nwd[6] * siluf_(lo2f(gv.w)), o[7] * rstd * nwd[7] * siluf_(hi2f(gv.w)));
            *(u32x4*)(BR3 + (size_t)row * 512 + 8 * lane) = w;
        }
        {
            const float l0 = cur.l0, l1 = cur.l1, l2 = cur.l2;
            const float M = fmaxf(fmaxf(l0, l1), l2); const float x0 = __expf(l0 - M), x1 = __expf(l1 - M), x2 = __expf(l2 - M); const float inv = __builtin_amdgcn_rcpf(x0 + x1 + x2);
            const float c0 = x0 * inv, c1 = x1 * inv, c2 = x2 * inv;
            const u32x4 a = cur.a, bb = cur.bb, cc = cur.cc;
            u32x4 w;
            w.x = pk2(c0 * lo2f(a.x) + c1 * lo2f(bb.x) + c2 * lo2f(cc.x), c0 * hi2f(a.x) + c1 * hi2f(bb.x) + c2 * hi2f(cc.x));
            w.y = pk2(c0 * lo2f(a.y) + c1 * lo2f(bb.y) + c2 * lo2f(cc.y), c0 * hi2f(a.y) + c1 * hi2f(bb.y) + c2 * hi2f(cc.y));
            w.z = pk2(c0 * lo2f(a.z) + c1 * lo2f(bb.z) + c2 * lo2f(cc.z), c0 * hi2f(a.z) + c1 * hi2f(bb.z) + c2 * hi2f(cc.z));
            w.w = pk2(c0 * lo2f(a.w) + c1 * lo2f(bb.w) + c2 * lo2f(cc.w), c0 * hi2f(a.w) + c1 * hi2f(bb.w) + c2 * hi2f(cc.w));
            *(u32x4*)(OG2 + (size_t)row * 512 + 8 * lane) = w;
        }
        {
            const u32x4 av = cur.av, bv = cur.bv;
            float d[8];
            d[0] = lo2f(av.x) - lam * lo2f(bv.x); d[1] = hi2f(av.x) - lam * hi2f(bv.x); d[2] = lo2f(av.y) - lam * lo2f(bv.y); d[3] = hi2f(av.y) - lam * hi2f(bv.y);
            d[4] = lo2f(av.z) - lam * lo2f(bv.z); d[5] = hi2f(av.z) - lam * hi2f(bv.z); d[6] = lo2f(av.w) - lam * lo2f(bv.w); d[7] = hi2f(av.w) - lam * hi2f(bv.w);
            float ss = 0.f;
#pragma unroll
            for (int e = 0; e < 8; ++e) ss += d[e] * d[e];
            ss += __int_as_float(__builtin_amdgcn_ds_bpermute((lane ^ 1) << 2, __float_as_int(ss)));
            ss += __int_as_float(__builtin_amdgcn_ds_bpermute((lane ^ 2) << 2, __float_as_int(ss)));
            ss += __int_as_float(__builtin_amdgcn_ds_bpermute((lane ^ 4) << 2, __float_as_int(ss)));
            ss += __int_as_float(__builtin_amdgcn_ds_bpermute((lane ^ 8) << 2, __float_as_int(ss)));
            const float rstd = rsqrtf(ss * (1.0f / 128.0f) + EPS) * oml;
            u32x4 w; w.x = pk2(d[0] * rstd * swl[0], d[1] * rstd * swl[1]); w.y = pk2(d[2] * rstd * swl[2], d[3] * rstd * swl[3]); w.z = pk2(d[4] * rstd * swl[4], d[5] * rstd * swl[5]); w.w = pk2(d[6] * rstd * swl[6], d[7] * rstd * swl[7]);
            *(u32x4*)(BR + (size_t)row * 512 + hq * 128 + e0) = w;
        }
        cur = nxt;
    }
#undef COMB_LOAD
}

using pg8::Unit; using pg8::HALF; using pg8::BM;
struct EpiMerge {
    static constexpr bool PERM = true, AFTER_DRAIN = false;
    const bf16_t* P; bf16_t* MS;
    __device__ __forceinline__ void operator()(const pg8::f32x4 (&acc)[2][2][4][2], const Unit& u, int wr, int wc, int fr, int fq) const {
        const int n = u.pn >> 2, pn = u.pn & 3, pm = u.pm & 63;
        const int row0 = pm * BM + wr * 64 + fr, col0 = pn * BM + wc * 32 + 8 * fq;
        u32x4 gl[2][2][2], pv[2][2][2];
#define MERGE_LOAD(B, Q) do { _Pragma("unroll") for (int m2 = 0; m2 < 2; ++m2) _Pragma("unroll") for (int bj = 0; bj < 2; ++bj) { \
            const unsigned row_ = (unsigned)(row0 + ((Q) >> 1) * HALF + (((Q) & 1) * 2 + m2) * 16), col_ = (unsigned)(col0 + bj * HALF); \
            gl[B][m2][bj] = *(const u32x4*)(P + (row_ * (unsigned)PLD + C_GATE + n * 1024 + col_)); \
            pv[B][m2][bj] = (n > 0) ? *(const u32x4*)(MS + (row_ * DM + col_)) : (u32x4){0u, 0u, 0u, 0u}; } } while (0)
#define MERGE_CALC(B, Q) do { _Pragma("unroll") for (int m2 = 0; m2 < 2; ++m2) _Pragma("unroll") for (int bj = 0; bj < 2; ++bj) { \
            const int ai_ = (Q) >> 1, m_ = ((Q) & 1) * 2 + m2; const unsigned row_ = (unsigned)(row0 + ai_ * HALF + m_ * 16), col_ = (unsigned)(col0 + bj * HALF); \
            const pg8::f32x4 v0 = acc[ai_][bj][m_][0], v1 = acc[ai_][bj][m_][1]; const u32x4 g = gl[B][m2][bj], p = pv[B][m2][bj]; \
            float r[8]; \
            r[0] = sigmoidf_(lo2f(g.x)) * v0[0] + lo2f(p.x); r[1] = sigmoidf_(hi2f(g.x)) * v0[1] + hi2f(p.x); r[2] = sigmoidf_(lo2f(g.y)) * v0[2] + lo2f(p.y); r[3] = sigmoidf_(hi2f(g.y)) * v0[3] + hi2f(p.y); \
            r[4] = sigmoidf_(lo2f(g.z)) * v1[0] + lo2f(p.z); r[5] = sigmoidf_(hi2f(g.z)) * v1[1] + hi2f(p.z); r[6] = sigmoidf_(lo2f(g.w)) * v1[2] + lo2f(p.w); r[7] = sigmoidf_(hi2f(g.w)) * v1[3] + hi2f(p.w); \
            u32x4 w; w.x = pk2(r[0], r[1]); w.y = pk2(r[2], r[3]); w.z = pk2(r[4], r[5]); w.w = pk2(r[6], r[7]); \
            *(u32x4*)(MS + (row_ * DM + col_)) = w; } } while (0)
        MERGE_LOAD(0, 0); MERGE_LOAD(1, 1);
        MERGE_CALC(0, 0); MERGE_LOAD(0, 2);
        MERGE_CALC(1, 1); MERGE_LOAD(1, 3);
        MERGE_CALC(0, 2);
        MERGE_CALC(1, 3);
#undef MERGE_LOAD
#undef MERGE_CALC
    }
};
struct OrderMerge { int G, c;
    __device__ __forceinline__ bool next(int i, Unit& u) const { const int L = (i >> 2) * G + c; if (L >= 256) return false; const int n = i & 3; u.pm = n * 64 + (L >> 2); u.pn = n * 4 + (L & 3); return true; }
    __device__ __forceinline__ void a_ready(const Unit&) const {}
    __device__ __forceinline__ void done(const Unit&) const {}
};
struct EpiWout {
    static constexpr bool PERM = false, AFTER_DRAIN = false;
    const float* xin; float* xout; const float* g1;
    __device__ __forceinline__ void operator()(const pg8::f32x4 (&acc)[2][2][4][2], const Unit& u, int wr, int wc, int fr, int fq) const {
        const int row0 = u.pm * BM + wr * 64 + fr, col0 = u.pn * BM + wc * 32 + 4 * fq;
        const float* g = g1 + (size_t)(row0 >> 12) * 6144;
        pg8::f32x4 gv[2][2];
#pragma unroll
        for (int bj = 0; bj < 2; ++bj)
#pragma unroll
            for (int n = 0; n < 2; ++n) gv[bj][n] = *(const pg8::f32x4*)(g + col0 + bj * HALF + n * 16);
#pragma unroll
        for (int am = 0; am < 4; ++am) { const int ai = am >> 1, m0 = (am & 1) * 2;
            pg8::f32x4 xv[2][2][2];
#pragma unroll
            for (int m = 0; m < 2; ++m)
#pragma unroll
                for (int bj = 0; bj < 2; ++bj)
#pragma unroll
                    for (int n = 0; n < 2; ++n) xv[m][bj][n] = *(const pg8::f32x4*)(xin + ((unsigned)(row0 + ai * HALF + (m0 + m) * 16) * DM + col0 + bj * HALF + n * 16));
#pragma unroll
            for (int m = 0; m < 2; ++m)
#pragma unroll
                for (int bj = 0; bj < 2; ++bj)
#pragma unroll
                    for (int n = 0; n < 2; ++n) *(pg8::f32x4*)(xout + ((unsigned)(row0 + ai * HALF + (m0 + m) * 16) * DM + col0 + bj * HALF + n * 16)) = xv[m][bj][n] + gv[bj][n] * acc[ai][bj][m0 + m][n];
        }
    }
};
struct EpiMoe1 {
    static constexpr bool PERM = true, AFTER_DRAIN = false;
    bf16_t* HID;
    __device__ __forceinline__ void operator()(const pg8::f32x4 (&acc)[2][2][4][2], const Unit& u, int wr, int wc, int fr, int fq) const {
        const int j = u.pn & 1, row0 = u.pm * BM + wr * 64 + fr, c0 = 128 * j + 16 * wc + 4 * fq;
#pragma unroll
        for (int ai = 0; ai < 2; ++ai)
#pragma unroll
            for (int m = 0; m < 4; ++m) { bf16_t* rp = HID + ((unsigned)(row0 + ai * HALF + m * 16) * 256u + c0);
#pragma unroll
                for (int bj = 0; bj < 2; ++bj) { const pg8::f32x4 g = acc[ai][bj][m][0], up = acc[ai][bj][m][1];
                    u32x2 w; w.x = pk2(siluf_(g[0]) * up[0], siluf_(g[1]) * up[1]); w.y = pk2(siluf_(g[2]) * up[2], siluf_(g[3]) * up[3]);
                    *(u32x2*)(rp + 64 * bj) = w; } }
    }
};
struct EpiMoe2 {
    static constexpr bool PERM = true, AFTER_DRAIN = false;
    bf16_t* Y;
    __device__ __forceinline__ void operator()(const pg8::f32x4 (&acc)[2][2][4][2], const Unit& u, int wr, int wc, int fr, int fq) const {
        const int j = u.pn & 3, row0 = u.pm * BM + wr * 64 + fr, c0 = 256 * j + 32 * wc + 8 * fq;
#pragma unroll
        for (int ai = 0; ai < 2; ++ai)
#pragma unroll
            for (int m = 0; m < 4; ++m) { const unsigned ro = (unsigned)(row0 + ai * HALF + m * 16) * DM + c0; bf16_t* rp = Y + ro;
#pragma unroll
                for (int bj = 0; bj < 2; ++bj) { const pg8::f32x4 v0 = acc[ai][bj][m][0], v1 = acc[ai][bj][m][1];
                    u32x4 w; w.x = pk2(v0[0], v0[1]); w.y = pk2(v0[2], v0[3]); w.z = pk2(v1[0], v1[1]); w.w = pk2(v1[2], v1[3]);
                    *(u32x4*)(rp + HALF * bj) = w; } }
    }
};
struct OrderList { const LAS int* lst;
    __device__ __forceinline__ bool next(int i, Unit& u) const { if (i >= lst[0]) return false; const int v = lst[1 + i]; u.pm = v >> 8; u.pn = v & 255; return true; }
    __device__ __forceinline__ void a_ready(const Unit&) const {}
    __device__ __forceinline__ void done(const Unit&) const {}
};
template <int SH> struct OrderMoe { int G, c, nunits; const LAS unsigned char* blk_e;
    __device__ __forceinline__ bool next(int i, Unit& u) const { const int L = i * G + c; if (L >= nunits) return false; u.pm = L >> SH; u.pn = ((int)blk_e[L >> SH] << SH) + (L & ((1 << SH) - 1)); return true; }
    __device__ __forceinline__ void a_ready(const Unit&) const {}
    __device__ __forceinline__ void done(const Unit&) const {}
};

struct Args { const float* in[25]; float* out; unsigned char* ws; };
__global__ void __launch_bounds__(NTHR, 2) mega_fwd(Args args) {
    extern __shared__ __attribute__((aligned(16))) unsigned char lds_raw[];
    Ctx C;
    C.out = args.out; C.ws = args.ws;
    C.lds = (LAS unsigned char*)lds_raw; C.G = gridDim.x; C.bid = blockIdx.x;
    { const int tid0 = threadIdx.x;
      for (int i = tid0; i < (LDS_BYTES - MISC_OFF) / 4; i += NTHR) MISCW(C)[i] = 0u;
      __syncthreads();
      if (tid0 < 25) { const unsigned long long p = (unsigned long long)args.in[tid0]; LAS unsigned* t = (LAS unsigned*)(C.lds + MISC_OFF + 1024) + 2 * tid0; t[0] = (unsigned)p; t[1] = (unsigned)(p >> 32); }
      __syncthreads(); }
    XcdBarrier bar = xcd_barrier_post((unsigned*)(C.ws + WS_CTL) + CW_BAR, MISCW(C));
    LAS unsigned char* stage = C.lds;
#define WSP(T_, off) ((T_*)(C.ws + (off)))

    PROBE_INIT();
#ifndef NO_PRO
    pro_mods(C);
    convert_main(C, 0);
#endif
    xcd_barrier(bar);
    PROBE_MARK(0);
    for (int l = 0; l < DEPTH; ++l) {
#ifndef NO_N1
        phase_rows<0>(C, l, l > 0);
#endif
        xcd_barrier(bar); PROBE_MARK(1);
#ifndef NO_G1
        { pg8::Gemm g{WSP(const bf16_t, WS_H), WSP(const bf16_t, WS_WIN), T, PLD, 1024}; pg8::StaticOrder S; S.init(T, PLD, C.G, C.bid);
          pg8::EpiBf16<0> E{WSP(bf16_t, WS_P), PLD, nullptr, 0, 0};
          pg8::gemm_phase<pg8::EpiBf16<0>, pg8::StaticOrder, false>(stage, g, S, E, nullptr); }
#endif
        xcd_barrier(bar); PROBE_MARK(2);
#ifndef NO_MIX
        phase_mix_a(C, l);
        xcd_barrier(bar); PROBE_MARK(15);
        phase_mix_b(C, l);
#endif
        xcd_barrier(bar); PROBE_MARK(3);
#ifndef NO_COMB
        phase_comb(C, l);
#endif
        xcd_barrier(bar); PROBE_MARK(4);
#ifndef NO_MERGE
        { pg8::Gemm g{WSP(const bf16_t, WS_BR), WSP(const bf16_t, WS_WMG), 4 * T, 4096, 512}; OrderMerge S{C.G, C.bid};
          EpiMerge E{WSP(const bf16_t, WS_P), WSP(bf16_t, WS_MIXS)};
          pg8::gemm_phase<EpiMerge, OrderMerge, false>(stage, g, S, E, nullptr); }
#endif
        xcd_barrier(bar); PROBE_MARK(5);
#ifndef NO_WOUT
        { pg8::Gemm g{WSP(const bf16_t, WS_MIXS), WSP(const bf16_t, WS_WOUT), T, 1024, 1024}; pg8::StaticOrder S; S.init(T, 1024, C.G, C.bid);
          EpiWout E{l == 0 ? INP(I_X) : (const float*)C.out, C.out, WSP(const float, WS_MOD) + (size_t)l * 4 * 6144 + 2048};
          pg8::gemm_phase<EpiWout, pg8::StaticOrder, false>(stage, g, S, E, nullptr); }
#endif
        xcd_barrier(bar); PROBE_MARK(6);
#ifndef NO_N2
        phase_n2(C, l, l + 1 < DEPTH); PROBE_MARK(16);
#endif
        xcd_barrier(bar); PROBE_MARK(7);
#ifndef NO_SCAT
        phase_scatter(C, l);
#endif
        xcd_barrier(bar); PROBE_MARK(8);
#ifndef NO_MOE1
        { const int nblk = (int)MISCW(C)[5];
          const LAS int* m1 = (const LAS int*)(C.lds + MISC_OFF + 2048); LAS int* rowl = (LAS int*)(C.lds + MISC_OFF + 4096);
          { const int* ROWTOK = (const int*)(C.ws + WS_ROWTOK); const int nu = m1[0] < 12 ? m1[0] : 12; int t0 = threadIdx.x; asm volatile("" : "+v"(t0));
            for (int i = 0; i < nu; ++i) if (t0 < 256) rowl[i * 256 + t0] = ROWTOK[(m1[1 + i] >> 8) * 256 + t0];
            __syncthreads(); }
          pg8::Gemm g{(const bf16_t*)(C.ws + WS_H), (const bf16_t*)(C.ws + WS_E1), MAXROWS, 64 * 512, 1024}; OrderList S{m1}; (void)nblk;
          EpiMoe1 E{(bf16_t*)(C.ws + WS_HID)};
          pg8::gemm_phase<EpiMoe1, OrderList, false, true>(stage, g, S, E, nullptr, rowl); }
#endif
        xcd_barrier(bar); PROBE_MARK(9);
#ifndef NO_MOE2
        { const int nblk = (int)MISCW(C)[5];
          pg8::Gemm g{(const bf16_t*)(C.ws + WS_HID), (const bf16_t*)(C.ws + WS_E2), MAXROWS, 64 * 1024, 256}; OrderList S{(const LAS int*)(C.lds + MISC_OFF + 2048) + 64}; (void)nblk;
          EpiMoe2 E{(bf16_t*)(C.ws + WS_Y)};
          pg8::gemm_phase<EpiMoe2, OrderList, false>(stage, g, S, E, nullptr); }
#endif
        xcd_barrier(bar); PROBE_MARK(10);
    }
#ifndef NO_FIN
    phase_rows<1>(C, DEPTH, true);
#endif
    PROBE_MARK(11);
    PROBE_FINISH();
}

extern "C" void kernel_launch(void* const* d_in, const int* in_sizes, int n_in, void* d_out, int out_size, void* d_ws, size_t ws_size, hipStream_t stream) {
    static int grid = 0;
    if (grid == 0) {
        if (n_in != 25 || out_size != T * DM || ws_size < WS_END) { fprintf(stderr, "kernel_launch: unexpected sizes (n_in %d out %d ws %zu need %zu)\n", n_in, out_size, ws_size, (size_t)WS_END); grid = -1; return; }
        int dev = 0, cus = 0, per_cu = 0;
        if (hipGetDevice(&dev) != hipSuccess || hipDeviceGetAttribute(&cus, hipDeviceAttributeMultiprocessorCount, dev) != hipSuccess) { grid = -1; return; }
        if (hipFuncSetAttribute((const void*)mega_fwd, hipFuncAttributeMaxDynamicSharedMemorySize, LDS_BYTES) != hipSuccess) { fprintf(stderr, "kernel_launch: hipFuncSetAttribute failed\n"); grid = -1; return; }
        if (hipOccupancyMaxActiveBlocksPerMultiprocessor(&per_cu, (const void*)mega_fwd, NTHR, LDS_BYTES) != hipSuccess || per_cu < 1) { fprintf(stderr, "kernel_launch: occupancy query says %d\n", per_cu); (void)hipGetLastError(); grid = -1; return; }
        grid = cus;
    }
    if (grid < 0) return;
    if (hipMemsetAsync((char*)d_ws + WS_CTL, 0, CTL_ZERO_BYTES, stream) != hipSuccess) return;
    Args a{};
    for (int i = 0; i < 25; ++i) a.in[i] = (const float*)d_in[i];
    a.out = (float*)d_out; a.ws = (unsigned char*)d_ws;
    hipLaunchKernelGGL(mega_fwd, dim3(grid), dim3(NTHR), LDS_BYTES, stream, a);
}
```

```cpp
#include <hip/hip_runtime.h>
#include <hip/hip_bf16.h>
#include <cstdio>
#include <cstdint>
namespace pg8 {
#define PG8_LAS __attribute__((address_space(3)))
typedef unsigned short bf16_t;
typedef short bf16x8 __attribute__((ext_vector_type(8)));
typedef float f32x4 __attribute__((ext_vector_type(4)));
typedef unsigned u32x4 __attribute__((ext_vector_type(4)));
typedef unsigned u32x2 __attribute__((ext_vector_type(2)));
constexpr int BM = 256, BK = 64, HALF = 128, HTB = HALF * BK * 2  , STAGE_BYTES = 8 * HTB, NXCD = 8, WGM = 4;

__host__ __device__ __forceinline__ int lds_byte(int r, int c) { const int st = (r >> 4) * 2 + (c >> 5), rr = r & 15, cc = c & 31, ob = rr * 64 + cc * 2; return st * 1024 + (ob ^ (((ob >> 9) & 1) << 5)); }
__host__ __device__ __forceinline__ void stage_rc(int b, int& R, int& C) { const int st = b / 1024, sb = b % 1024, swz = sb ^ (((sb >> 9) & 1) << 5); R = (st >> 1) * 16 + swz / 64; C = (st & 1) * 32 + (swz % 64) / 2; }
__host__ __device__ __forceinline__ int perm32(int rho) { const int n = rho >> 4, i = rho & 15; return 8 * (i >> 2) + 4 * n + (i & 3); }

struct Unit { int pm, pn; int ko = 0; };
struct Gemm { const bf16_t* A; const bf16_t* Bt; int M, N, K; int KL = 0; };

struct StaticOrder {
    int nM, nN, nwg, G, c;
    __host__ __device__ void init(int M, int N, int G_, int c_) { nM = M / BM; nN = N / BM; nwg = nM * nN; G = G_; c = c_; }
    __host__ __device__ bool next(int i, Unit& u) const {
        const long L = (long)i * G + c; if (L >= nwg) return false;
        int wgid = (int)L; { const int q = nwg / NXCD, r = nwg % NXCD, xcd = wgid % NXCD, off = wgid / NXCD; wgid = (xcd < r ? xcd * (q + 1) : r * (q + 1) + (xcd - r) * q) + off; }
        const int nig = WGM * nN, gid = wgid / nig, fm = gid * WGM, gsz = (nM - fm) < WGM ? (nM - fm) : WGM;
        u.pm = fm + ((wgid % nig) % gsz); u.pn = (wgid % nig) / gsz; return true;
    }
    __device__ __forceinline__ void a_ready(const Unit&) const {}
    __device__ __forceinline__ void done(const Unit&) const {}
};
__device__ __forceinline__ unsigned cvt_pk_bf16(float lo, float hi) { unsigned r; asm volatile("v_cvt_pk_bf16_f32 %0, %1, %2" : "=v"(r) : "v"(lo), "v"(hi)); return r; }
template <int ACT  > struct EpiBf16 {
    static constexpr bool PERM = true, AFTER_DRAIN = false, NT = false;
    bf16_t* O; int ldc; const float* bias; int split_cols; size_t split_stride;
    __device__ __forceinline__ void operator()(const f32x4 (&acc)[2][2][4][2], const Unit& u, int wr, int wc, int fr, int fq) const {
        const int row0 = u.pm * BM + wr * 64 + fr; int colt = u.pn * BM; bf16_t* base = O;
        if (split_cols) { const int t = colt / split_cols; base += (size_t)t * split_stride; colt -= t * split_cols; }
        const int col0 = colt + wc * 32 + 8 * fq, bcol0 = u.pn * BM + wc * 32 + 8 * fq;
        f32x4 bv[2][2];
#pragma unroll
        for (int bj = 0; bj < 2; ++bj)
#pragma unroll
            for (int n = 0; n < 2; ++n) bv[bj][n] = bias ? *(const f32x4*)(bias + bcol0 + bj * HALF + 4 * n) : (f32x4){0.f, 0.f, 0.f, 0.f};
#pragma unroll
        for (int ai = 0; ai < 2; ++ai)
#pragma unroll
            for (int m = 0; m < 4; ++m) { bf16_t* rowp = base + (size_t)(row0 + ai * HALF + m * 16) * ldc + col0;
#pragma unroll
                for (int bj = 0; bj < 2; ++bj) { f32x4 v0 = acc[ai][bj][m][0] + bv[bj][0], v1 = acc[ai][bj][m][1] + bv[bj][1];
                    u32x4 w; w.x = cvt_pk_bf16(v0[0], v0[1]); w.y = cvt_pk_bf16(v0[2], v0[3]); w.z = cvt_pk_bf16(v1[0], v1[1]); w.w = cvt_pk_bf16(v1[2], v1[3]);
                    *(u32x4*)(rowp + bj * HALF) = w; } }
    }
};

__host__ __device__ __forceinline__ int nt_brow(int R) { return 64 * (R >> 5) + 4 * (R & 15) + ((R >> 4) & 1); }
struct EpiBf16NT {
    static constexpr bool PERM = false, AFTER_DRAIN = false, NT = true; static constexpr int BHALF = 2;
    __host__ __device__ static int brow(int R) { return nt_brow(R); }
    bf16_t* O; int ldc;
    __device__ __forceinline__ void operator()(const f32x4 (&acc)[2][2][4][2], const Unit& u, int wr, int wc, int fr, int fq) const {
        bf16_t* base = O + (size_t)(u.pm * BM + wr * 64 + 4 * fq) * ldc + u.pn * BM + wc * 64 + 4 * fr;
#pragma unroll
        for (int ai = 0; ai < 2; ++ai)
#pragma unroll
            for (int m = 0; m < 4; ++m)
#pragma unroll
                for (int e = 0; e < 4; ++e) { u32x2 w; w.x = cvt_pk_bf16(acc[ai][0][m][0][e], acc[ai][0][m][1][e]); w.y = cvt_pk_bf16(acc[ai][1][m][0][e], acc[ai][1][m][1][e]);
                    __builtin_nontemporal_store(w, (u32x2*)(base + (size_t)(ai * HALF + m * 16 + e) * ldc)); }
    }
};

struct EpiSplitK {
    static constexpr bool PERM = false, AFTER_DRAIN = false, NT = true; static constexpr int BHALF = 2;
    __host__ __device__ static int brow(int R) { return nt_brow(R); }
    bf16_t* O; int ldc; bf16_t* PB; int Trows;
    __device__ __forceinline__ void operator()(const f32x4 (&acc)[2][2][4][2], const Unit& u, int wr, int wc, int fr, int fq) const {
        const int kq = u.ko >> 8; const int row0 = u.pm * BM + wr * 64 + 4 * fq, col0 = wc * 64 + 4 * fr;
        bf16_t* base; int ld;
        if (kq == 0) { base = O + (size_t)row0 * ldc + u.pn * BM + col0; ld = ldc; } else { base = PB + ((size_t)(kq - 1) * Trows + row0) * 256 + col0; ld = 256; }
#pragma unroll
        for (int ai = 0; ai < 2; ++ai)
#pragma unroll
            for (int m = 0; m < 4; ++m)
#pragma unroll
                for (int e = 0; e < 4; ++e) { u32x2 w; w.x = cvt_pk_bf16(acc[ai][0][m][0][e], acc[ai][0][m][1][e]); w.y = cvt_pk_bf16(acc[ai][1][m][0][e], acc[ai][1][m][1][e]);
                    *(u32x2*)(base + (size_t)(ai * HALF + m * 16 + e) * ld) = w; }
    }
};
struct SplitKOrder { int G, c, pn;
    __device__ __forceinline__ bool next(int i, Unit& u) const { const int L = i * G + c; if (L >= 256) return false; u.pm = L >> 2; u.pn = pn; u.ko = (L & 3) * 256; return true; }
    __device__ __forceinline__ void a_ready(const Unit&) const {}
    __device__ __forceinline__ void done(const Unit&) const {}
};

template <class Epi, class Sched, bool STAMP = false, bool GATHER = false>
__device__ __forceinline__ void gemm_phase(PG8_LAS unsigned char* lds, const Gemm g, const Sched& S, const Epi& E, unsigned long long* stamps, const PG8_LAS int* rowl = nullptr) {
    int tid_ = threadIdx.x; asm volatile("" : "+v"(tid_));
    const int tid = tid_, wid = __builtin_amdgcn_readfirstlane(tid >> 6), lane = tid & 63, wr = wid >> 2, wc = wid & 3, fr = lane & 15, fq = lane >> 4;
    const int K = g.K, nt = (g.KL ? g.KL : K) / BK;
    int ts_lo = 0, ts_hi = 0, nts = 0; const unsigned long long rt_entry = STAMP ? (unsigned long long)wall_clock64() : 0ull;
#define PG8_STAMP() do { if (STAMP && wid == 0 && nts < 64) { const unsigned long long _c = (unsigned long long)clock64(); \
        ts_lo = (lane == nts) ? (int)(unsigned)_c : ts_lo; ts_hi = (lane == nts) ? (int)(unsigned)(_c >> 32) : ts_hi; ++nts; } } while (0)
    PG8_STAMP();
    unsigned voffA[2], voffB[2];
#pragma unroll
    for (int i = 0; i < 2; ++i) { int R, C; stage_rc(tid * 16 + i * 8192, R, C); int Rb; if constexpr (Epi::NT) Rb = Epi::brow(R); else Rb = Epi::PERM ? ((R & ~31) + perm32(R & 31)) : R;
        voffA[i] = (unsigned)(R * K + C) * 2u; voffB[i] = (unsigned)(Rb * K + C) * 2u; }
    unsigned vA0[2], vA1[2], nA0[2], nA1[2];
#define PG8_GOFF(d0, d1, u_) do { _Pragma("unroll") for (int _i = 0; _i < 2; ++_i) { int R_, C_; stage_rc(tid * 16 + _i * 8192, R_, C_);     \
        (d0)[_i] = (unsigned)rowl[256 * (u_) + R_] * (unsigned)(K * 2) + (unsigned)C_ * 2u; (d1)[_i] = (unsigned)rowl[256 * (u_) + 128 + R_] * (unsigned)(K * 2) + (unsigned)C_ * 2u; } } while (0)
    const size_t kstep = (size_t)(BK * 2);
    const size_t hstep = (size_t)HALF * K * 2;
    size_t hstepB_ = hstep; if constexpr (Epi::NT) hstepB_ = (size_t)Epi::BHALF * K * 2; const size_t hstepB = hstepB_;
    const size_t tstep = 2 * hstep;
    const unsigned ldsw = (unsigned)wid * 1024u;
    const int aoff = lds_byte(wr * 64 + fr, fq * 8), boff = lds_byte(wc * 32 + fr, fq * 8);
#define PG8_SA(b, h) (((b) * 2 + (h)) * HTB)
#define PG8_SB(b, h) ((4 + (b) * 2 + (h)) * HTB)
#define PG8_STAGE(bufoff, gbase, voff) do { _Pragma("unroll") for (int _i = 0; _i < 2; ++_i) \
        __builtin_amdgcn_global_load_lds((const unsigned*)((const char*)(gbase) + (voff)[_i]), (PG8_LAS unsigned*)(lds + (bufoff) + ldsw + _i * 8192), 16, 0, 0); } while (0)
#define PG8_LDA(dst, b, h) do { _Pragma("unroll") for (int m = 0; m < 4; ++m) _Pragma("unroll") for (int k = 0; k < 2; ++k) dst[m][k] = *(const PG8_LAS bf16x8*)(lds + PG8_SA(b, h) + aoff + m * 2048 + k * 1024); } while (0)
#define PG8_LDB(dst, b, h) do { _Pragma("unroll") for (int n = 0; n < 2; ++n) _Pragma("unroll") for (int k = 0; k < 2; ++k) dst[n][k] = *(const PG8_LAS bf16x8*)(lds + PG8_SB(b, h) + boff + n * 2048 + k * 1024); } while (0)
#define PG8_MMA(ai, bj, At, Bt) do { __builtin_amdgcn_s_setprio(1); _Pragma("unroll") for (int m = 0; m < 4; ++m) _Pragma("unroll") for (int n = 0; n < 2; ++n) _Pragma("unroll") for (int k = 0; k < 2; ++k) \
        acc[ai][bj][m][n] = Epi::NT ? __builtin_amdgcn_mfma_f32_16x16x32_bf16(At[m][k], Bt[n][k], acc[ai][bj][m][n], 0, 0, 0) : __builtin_amdgcn_mfma_f32_16x16x32_bf16(Bt[n][k], At[m][k], acc[ai][bj][m][n], 0, 0, 0); __builtin_amdgcn_s_setprio(0); } while (0)
#define PG8_WAIT_V(n) asm volatile("s_waitcnt vmcnt(" #n ")" ::: "memory")
#define PG8_WAIT_L(n) asm volatile("s_waitcnt lgkmcnt(" #n ")" ::: "memory")
#define PG8_BAR __builtin_amdgcn_s_barrier()
#define PG8_SCHED __builtin_amdgcn_sched_barrier(0)
    Unit cur, nxt; int ui = 0;
    if (!S.next(0, cur)) return;
    f32x4 acc[2][2][4][2];
#pragma unroll
    for (int a = 0; a < 2; ++a)
#pragma unroll
        for (int b = 0; b < 2; ++b)
#pragma unroll
            for (int m = 0; m < 4; ++m)
#pragma unroll
                for (int n = 0; n < 2; ++n) acc[a][b][m][n] = (f32x4){0.f, 0.f, 0.f, 0.f};
    bf16x8 At[4][2], B0[2][2], B1[2][2];
    const char* cA = GATHER ? (const char*)g.A : (const char*)g.A + (size_t)cur.pm * tstep + (size_t)cur.ko * 2; const char* cB = (const char*)g.Bt + (size_t)cur.pn * tstep + (size_t)cur.ko * 2;
    if constexpr (GATHER) { PG8_GOFF(vA0, vA1, 0); }
    S.a_ready(cur);
    PG8_STAGE(PG8_SB(0, 0), cB, voffB); if constexpr (GATHER) PG8_STAGE(PG8_SA(0, 0), cA, vA0); else PG8_STAGE(PG8_SA(0, 0), cA, voffA); PG8_STAGE(PG8_SB(0, 1), cB + hstepB, voffB); if constexpr (GATHER) PG8_STAGE(PG8_SA(0, 1), cA, vA1); else PG8_STAGE(PG8_SA(0, 1), cA + hstep, voffA);
    if (wr == 1) PG8_BAR;
    PG8_WAIT_V(4); PG8_BAR;
    PG8_STAGE(PG8_SB(1, 0), cB + kstep, voffB); if constexpr (GATHER) PG8_STAGE(PG8_SA(1, 0), cA + kstep, vA0); else PG8_STAGE(PG8_SA(1, 0), cA + kstep, voffA); PG8_STAGE(PG8_SB(1, 1), cB + hstepB + kstep, voffB);
    PG8_WAIT_V(6); PG8_BAR;
    PG8_STAMP();
    for (;;) {
        const bool has_next = S.next(ui + 1, nxt);
        const char* nA = GATHER ? cA : (has_next ? (const char*)g.A + (size_t)nxt.pm * tstep + (size_t)nxt.ko * 2 : cA); const char* nB = has_next ? (const char*)g.Bt + (size_t)nxt.pn * tstep + (size_t)nxt.ko * 2 : cB;
        if constexpr (GATHER) { if (has_next) { PG8_GOFF(nA0, nA1, ui + 1); } else { nA0[0] = vA0[0]; nA0[1] = vA0[1]; nA1[0] = vA1[0]; nA1[1] = vA1[1]; } }
#pragma unroll 1
        for (int t = 0; t < nt; t += 2) {
            const bool last = (t == nt - 2);
            const char* a1 = cA + (size_t)(t + 1) * kstep;
            const char* a2 = last ? nA : cA + (size_t)(t + 2) * kstep; const char* b2 = last ? nB : cB + (size_t)(t + 2) * kstep;
            const char* a3 = a2 + kstep; const char* b3 = b2 + kstep;
            if (last && has_next) S.a_ready(nxt);
            unsigned sA0[2], sA1[2];
            if constexpr (GATHER) { sA0[0] = last ? nA0[0] : vA0[0]; sA0[1] = last ? nA0[1] : vA0[1]; sA1[0] = last ? nA1[0] : vA1[0]; sA1[1] = last ? nA1[1] : vA1[1]; }
            PG8_LDB(B0, 0, 0); PG8_SCHED; PG8_LDA(At, 0, 0); if constexpr (GATHER) PG8_STAGE(PG8_SA(1, 1), a1, vA1); else PG8_STAGE(PG8_SA(1, 1), a1 + hstep, voffA);
            PG8_WAIT_L(8); PG8_BAR; PG8_WAIT_L(0); PG8_MMA(0, 0, At, B0); PG8_BAR; PG8_SCHED;
            PG8_LDB(B1, 0, 1); PG8_STAGE(PG8_SB(0, 0), b2, voffB);
            PG8_BAR; PG8_WAIT_L(0); PG8_MMA(0, 1, At, B1); PG8_BAR;
            PG8_LDA(At, 0, 1); if constexpr (GATHER) PG8_STAGE(PG8_SA(0, 0), a2, sA0); else PG8_STAGE(PG8_SA(0, 0), a2, voffA);
            PG8_BAR; PG8_WAIT_L(0); PG8_MMA(1, 0, At, B0); PG8_BAR; PG8_SCHED;
            PG8_STAGE(PG8_SB(0, 1), b2 + hstepB, voffB);
            PG8_WAIT_V(6); PG8_BAR; PG8_MMA(1, 1, At, B1); PG8_BAR;
            PG8_LDB(B0, 1, 0); PG8_SCHED; PG8_LDA(At, 1, 0); if constexpr (GATHER) PG8_STAGE(PG8_SA(0, 1), a2, sA1); else PG8_STAGE(PG8_SA(0, 1), a2 + hstep, voffA);
            PG8_WAIT_L(8); PG8_BAR; PG8_WAIT_L(0); PG8_MMA(0, 0, At, B0); PG8_BAR; PG8_SCHED;
            PG8_LDB(B1, 1, 1); PG8_STAGE(PG8_SB(1, 0), b3, voffB);
            PG8_BAR; PG8_WAIT_L(0); PG8_MMA(0, 1, At, B1); PG8_BAR;
            PG8_LDA(At, 1, 1); if constexpr (GATHER) PG8_STAGE(PG8_SA(1, 0), a3, sA0); else PG8_STAGE(PG8_SA(1, 0), a3, voffA);
            PG8_BAR; PG8_WAIT_L(0); PG8_MMA(1, 0, At, B0); PG8_BAR; PG8_SCHED;
            PG8_STAGE(PG8_SB(1, 1), b3 + hstepB, voffB);
            PG8_WAIT_V(6); PG8_BAR; PG8_MMA(1, 1, At, B1); PG8_BAR;
        }
        PG8_STAMP();
        if constexpr (!Epi::AFTER_DRAIN) { E(acc, cur, wr, wc, fr, fq); S.done(cur); }
        PG8_STAMP();
        if (!has_next) break;
#pragma unroll
        for (int a = 0; a < 2; ++a)
#pragma unroll
            for (int b = 0; b < 2; ++b)
#pragma unroll
                for (int m = 0; m < 4; ++m)
#pragma unroll
                    for (int n = 0; n < 2; ++n) acc[a][b][m][n] = (f32x4){0.f, 0.f, 0.f, 0.f};
        cur = nxt; cA = nA; cB = nB; ++ui;
        if constexpr (GATHER) { vA0[0] = nA0[0]; vA0[1] = nA0[1]; vA1[0] = nA1[0]; vA1[1] = nA1[1]; }
    }
    PG8_WAIT_V(0);
    if (wr == 0) PG8_BAR;
    PG8_BAR;
    if constexpr (Epi::AFTER_DRAIN) { E.fused(acc, cur, wr, wc, fr, fq, lds, wid, lane); S.done(cur); }
    PG8_STAMP();
    if (STAMP && wid == 0) { stamps[lane] = lane < nts ? (((unsigned long long)(unsigned)ts_hi << 32) | (unsigned)ts_lo) : 0ull;
        if (lane == 62) stamps[62] = rt_entry; if (lane == 63) stamps[63] = (unsigned long long)wall_clock64(); }
#undef PG8_STAMP
#undef PG8_SA
#undef PG8_SB
#undef PG8_STAGE
#undef PG8_GOFF
#undef PG8_LDA
#undef PG8_LDB
#undef PG8_MMA
#undef PG8_WAIT_V
#undef PG8_WAIT_L
#undef PG8_BAR
#undef PG8_SCHED
}
}

namespace attn_body {
using bf16=__hip_bfloat16;
using bf16x8=__attribute__((ext_vector_type(8)))short;
using s16x4=__attribute__((ext_vector_type(4)))short;
using f32x16=__attribute__((ext_vector_type(16)))float;
using u32x4=__attribute__((ext_vector_type(4)))unsigned;
constexpr int D=64;
constexpr int NW=8,QBLK=32,QB=QBLK*NW,KVBLK=64;
__device__ __forceinline__ int crow(int r,int hi){return (r&3)+8*(r>>2)+4*hi;}
#define SBAR() __builtin_amdgcn_sched_barrier(0)
__device__ __forceinline__ void cmask(f32x16&p0,f32x16&p1,int jb,int qrel,int hi){
  const float NEG=-INFINITY; int kb=64*jb+4*hi;
  #pragma unroll
  for(int r=0;r<16;++r){int kv=kb+(r&3)+8*(r>>2); if(kv>qrel)p0[r]=NEG; if(kv+32>qrel)p1[r]=NEG;}
}

constexpr int NSLOT=3, SLOTB=8192;
constexpr int LDS_K=0, LDS_V=NSLOT*SLOTB, LDS_WS=2*NSLOT*SLOTB, LDS_OST=LDS_WS+NW*64*4, LDS_BYTES=LDS_OST+NW*4096;
constexpr float C2=0.125f*1.4426950408889634f;
__device__ __forceinline__ void glds16(const void*gsrc,unsigned lds_dst){unsigned keep;
  asm volatile("s_mov_b32 %0, m0\n\ts_mov_b32 m0, %2\n\ts_nop 0\n\tglobal_load_lds_dwordx4 %1, off\n\ts_mov_b32 m0, %0":"=&s"(keep):"v"(gsrc),"s"(lds_dst):"memory");}
__device__ __forceinline__ float max3f(float a,float b,float c){float r;asm("v_max3_f32 %0, %1, %2, %3":"=v"(r):"v"(a),"v"(b),"v"(c));return r;}
__device__ __forceinline__ float max2f(float a,float b){float r;asm("v_max_f32_e32 %0, %1, %2":"=v"(r):"v"(a),"v"(b));return r;}
__device__ __forceinline__ float fadd_s(float a,float b){float r;asm("v_add_f32_e32 %0, %1, %2":"=v"(r):"v"(a),"v"(b));return r;}
__device__ __forceinline__ float fsub_s(float a,float b){float r;asm("v_sub_f32_e32 %0, %1, %2":"=v"(r):"v"(a),"v"(b));return r;}
typedef float f32x2_t __attribute__((ext_vector_type(2))); typedef __bf16 bf16x2_t __attribute__((ext_vector_type(2)));
__device__ __forceinline__ unsigned cvtpk_s(float lo,float hi){f32x2_t v={lo,hi};bf16x2_t b=__builtin_convertvector(v,bf16x2_t);return __builtin_bit_cast(unsigned,b);}
#define WAIT_BAR(N) asm volatile("s_waitcnt vmcnt(" #N ") lgkmcnt(0)\n\ts_barrier":::"memory")

__device__ __forceinline__ void qkt(f32x16&p0,f32x16&p1,const char*Kslot,const bf16x8*qr,const f32x16&negm,int r32,int hi){
  const char*kb=Kslot+hi*1024+r32*16;
  #pragma unroll
  for(int d0=0;d0<4;++d0){
    const bf16x8 b0=*reinterpret_cast<const bf16x8*>(kb+d0*2048);
    const bf16x8 b1=*reinterpret_cast<const bf16x8*>(kb+d0*2048+512);
    if(d0==0){p0=__builtin_amdgcn_mfma_f32_32x32x16_bf16(b0,qr[0],negm,0,0,0);p1=__builtin_amdgcn_mfma_f32_32x32x16_bf16(b1,qr[0],negm,0,0,0);}
    else{p0=__builtin_amdgcn_mfma_f32_32x32x16_bf16(b0,qr[d0],p0,0,0,0);p1=__builtin_amdgcn_mfma_f32_32x32x16_bf16(b1,qr[d0],p1,0,0,0);}}
}
typedef __attribute__((address_space(3))) const char* lds_cptr;
typedef short v4i16_t __attribute__((ext_vector_type(4)));
__device__ __forceinline__ void kload8(bf16x8*kf,lds_cptr kp){
  kf[0]=*(const __attribute__((address_space(3))) bf16x8*)(kp);      kf[1]=*(const __attribute__((address_space(3))) bf16x8*)(kp+512);
  kf[2]=*(const __attribute__((address_space(3))) bf16x8*)(kp+2048); kf[3]=*(const __attribute__((address_space(3))) bf16x8*)(kp+2560);
  kf[4]=*(const __attribute__((address_space(3))) bf16x8*)(kp+4096); kf[5]=*(const __attribute__((address_space(3))) bf16x8*)(kp+4608);
  kf[6]=*(const __attribute__((address_space(3))) bf16x8*)(kp+6144); kf[7]=*(const __attribute__((address_space(3))) bf16x8*)(kp+6656);
}
__device__ __forceinline__ void kload2(bf16x8*kf,lds_cptr kp,int j){ kf[2*j]=*(const __attribute__((address_space(3))) bf16x8*)(kp+j*2048); kf[2*j+1]=*(const __attribute__((address_space(3))) bf16x8*)(kp+j*2048+512); }
__device__ __forceinline__ s16x4 vtr(lds_cptr p){ return __builtin_bit_cast(s16x4,__builtin_amdgcn_ds_read_tr16_b64_v4i16((__attribute__((address_space(3))) v4i16_t*)p)); }
__device__ __forceinline__ float rowmax(const f32x16&p0,const f32x16&p1){
  float a=max3f(p0[0],p0[1],p1[0]),b=max3f(p0[2],p0[3],p1[1]);a=max3f(a,p1[2],p1[3]);
  #pragma unroll
  for(int r=4;r<16;r+=4){a=max3f(a,p0[r],p0[r+1]);b=max3f(b,p0[r+2],p0[r+3]);a=max3f(a,p1[r],p1[r+1]);b=max3f(b,p1[r+2],p1[r+3]);}
  const float m=max2f(a,b);
  auto rr=__builtin_amdgcn_permlane32_swap(__float_as_uint(m),__float_as_uint(m),false,false);
  return max2f(__uint_as_float(rr[0]),__uint_as_float(rr[1]));
}
__device__ __forceinline__ void pv(f32x16*o,int vb,bf16x8 pa0,bf16x8 pa1,bf16x8 pa2,bf16x8 pa3){
  #pragma unroll
  for(int d0=0;d0<2;++d0){s16x4 lo[4],hi[4];
    #pragma unroll
    for(int ks=0;ks<4;++ks){
      asm volatile("ds_read_b64_tr_b16 %0,%1 offset:%c2":"=&v"(lo[ks]):"v"(vb),"i"(d0*4096+ks*1024):"memory");
      asm volatile("ds_read_b64_tr_b16 %0,%1 offset:%c2":"=&v"(hi[ks]):"v"(vb),"i"(d0*4096+ks*1024+512):"memory");}
    asm volatile("s_waitcnt lgkmcnt(0)":::"memory");SBAR();
    #define PK(k) (bf16x8){lo[k][0],lo[k][1],lo[k][2],lo[k][3],hi[k][0],hi[k][1],hi[k][2],hi[k][3]}
    o[d0]=__builtin_amdgcn_mfma_f32_32x32x16_bf16(pa0,PK(0),o[d0],0,0,0);
    o[d0]=__builtin_amdgcn_mfma_f32_32x32x16_bf16(pa1,PK(1),o[d0],0,0,0);
    o[d0]=__builtin_amdgcn_mfma_f32_32x32x16_bf16(pa2,PK(2),o[d0],0,0,0);
    o[d0]=__builtin_amdgcn_mfma_f32_32x32x16_bf16(pa3,PK(3),o[d0],0,0,0);
    #undef PK
  }
}

#ifndef ATTN_STORE16
#define ATTN_STORE16(p,v) (*(u32x4*)(p)=(v))
#endif
template<int THRL,int PQ,int PO> __device__ __forceinline__ void attn_unit(int qb,const bf16*Qh,const bf16*__restrict__ Kh,const bf16*__restrict__ Vh,bf16*Oh,char*shm){
  int tid_=threadIdx.x; asm volatile("":"+v"(tid_)); const int tid=tid_,lane=tid&63,r32=lane&31,hi=lane>>5; const int wid=__builtin_amdgcn_readfirstlane(tid>>6);
  const int q0=qb*QB;
  const bf16*Qw=Qh+(long)(q0+wid*QBLK)*PQ;
  const unsigned lds0=(unsigned)(uintptr_t)shm;
  float*wsf=(float*)(shm+LDS_WS)+wid*64;
  const bf16*ksrc=Kh+(long)lane*PQ+wid*8;
  const bf16*vsrc=Vh+(long)(16*(wid&3)+(lane>>2))*PQ+(wid>>2)*32+(lane&3)*8;
  const unsigned kdst=lds0+LDS_K+wid*1024, vdst=lds0+LDS_V+wid*1024;
  #define DMA_K(t,slot) glds16(ksrc+(long)(t)*KVBLK*PQ,(unsigned)__builtin_amdgcn_readfirstlane(kdst+(slot)))
  #define DMA_V(t,slot) glds16(vsrc+(long)(t)*KVBLK*PQ,(unsigned)__builtin_amdgcn_readfirstlane(vdst+(slot)))
  const int vb0=(int)(lds0+LDS_V)+((lane>>4)&1)*32+(lane&3)*8+(4*hi+((lane&15)>>2))*64;
  const char*Kbase=shm+LDS_K; bf16x8 kf[8];
  const lds_cptr shm3=(lds_cptr)shm; const lds_cptr kp0=shm3+LDS_K+hi*1024+r32*16; const lds_cptr vp0=shm3+LDS_V+((lane>>4)&1)*32+(lane&3)*8+(4*hi+((lane&15)>>2))*64;
  const int NT=(q0+QB)/KVBLK;
  DMA_K(0,0);DMA_V(0,0);DMA_K(1,SLOTB);
  bf16x8 qr[4];
  #pragma unroll
  for(int d0=0;d0<4;++d0)qr[d0]=*reinterpret_cast<const bf16x8*>(&Qw[(long)r32*PQ+d0*16+hi*8]);
  float mhat=0.f,l_reg=0.f;f32x16 o[2];o[0]=f32x16{};o[1]=f32x16{};f32x16 negm=f32x16{};asm volatile("":"+v"(negm));
  const int qrel=wid*QBLK+r32;
  #define CMASK(P0,P1,t) do{int jb_=(t)-(NT-4); if(jb_>=0)cmask(P0,P1,jb_,qrel,hi);}while(0)
  bool resc=false;
  #define START(P0,P1) do{ const float rm=rowmax(P0,P1); resc=false; \
    { const float dl=rm; mhat=fadd_s(mhat,dl); \
      _Pragma("unroll") for(int r=0;r<16;++r){P0[r]=fsub_s(P0[r],dl);P1[r]=fsub_s(P1[r],dl);} \
      _Pragma("unroll") for(int r=0;r<16;++r)negm[r]=-mhat; asm volatile("":"+v"(negm)); } \
    _Pragma("unroll") for(int r=0;r<16;++r)P0[r]=__builtin_amdgcn_exp2f(P0[r]); }while(0)
  #define RESC() do{ if(resc){ asm volatile("s_waitcnt lgkmcnt(0)":::"memory"); \
      _Pragma("unroll") for(int d_=0;d_<2;++d_) _Pragma("unroll") for(int r=0;r<16;++r)o[d_][r]*=wsf[crow(r,hi)]; } }while(0)
  f32x16 pA0,pA1,pB0,pB1;
  int sl_prev=0,sl_cur=0,sl_next=SLOTB;
  #define ROT() do{sl_prev=sl_cur;sl_cur=sl_next;sl_next=(sl_next==(NSLOT-1)*SLOTB)?0:sl_next+SLOTB;}while(0)
  DMA_K(2,2*SLOTB);
  WAIT_BAR(3);
  qkt(pA0,pA1,Kbase,qr,negm,r32,hi);asm volatile("s_nop 15\n\ts_nop 7":"+v"(pA0),"+v"(pA1));CMASK(pA0,pA1,0);
  START(pA0,pA1);
  _Pragma("unroll") for(int r=0;r<16;++r)pA1[r]=__builtin_amdgcn_exp2f(pA1[r]);
  WAIT_BAR(0);
  DMA_K(3,0);DMA_V(1,SLOTB);
  ROT();
  kload8(kf,kp0+sl_cur);
  WAIT_BAR(2);
  s16x4 vlo[8],vhi[8]; u32x4 pw0,pw1,pw2,pw3;
  #define PKW(P,B) cvtpk_s(P[B],P[B+1])
  #define PAF(k) __builtin_bit_cast(bf16x8,pw##k)
  #define VFR(i) (bf16x8){vlo[i][0],vlo[i][1],vlo[i][2],vlo[i][3],vhi[i][0],vhi[i][1],vhi[i][2],vhi[i][3]}
  #define PIN(x) asm volatile("":"+v"(x))
  #define MX3(a,b,c) __builtin_fmaxf(__builtin_fmaxf((a),(b)),(c))
  #define GAPA(MF,A0,A1,A2,A3,W0,W1,PW) do{ MF; sacc+=A0; sacc+=A1; sacc+=A2; sacc+=A3; PIN(sacc); W0; W1; PIN(PW); SBAR(); }while(0)
  #define EX(v) __builtin_amdgcn_exp2f(v)
  #define GAPB(MF,X,B) do{ MF; X[B]=EX(X[B]); X[B+1]=EX(X[B+1]); X[B+2]=EX(X[B+2]); X[B+3]=EX(X[B+3]); PIN(X); SBAR(); }while(0)
  #define VRD(i) do{ vlo[i]=vtr(vp_+(((i)>>2)*4096+((i)&3)*1024)); vhi[i]=vtr(vp_+(((i)>>2)*4096+((i)&3)*1024+512)); }while(0)
  #define KRD(G,j) do{ if(G){ kload2(kf,kp0+sl_next,j); SBAR(); } }while(0)
  #define STEP(C0,C1,P0,P1,t,GK,GV,GL) do{ SBAR(); \
    const lds_cptr vp_=vp0+sl_prev; \
    VRD(0); SBAR(); float sacc=(P0[0]+P0[1]); \
    GAPA(C0=__builtin_amdgcn_mfma_f32_32x32x16_bf16(kf[0],qr[0],negm,0,0,0), P0[2],P0[3],P0[4],P0[5],     pw0[0]=PKW(P0,0), pw0[1]=PKW(P0,2), pw0); \
    VRD(4); SBAR(); GAPA(C1=__builtin_amdgcn_mfma_f32_32x32x16_bf16(kf[1],qr[0],negm,0,0,0), P0[6],P0[7],P0[8],P0[9],     pw0[2]=PKW(P0,4), pw0[3]=PKW(P0,6), pw0); \
    VRD(1); SBAR(); GAPA(C0=__builtin_amdgcn_mfma_f32_32x32x16_bf16(kf[2],qr[1],C0,0,0,0),   P0[10],P0[11],P0[12],P0[13], pw1[0]=PKW(P0,8), pw1[1]=PKW(P0,10), pw1); \
    VRD(5); SBAR(); GAPA(C1=__builtin_amdgcn_mfma_f32_32x32x16_bf16(kf[3],qr[1],C1,0,0,0),   P0[14],P0[15],P1[0],P1[1],   pw1[2]=PKW(P0,12),pw1[3]=PKW(P0,14), pw1); \
    VRD(2); SBAR(); GAPA(C0=__builtin_amdgcn_mfma_f32_32x32x16_bf16(kf[4],qr[2],C0,0,0,0),   P1[2],P1[3],P1[4],P1[5],     pw2[0]=PKW(P1,0), pw2[1]=PKW(P1,2), pw2); \
    VRD(6); SBAR(); GAPA(C1=__builtin_amdgcn_mfma_f32_32x32x16_bf16(kf[5],qr[2],C1,0,0,0),   P1[6],P1[7],P1[8],P1[9],     pw2[2]=PKW(P1,4), pw2[3]=PKW(P1,6), pw2); \
    VRD(3); SBAR(); GAPA(C0=__builtin_amdgcn_mfma_f32_32x32x16_bf16(kf[6],qr[3],C0,0,0,0),   P1[10],P1[11],P1[12],P1[13], pw3[0]=PKW(P1,8), pw3[1]=PKW(P1,10), pw3); \
    VRD(7); SBAR(); GAPA(C1=__builtin_amdgcn_mfma_f32_32x32x16_bf16(kf[7],qr[3],C1,0,0,0),   P1[14],P1[15],0.f,0.f,       pw3[2]=PKW(P1,12),pw3[3]=PKW(P1,14), pw3); \
    l_reg+=sacc; \
    if(GK){DMA_K((t)+3,sl_cur);} if(GV){DMA_V((t)+1,sl_next);} \
    CMASK(C0,C1,t); \
    { float a=MX3(C0[0],C0[1],C1[0]),b=MX3(C0[2],C0[3],C1[1]); a=MX3(a,C1[2],C1[3]); \
      _Pragma("unroll") for(int r=4;r<16;r+=4){a=MX3(a,C0[r],C0[r+1]);b=MX3(b,C0[r+2],C0[r+3]);a=MX3(a,C1[r],C1[r+1]);b=MX3(b,C1[r+2],C1[r+3]);} \
      float rm=__builtin_fmaxf(a,b); { auto rr=__builtin_amdgcn_permlane32_swap(__float_as_uint(rm),__float_as_uint(rm),false,false); rm=__builtin_fmaxf(__uint_as_float(rr[0]),__uint_as_float(rr[1])); } \
      resc=false; \
      if(__builtin_expect(__any(rm>(float)THRL),0)){ const float dl=__builtin_fmaxf(rm,0.f); mhat+=dl; \
        _Pragma("unroll") for(int r=0;r<16;++r){C0[r]-=dl;C1[r]-=dl;} \
        _Pragma("unroll") for(int r=0;r<16;++r)negm[r]=-mhat; asm volatile("":"+v"(negm)); \
        const float f=__builtin_amdgcn_exp2f(-dl); l_reg*=f; if(hi==0)wsf[r32]=f; resc=true; } } \
    SBAR(); \
    GAPB(o[0]=__builtin_amdgcn_mfma_f32_32x32x16_bf16(PAF(0),VFR(0),o[0],0,0,0), C0,0); \
    GAPB(o[1]=__builtin_amdgcn_mfma_f32_32x32x16_bf16(PAF(0),VFR(4),o[1],0,0,0), C0,4); \
    KRD(GL,0); GAPB(o[0]=__builtin_amdgcn_mfma_f32_32x32x16_bf16(PAF(1),VFR(1),o[0],0,0,0), C0,8); \
    KRD(GL,1); GAPB(o[1]=__builtin_amdgcn_mfma_f32_32x32x16_bf16(PAF(1),VFR(5),o[1],0,0,0), C0,12); \
    KRD(GL,2); GAPB(o[0]=__builtin_amdgcn_mfma_f32_32x32x16_bf16(PAF(2),VFR(2),o[0],0,0,0), C1,0); \
    KRD(GL,3); GAPB(o[1]=__builtin_amdgcn_mfma_f32_32x32x16_bf16(PAF(2),VFR(6),o[1],0,0,0), C1,4); \
    GAPB(o[0]=__builtin_amdgcn_mfma_f32_32x32x16_bf16(PAF(3),VFR(3),o[0],0,0,0), C1,8); \
    GAPB(o[1]=__builtin_amdgcn_mfma_f32_32x32x16_bf16(PAF(3),VFR(7),o[1],0,0,0), C1,12); \
    }while(0)
  int t=1;
  #undef CMASK
  #define CMASK(P0,P1,t) do{}while(0)
  for(;t+5<NT;t+=2){
    STEP(pB0,pB1,pA0,pA1,t,true,true,true);     WAIT_BAR(2); RESC(); ROT();
    STEP(pA0,pA1,pB0,pB1,t+1,true,true,true);   WAIT_BAR(2); RESC(); ROT();
  }
  #undef CMASK
  #define CMASK(P0,P1,t) do{int jb_=(t)-(NT-4); if(jb_>=0)cmask(P0,P1,jb_,qrel,hi);}while(0)
  #define ENDW(tt) do{ if((tt)+3<NT){WAIT_BAR(2);} else if((tt)+2<NT){WAIT_BAR(1);} else {WAIT_BAR(0);} }while(0)
  for(;t+1<NT;t+=2){
    STEP(pB0,pB1,pA0,pA1,t,(t+3<NT),(t+1<NT),(t+1<NT));       ENDW(t);   RESC(); ROT();
    STEP(pA0,pA1,pB0,pB1,t+1,(t+4<NT),(t+2<NT),(t+2<NT));     ENDW(t+1); RESC(); ROT();
  }
  STEP(pB0,pB1,pA0,pA1,NT-1,false,false,false); RESC();
  { float sacc=pB0[0]+pB0[1]; _Pragma("unroll") for(int r=2;r<16;++r)sacc+=pB0[r]; _Pragma("unroll") for(int r=0;r<16;++r)sacc+=pB1[r]; l_reg+=sacc;
    pw0=(u32x4){PKW(pB0,0),PKW(pB0,2),PKW(pB0,4),PKW(pB0,6)};pw1=(u32x4){PKW(pB0,8),PKW(pB0,10),PKW(pB0,12),PKW(pB0,14)};pw2=(u32x4){PKW(pB1,0),PKW(pB1,2),PKW(pB1,4),PKW(pB1,6)};pw3=(u32x4){PKW(pB1,8),PKW(pB1,10),PKW(pB1,12),PKW(pB1,14)};
    SBAR(); pv(o,vb0+sl_cur,PAF(0),PAF(1),PAF(2),PAF(3)); }
  #undef PKW
  #undef PAF
  #undef VFR
  #undef PIN
  #undef MX3
  #undef GAPA
  #undef GAPB
  #undef EX
  #undef VRD
  #undef KRD
  #undef STEP
  #undef ENDW
  {auto rr=__builtin_amdgcn_permlane32_swap(__float_as_uint(l_reg),__float_as_uint(l_reg),false,false);l_reg=__uint_as_float(rr[0])+__uint_as_float(rr[1]);}
  if(hi==0)wsf[32+r32]=l_reg;asm volatile("s_waitcnt lgkmcnt(0)":::"memory");
  float rli[16];
  #pragma unroll
  for(int r=0;r<16;++r)rli[r]=__builtin_amdgcn_rcpf(wsf[32+crow(r,hi)]);
  bf16*Ow=Oh+(long)(q0+wid*QBLK)*PO;
  { bf16*stg=(bf16*)(shm+LDS_OST)+wid*2048;
    #pragma unroll
    for(int r=0;r<16;++r){const int orow=crow(r,hi);
      #pragma unroll
      for(int d0=0;d0<2;++d0)stg[orow*64+d0*32+r32]=__float2bfloat16(o[d0][r]*rli[r]);}
    asm volatile("s_waitcnt lgkmcnt(0)":::"memory");
    #pragma unroll
    for(int i=0;i<4;++i){const int row=i*8+(lane>>3),ch=lane&7; const u32x4 v=*(const u32x4*)(stg+row*64+ch*8); ATTN_STORE16(Ow+(long)row*PO+ch*8,v);} }
  asm volatile("s_waitcnt lgkmcnt(0)\n\ts_barrier":::"memory");
  #undef DMA_K
  #undef DMA_V
  #undef CMASK
  #undef START
  #undef RESC
  #undef ROT
}
constexpr int SLOTV=16384, LDS2_V=NSLOT*SLOTB, LDS2_WS=LDS2_V+NSLOT*SLOTV, LDS2_OST=LDS2_WS+NW*64*4, LDS2_BYTES=LDS2_OST+NW*4096;
#ifndef ATTN_STORE16
#define ATTN_STORE16(p,v) (*(u32x4*)(p)=(v))
#endif
template<int THRL,int PQ,int PO> __device__ __forceinline__ void attn_unit128(int qb,const bf16*Qh,const bf16*__restrict__ Kh,const bf16*__restrict__ Vh,bf16*Oh,char*shm){
  int tid_=threadIdx.x; asm volatile("":"+v"(tid_)); const int tid=tid_,lane=tid&63,r32=lane&31,hi=lane>>5; const int wid=__builtin_amdgcn_readfirstlane(tid>>6);
  const int q0=qb*QB;
  const bf16*Qw=Qh+(long)(q0+wid*QBLK)*PQ;
  const unsigned lds0=(unsigned)(uintptr_t)shm;
  float*wsf=(float*)(shm+LDS2_WS)+wid*64;
  const bf16*ksrc=Kh+(long)lane*PQ+wid*8;
  const bf16*vsrc=Vh+(long)(16*(wid&3)+(lane>>2))*PQ+(wid>>2)*32+(lane&3)*8;
  const unsigned kdst=lds0+LDS_K+wid*1024, vdst=lds0+LDS2_V+wid*1024;
  #define DMA_K(t,slot) glds16(ksrc+(long)(t)*KVBLK*PQ,(unsigned)__builtin_amdgcn_readfirstlane(kdst+(slot)))
  #define DMA_V(t,slot) do{ glds16(vsrc+(long)(t)*KVBLK*PQ,(unsigned)__builtin_amdgcn_readfirstlane(vdst+2*(slot))); glds16(vsrc+(long)(t)*KVBLK*PQ+64,(unsigned)__builtin_amdgcn_readfirstlane(vdst+2*(slot)+8192)); }while(0)
  const int vb0=(int)(lds0+LDS2_V)+((lane>>4)&1)*32+(lane&3)*8+(4*hi+((lane&15)>>2))*64;
  const char*Kbase=shm+LDS_K; bf16x8 kf[8];
  const lds_cptr shm3=(lds_cptr)shm; const lds_cptr kp0=shm3+LDS_K+hi*1024+r32*16; const lds_cptr vp0=shm3+LDS2_V+((lane>>4)&1)*32+(lane&3)*8+(4*hi+((lane&15)>>2))*64;
  const int NT=(q0+QB)/KVBLK;
  DMA_K(0,0);DMA_V(0,0);DMA_K(1,SLOTB);
  bf16x8 qr[4];
  #pragma unroll
  for(int d0=0;d0<4;++d0)qr[d0]=*reinterpret_cast<const bf16x8*>(&Qw[(long)r32*PQ+d0*16+hi*8]);
  float mhat=0.f,l_reg=0.f;f32x16 o[4];o[0]=f32x16{};o[1]=f32x16{};o[2]=f32x16{};o[3]=f32x16{};f32x16 negm=f32x16{};asm volatile("":"+v"(negm));
  const int qrel=wid*QBLK+r32;
  #define CMASK(P0,P1,t) do{int jb_=(t)-(NT-4); if(jb_>=0)cmask(P0,P1,jb_,qrel,hi);}while(0)
  bool resc=false;
  #define START(P0,P1) do{ const float rm=rowmax(P0,P1); resc=false; \
    { const float dl=rm; mhat=fadd_s(mhat,dl); \
      _Pragma("unroll") for(int r=0;r<16;++r){P0[r]=fsub_s(P0[r],dl);P1[r]=fsub_s(P1[r],dl);} \
      _Pragma("unroll") for(int r=0;r<16;++r)negm[r]=-mhat; asm volatile("":"+v"(negm)); } \
    _Pragma("unroll") for(int r=0;r<16;++r)P0[r]=__builtin_amdgcn_exp2f(P0[r]); }while(0)
  #define RESC() do{ if(resc){ asm volatile("s_waitcnt lgkmcnt(0)":::"memory"); \
      _Pragma("unroll") for(int d_=0;d_<4;++d_) _Pragma("unroll") for(int r=0;r<16;++r)o[d_][r]*=wsf[crow(r,hi)]; } }while(0)
  f32x16 pA0,pA1,pB0,pB1;
  int sl_prev=0,sl_cur=0,sl_next=SLOTB;
  #define ROT() do{sl_prev=sl_cur;sl_cur=sl_next;sl_next=(sl_next==(NSLOT-1)*SLOTB)?0:sl_next+SLOTB;}while(0)
  DMA_K(2,2*SLOTB);
  WAIT_BAR(4);
  qkt(pA0,pA1,Kbase,qr,negm,r32,hi);asm volatile("s_nop 15\n\ts_nop 7":"+v"(pA0),"+v"(pA1));CMASK(pA0,pA1,0);
  START(pA0,pA1);
  _Pragma("unroll") for(int r=0;r<16;++r)pA1[r]=__builtin_amdgcn_exp2f(pA1[r]);
  WAIT_BAR(0);
  DMA_K(3,0);DMA_V(1,SLOTB);
  ROT();
  kload8(kf,kp0+sl_cur);
  WAIT_BAR(3);
  s16x4 vlo[4],vhi[4]; u32x4 pw0,pw1,pw2,pw3;
  #define PKW(P,B) cvtpk_s(P[B],P[B+1])
  #define PAF(k) __builtin_bit_cast(bf16x8,pw##k)
  #define VFR(i) (bf16x8){vlo[i][0],vlo[i][1],vlo[i][2],vlo[i][3],vhi[i][0],vhi[i][1],vhi[i][2],vhi[i][3]}
  #define PIN(x) asm volatile("":"+v"(x))
  #define MX3(a,b,c) __builtin_fmaxf(__builtin_fmaxf((a),(b)),(c))
  #define GAPA(MF,A0,A1,A2,A3,W0,W1,PW) do{ MF; sacc+=A0; sacc+=A1; sacc+=A2; sacc+=A3; PIN(sacc); W0; W1; PIN(PW); SBAR(); }while(0)
  #define EX(v) __builtin_amdgcn_exp2f(v)
  #define GAPB(MF,X,B) do{ MF; X[B]=EX(X[B]); X[B+1]=EX(X[B+1]); PIN(X); SBAR(); }while(0)
  #define VLD(R,OFF) do{ vlo[R]=vtr(vp_+(OFF)); vhi[R]=vtr(vp_+((OFF)+512)); }while(0)
  #define VLDS(R,OFF) do{ VLD(R,OFF); SBAR(); }while(0)
  #define KRD(G,j) do{ if(G){ kload2(kf,kp0+sl_next,j); SBAR(); } }while(0)
  #define STEP(C0,C1,P0,P1,t,GK,GV,GL) do{ SBAR(); \
    const lds_cptr vp_=vp0+2*sl_prev; \
    float sacc=(P0[0]+P0[1]); \
    GAPA(C0=__builtin_amdgcn_mfma_f32_32x32x16_bf16(kf[0],qr[0],negm,0,0,0), P0[2],P0[3],P0[4],P0[5],     pw0[0]=PKW(P0,0), pw0[1]=PKW(P0,2), pw0); \
    GAPA(C1=__builtin_amdgcn_mfma_f32_32x32x16_bf16(kf[1],qr[0],negm,0,0,0), P0[6],P0[7],P0[8],P0[9],     pw0[2]=PKW(P0,4), pw0[3]=PKW(P0,6), pw0); \
    GAPA(C0=__builtin_amdgcn_mfma_f32_32x32x16_bf16(kf[2],qr[1],C0,0,0,0),   P0[10],P0[11],P0[12],P0[13], pw1[0]=PKW(P0,8), pw1[1]=PKW(P0,10), pw1); \
    GAPA(C1=__builtin_amdgcn_mfma_f32_32x32x16_bf16(kf[3],qr[1],C1,0,0,0),   P0[14],P0[15],P1[0],P1[1],   pw1[2]=PKW(P0,12),pw1[3]=PKW(P0,14), pw1); \
    VLD(0,0); SBAR(); GAPA(C0=__builtin_amdgcn_mfma_f32_32x32x16_bf16(kf[4],qr[2],C0,0,0,0),   P1[2],P1[3],P1[4],P1[5],     pw2[0]=PKW(P1,0), pw2[1]=PKW(P1,2), pw2); \
    VLD(1,4096); SBAR(); GAPA(C1=__builtin_amdgcn_mfma_f32_32x32x16_bf16(kf[5],qr[2],C1,0,0,0),   P1[6],P1[7],P1[8],P1[9],     pw2[2]=PKW(P1,4), pw2[3]=PKW(P1,6), pw2); \
    VLD(2,1024); SBAR(); GAPA(C0=__builtin_amdgcn_mfma_f32_32x32x16_bf16(kf[6],qr[3],C0,0,0,0),   P1[10],P1[11],P1[12],P1[13], pw3[0]=PKW(P1,8), pw3[1]=PKW(P1,10), pw3); \
    VLD(3,5120); SBAR(); GAPA(C1=__builtin_amdgcn_mfma_f32_32x32x16_bf16(kf[7],qr[3],C1,0,0,0),   P1[14],P1[15],0.f,0.f,       pw3[2]=PKW(P1,12),pw3[3]=PKW(P1,14), pw3); \
    l_reg+=sacc; \
    if(GK){DMA_K((t)+3,sl_cur);} if(GV){DMA_V((t)+1,sl_next);} \
    CMASK(C0,C1,t); \
    { float a=MX3(C0[0],C0[1],C1[0]),b=MX3(C0[2],C0[3],C1[1]); a=MX3(a,C1[2],C1[3]); \
      _Pragma("unroll") for(int r=4;r<16;r+=4){a=MX3(a,C0[r],C0[r+1]);b=MX3(b,C0[r+2],C0[r+3]);a=MX3(a,C1[r],C1[r+1]);b=MX3(b,C1[r+2],C1[r+3]);} \
      float rm=__builtin_fmaxf(a,b); { auto rr=__builtin_amdgcn_permlane32_swap(__float_as_uint(rm),__float_as_uint(rm),false,false); rm=__builtin_fmaxf(__uint_as_float(rr[0]),__uint_as_float(rr[1])); } \
      resc=false; \
      if(__builtin_expect(__any(rm>(float)THRL),0)){ const float dl=__builtin_fmaxf(rm,0.f); mhat+=dl; \
        _Pragma("unroll") for(int r=0;r<16;++r){C0[r]-=dl;C1[r]-=dl;} \
        _Pragma("unroll") for(int r=0;r<16;++r)negm[r]=-mhat; asm volatile("":"+v"(negm)); \
        const float f=__builtin_amdgcn_exp2f(-dl); l_reg*=f; if(hi==0)wsf[r32]=f; resc=true; } } \
    SBAR(); \
    GAPB(o[0]=__builtin_amdgcn_mfma_f32_32x32x16_bf16(PAF(0),VFR(0),o[0],0,0,0), C0,0); VLDS(0,2048); \
    GAPB(o[1]=__builtin_amdgcn_mfma_f32_32x32x16_bf16(PAF(0),VFR(1),o[1],0,0,0), C0,2); VLDS(1,6144); \
    KRD(GL,0); GAPB(o[0]=__builtin_amdgcn_mfma_f32_32x32x16_bf16(PAF(1),VFR(2),o[0],0,0,0), C0,4); VLDS(2,3072); \
    KRD(GL,1); GAPB(o[1]=__builtin_amdgcn_mfma_f32_32x32x16_bf16(PAF(1),VFR(3),o[1],0,0,0), C0,6); VLDS(3,7168); \
    KRD(GL,2); GAPB(o[0]=__builtin_amdgcn_mfma_f32_32x32x16_bf16(PAF(2),VFR(0),o[0],0,0,0), C0,8); VLDS(0,8192); \
    KRD(GL,3); GAPB(o[1]=__builtin_amdgcn_mfma_f32_32x32x16_bf16(PAF(2),VFR(1),o[1],0,0,0), C0,10); VLDS(1,12288); \
    GAPB(o[0]=__builtin_amdgcn_mfma_f32_32x32x16_bf16(PAF(3),VFR(2),o[0],0,0,0), C0,12); VLDS(2,9216); \
    GAPB(o[1]=__builtin_amdgcn_mfma_f32_32x32x16_bf16(PAF(3),VFR(3),o[1],0,0,0), C0,14); VLDS(3,13312); \
    GAPB(o[2]=__builtin_amdgcn_mfma_f32_32x32x16_bf16(PAF(0),VFR(0),o[2],0,0,0), C1,0); VLDS(0,10240); \
    GAPB(o[3]=__builtin_amdgcn_mfma_f32_32x32x16_bf16(PAF(0),VFR(1),o[3],0,0,0), C1,2); VLDS(1,14336); \
    GAPB(o[2]=__builtin_amdgcn_mfma_f32_32x32x16_bf16(PAF(1),VFR(2),o[2],0,0,0), C1,4); VLDS(2,11264); \
    GAPB(o[3]=__builtin_amdgcn_mfma_f32_32x32x16_bf16(PAF(1),VFR(3),o[3],0,0,0), C1,6); VLDS(3,15360); \
    GAPB(o[2]=__builtin_amdgcn_mfma_f32_32x32x16_bf16(PAF(2),VFR(0),o[2],0,0,0), C1,8); \
    GAPB(o[3]=__builtin_amdgcn_mfma_f32_32x32x16_bf16(PAF(2),VFR(1),o[3],0,0,0), C1,10); \
    GAPB(o[2]=__builtin_amdgcn_mfma_f32_32x32x16_bf16(PAF(3),VFR(2),o[2],0,0,0), C1,12); \
    GAPB(o[3]=__builtin_amdgcn_mfma_f32_32x32x16_bf16(PAF(3),VFR(3),o[3],0,0,0), C1,14); \
    }while(0)
  int t=1;
  #undef CMASK
  #define CMASK(P0,P1,t) do{}while(0)
  for(;t+5<NT;t+=2){
    STEP(pB0,pB1,pA0,pA1,t,true,true,true);     WAIT_BAR(3); RESC(); ROT();
    STEP(pA0,pA1,pB0,pB1,t+1,true,true,true);   WAIT_BAR(3); RESC(); ROT();
  }
  #undef CMASK
  #define CMASK(P0,P1,t) do{int jb_=(t)-(NT-4); if(jb_>=0)cmask(P0,P1,jb_,qrel,hi);}while(0)
  #define ENDW(tt) do{ if((tt)+3<NT){WAIT_BAR(3);} else if((tt)+2<NT){WAIT_BAR(2);} else {WAIT_BAR(0);} }while(0)
  for(;t+1<NT;t+=2){
    STEP(pB0,pB1,pA0,pA1,t,(t+3<NT),(t+1<NT),(t+1<NT));       ENDW(t);   RESC(); ROT();
    STEP(pA0,pA1,pB0,pB1,t+1,(t+4<NT),(t+2<NT),(t+2<NT));     ENDW(t+1); RESC(); ROT();
  }
  STEP(pB0,pB1,pA0,pA1,NT-1,false,false,false); RESC();
  { float sacc=pB0[0]+pB0[1]; _Pragma("unroll") for(int r=2;r<16;++r)sacc+=pB0[r]; _Pragma("unroll") for(int r=0;r<16;++r)sacc+=pB1[r]; l_reg+=sacc;
    pw0=(u32x4){PKW(pB0,0),PKW(pB0,2),PKW(pB0,4),PKW(pB0,6)};pw1=(u32x4){PKW(pB0,8),PKW(pB0,10),PKW(pB0,12),PKW(pB0,14)};pw2=(u32x4){PKW(pB1,0),PKW(pB1,2),PKW(pB1,4),PKW(pB1,6)};pw3=(u32x4){PKW(pB1,8),PKW(pB1,10),PKW(pB1,12),PKW(pB1,14)};
    SBAR(); pv(o,vb0+2*sl_cur,PAF(0),PAF(1),PAF(2),PAF(3)); pv(o+2,vb0+2*sl_cur+8192,PAF(0),PAF(1),PAF(2),PAF(3)); }
  #undef PKW
  #undef PAF
  #undef VFR
  #undef PIN
  #undef MX3
  #undef GAPA
  #undef GAPB
  #undef EX
  #undef VLD
  #undef VLDS
  #undef KRD
  #undef STEP
  #undef ENDW
  {auto rr=__builtin_amdgcn_permlane32_swap(__float_as_uint(l_reg),__float_as_uint(l_reg),false,false);l_reg=__uint_as_float(rr[0])+__uint_as_float(rr[1]);}
  if(hi==0)wsf[32+r32]=l_reg;asm volatile("s_waitcnt lgkmcnt(0)":::"memory");
  float rli[16];
  #pragma unroll
  for(int r=0;r<16;++r)rli[r]=__builtin_amdgcn_rcpf(wsf[32+crow(r,hi)]);
  bf16*Ow=Oh+(long)(q0+wid*QBLK)*PO;
  { bf16*stg=(bf16*)(shm+LDS2_OST)+wid*2048;
    #pragma unroll
    for(int h2=0;h2<2;++h2){
      #pragma unroll
      for(int r=0;r<16;++r){const int orow=crow(r,hi);
        #pragma unroll
        for(int d0=0;d0<2;++d0)stg[orow*64+d0*32+r32]=__float2bfloat16(o[2*h2+d0][r]*rli[r]);}
      asm volatile("s_waitcnt lgkmcnt(0)":::"memory");
      #pragma unroll
      for(int i=0;i<4;++i){const int row=i*8+(lane>>3),ch=lane&7; const u32x4 v=*(const u32x4*)(stg+row*64+ch*8); ATTN_STORE16(Ow+(long)row*PO+h2*64+ch*8,v);}
      asm volatile("s_waitcnt lgkmcnt(0)":::"memory"); } }
  asm volatile("s_waitcnt lgkmcnt(0)\n\ts_barrier":::"memory");
  #undef DMA_K
  #undef DMA_V
  #undef CMASK
  #undef START
  #undef RESC
  #undef ROT
}
constexpr int ATTN_LDS_BYTES=LDS_BYTES;
#undef SBAR
#undef WAIT_BAR
}

#define XB_TMO      128
#define XB_XCNT(j)  (256  + 64 * (j))
#define XB_XSUB(j)  (1280 + 64 * (j))
#define XB_XGEN(j)  (2304 + 64 * (j))
#define XB_TOP      3328
#define XB_TOPGEN   3392
#define XCD_BAR_WORDS 3456
#define XB_SPIN_CAP (1u << 22)
#define LAS __attribute__((address_space(3)))

__device__ __forceinline__ unsigned xb_ld(unsigned* p)              { return __hip_atomic_load(p, __ATOMIC_RELAXED, __HIP_MEMORY_SCOPE_AGENT); }
__device__ __forceinline__ unsigned xb_add(unsigned* p, unsigned v) { return __hip_atomic_fetch_add(p, v, __ATOMIC_RELAXED, __HIP_MEMORY_SCOPE_AGENT); }
__device__ __forceinline__ unsigned xb_xcc_id() { return (unsigned)__builtin_amdgcn_s_getreg((3 << 11) | 20) & 0xFu; }
#define XB_SPIN(cond, bar) do { unsigned _sp = 0; while (cond) { __builtin_amdgcn_s_sleep(1); \
    if ((++_sp & 255u) == 0u) { if (xb_ld(&(bar)[XB_TMO])) break; if (_sp > XB_SPIN_CAP) { atomicAdd(&(bar)[XB_TMO], 1u); break; } } } } while (0)

struct XcdBarrier {
    unsigned* bar; unsigned x;
    volatile LAS unsigned* st;
};

__device__ __forceinline__ XcdBarrier xcd_barrier_post(unsigned* bar, volatile LAS unsigned* st) {
    XcdBarrier b; b.bar = bar; b.x = xb_xcc_id(); b.st = st;
    if (threadIdx.x == 0) (void)xb_add(&bar[XB_XCNT(b.x)], 1u);
    return b;
}
__device__ __forceinline__ void xcd_barrier_complete(unsigned* bar, unsigned x, unsigned& nloc, unsigned& nx) {
    const unsigned G = gridDim.x * gridDim.y * gridDim.z;
    unsigned sum, cnt, mine, sp = 0u;
    for (;;) {
        sum = 0u; cnt = 0u; mine = 0u;
#pragma unroll
        for (unsigned j = 0; j < 16; ++j) { const unsigned c = xb_ld(&bar[XB_XCNT(j)]); sum += c; cnt += (c > 0u) ? 1u : 0u; mine = (j == x) ? c : mine; }
        if (sum == G) break;
        __builtin_amdgcn_s_sleep(1);
        if ((++sp & 255u) == 0u) { if (xb_ld(&bar[XB_TMO])) break; if (sp > XB_SPIN_CAP) { atomicAdd(&bar[XB_TMO], 1u); break; } }
    }
    nloc = mine > 0u ? mine : 1u; nx = cnt > 0u ? cnt : 1u;
}

__device__ __forceinline__ void xcd_barrier(const XcdBarrier& b) {
    asm volatile("s_waitcnt vmcnt(0)" ::: "memory");
    __syncthreads();
    if (threadIdx.x == 0) {
        unsigned* bar = b.bar; unsigned bx = b.x; asm volatile("" : "+s"(bx));
        __builtin_amdgcn_s_waitcnt(0);
        unsigned nloc = b.st[0], nx = b.st[1];
        if (nloc == 0u) { xcd_barrier_complete(bar, bx, nloc, nx); b.st[0] = nloc; b.st[1] = nx; }
        const unsigned old = xb_add(&bar[XB_XSUB(bx)], 1u);
        const unsigned gen = old / nloc;
        if (old + 1u == (gen + 1u) * nloc) {
            __builtin_amdgcn_fence(__ATOMIC_RELEASE, "agent");
            asm volatile("s_waitcnt vmcnt(0)" ::: "memory");
            const unsigned og = xb_add(&bar[XB_TOP], 1u);
            const unsigned tg = og / nx;
            if (og + 1u == (tg + 1u) * nx) xb_add(&bar[XB_TOPGEN], 1u);
            else XB_SPIN(xb_ld(&bar[XB_TOPGEN]) == tg, bar);
            __builtin_amdgcn_fence(__ATOMIC_ACQUIRE, "agent");
            xb_add(&bar[XB_XGEN(bx)], 1u);
            asm volatile("s_waitcnt vmcnt(0)" ::: "memory");
        } else {
            XB_SPIN(xb_ld(&bar[XB_XGEN(bx)]) == gen, bar);
            __builtin_amdgcn_fence(__ATOMIC_ACQUIRE, "agent");
            asm volatile("s_waitcnt vmcnt(0)" ::: "memory");
        }
    }
    __syncthreads();
}


#define LAS __attribute__((address_space(3)))
typedef unsigned short bf16_t;
typedef float f32x4 __attribute__((ext_vector_type(4)));
typedef unsigned u32x4 __attribute__((ext_vector_type(4)));
typedef unsigned u32x2 __attribute__((ext_vector_type(2)));

constexpr int T = 16384, DM = 1024, SEQ = 4096, NB = 4, DEPTH = 2;
constexpr int PLD = 13568;
constexpr int C_Z = 0, C_X = 512, C_QB = 1280, C_KB = 2816, C_VB = 4352, C_QC = 5888, C_KC = 6400, C_VC = 6912,
              C_QD = 7424, C_FD = 7936, C_ID = 8448, C_GD = 8960, C_GATE = 9472;
constexpr int WIN_LD = 13576;
constexpr float EPS = 1e-6f;
constexpr int NWAVES = 8, NTHR = 512;
constexpr int MAXROWS = 49152;

constexpr size_t MiB = 1u << 20, KiB = 1u << 10;
constexpr size_t WS_CTL = 0, CTL_ZERO_BYTES = 1 * MiB;
constexpr int CW_BAR = 4096;
constexpr int CW_WQ = 8192;
constexpr int CW_ECNT = 9216;
constexpr size_t WS_SSQ = 3 * MiB + 256 * KiB;
constexpr size_t WS_MOD = 1 * MiB;
constexpr size_t WS_DT = 1 * MiB + 256 * KiB;
constexpr size_t WS_RE = 2 * MiB, WS_RS = WS_RE + 128 * KiB, WS_RW = WS_RE + 256 * KiB, WS_POS = WS_RE + 384 * KiB;
constexpr size_t WS_ROWTOK = 3 * MiB + 512 * KiB;
constexpr size_t WS_CNT = 3 * MiB + 256 * KiB;
constexpr size_t WS_LSE = WS_RE + 512 * KiB;
constexpr size_t WS_WIN = 4 * MiB;
constexpr size_t WS_WMG = 31 * MiB;
constexpr size_t WS_WOUT = 35 * MiB;
constexpr size_t WS_H = 38 * MiB;
constexpr size_t WS_MIXS = 70 * MiB;
constexpr size_t WS_BR = 102 * MiB;
constexpr size_t WS_P = 166 * MiB;
constexpr size_t WS_E1 = WS_P, WS_E2 = WS_P + 64 * MiB, WS_XS = WS_P + 96 * MiB, WS_HID = WS_P + 192 * MiB, WS_Y = WS_P + 216 * MiB;
constexpr size_t WS_O16 = 590 * MiB;
constexpr size_t WS_END = 622 * MiB;
constexpr size_t WS_CT = WS_H, WS_VT = WS_H + 16 * MiB;
constexpr size_t WS_QG = WS_MIXS, WS_KHT = WS_MIXS + 16 * MiB;
constexpr size_t WS_HL = WS_WIN, WS_DG = WS_WIN + 16 * MiB, WS_DEC = WS_WIN + 17 * MiB;
constexpr int CW_P2 = 9472;
static_assert(WS_Y + (size_t)MAXROWS * 1024 * 2 <= WS_END && WS_P + (size_t)T * PLD * 2 <= WS_END, "ws map");
static_assert(WS_WIN + (size_t)PLD * 1024 * 2 <= WS_WMG, "ws map");

constexpr int SCR_BYTES = 131072, MISC_OFF = SCR_BYTES, LDS_BYTES = 147456;

__device__ __forceinline__ float bf2f(bf16_t v) { return __uint_as_float(((unsigned)v) << 16); }
typedef float pk_f32x2 __attribute__((ext_vector_type(2))); typedef __bf16 pk_bf16x2 __attribute__((ext_vector_type(2)));
__device__ __forceinline__ unsigned pk2(float lo, float hi) { const pk_f32x2 v = {lo, hi}; return __builtin_bit_cast(unsigned, __builtin_convertvector(v, pk_bf16x2)); }
__device__ __forceinline__ unsigned f2bf(float f) { return pk2(f, 0.f) & 0xffffu; }
__device__ __forceinline__ float lo2f(unsigned w) { return __uint_as_float(w << 16); }
__device__ __forceinline__ float hi2f(unsigned w) { return __uint_as_float(w & 0xffff0000u); }
#define wave_sum(v) wave_sum_(v, lane)
#define wave_max(v) wave_max_(v, lane)
__device__ __forceinline__ float wave_sum_(float v, int lane) {
#pragma unroll
    for (int o = 32; o >= 1; o >>= 1) v += __int_as_float(__builtin_amdgcn_ds_bpermute((lane ^ o) << 2, __float_as_int(v)));
    return v; }
__device__ __forceinline__ float wave_max_(float v, int lane) {
#pragma unroll
    for (int o = 32; o >= 1; o >>= 1) v = fmaxf(v, __int_as_float(__builtin_amdgcn_ds_bpermute((lane ^ o) << 2, __float_as_int(v))));
    return v; }
__device__ __forceinline__ float sigmoidf_(float x) { return __builtin_amdgcn_rcpf(1.0f + __expf(-x)); }
__device__ __forceinline__ float siluf_(float x) { return x * __builtin_amdgcn_rcpf(1.0f + __expf(-x)); }
__device__ __forceinline__ float softplusf_(float x) { return x > 20.f ? x : log1pf(__expf(x)); }

struct Ctx {
    float* out; unsigned char* ws;
    LAS unsigned char* lds;
    int G, bid;
};
#define PH_IDS() int tid = threadIdx.x; asm volatile("" : "+v"(tid)); const int lane = tid & 63; const int wave = __builtin_amdgcn_readfirstlane(tid >> 6); (void)lane; (void)wave
__device__ __forceinline__ const float* inp_ptr(const Ctx& C, int k) {
    unsigned ta = MISC_OFF + 1024 + 8 * k; asm volatile("" : "+s"(ta));
    const LAS unsigned* t = (const LAS unsigned*)(LAS unsigned char*)(size_t)0 + 0; t = (const LAS unsigned*)(C.lds + ta);
    const unsigned lo = __builtin_amdgcn_readfirstlane(t[0]), hi = __builtin_amdgcn_readfirstlane(t[1]);
    return (const float*)(((unsigned long long)hi << 32) | lo);
}
#define INP(k) inp_ptr(C, k)
#define MISCW(C) ((volatile LAS unsigned*)((C).lds + MISC_OFF))
enum { I_X = 0, I_C, I_WADA, I_BADA, I_NMIX, I_NFFN, I_WIN, I_CONVW, I_CONVB, I_DTB, I_ALOG, I_SSDD, I_SSDNW, I_DLAM, I_SUBLN, I_LBL, I_HGNW, I_WMG, I_WOUT, I_WR, I_RB, I_EG, I_EU, I_ED, I_FNW };

__device__ __forceinline__ void pro_mods(const Ctx& C) {
    PH_IDS();
    LAS float* cact = (LAS float*)C.lds;
    LAS float* red = cact + 4096;
    for (int i = tid; i < 4096; i += NTHR) cact[i] = siluf_(INP(I_C)[i]);
    __syncthreads();
    float* mod = (float*)(C.ws + WS_MOD);
    const int kr = lane >> 4, c4 = lane & 15;
    for (int u = C.bid; u < 2 * 96; u += C.G) {
        const int l = u / 96, col0 = (u % 96) * 64;
        const float* w = INP(I_WADA) + (size_t)l * 1024 * 6144 + col0 + 4 * c4;
        f32x4 a0 = {0.f, 0.f, 0.f, 0.f}, a1 = a0, a2 = a0, a3 = a0;
        const int kb = wave * 128 + kr;
#pragma unroll 16
        for (int kk = 0; kk < 32; ++kk) { const int k = kb + 4 * kk; const f32x4 wv = *(const f32x4*)(w + (size_t)k * 6144);
            a0 += cact[k] * wv; a1 += cact[1024 + k] * wv; a2 += cact[2048 + k] * wv; a3 += cact[3072 + k] * wv; }
        { LAS float* rp = red + ((wave * 4 + kr) * 4) * 64 + 4 * c4;
          *(LAS f32x4*)(rp) = a0; *(LAS f32x4*)(rp + 64) = a1; *(LAS f32x4*)(rp + 128) = a2; *(LAS f32x4*)(rp + 192) = a3; }
        __syncthreads();
        if (tid < 256) { const int b = tid >> 6, cl = tid & 63; float s = 0.f;
#pragma unroll
            for (int g = 0; g < 32; ++g) s += red[(g * 4 + b) * 64 + cl];
            mod[((size_t)l * 4 + b) * 6144 + col0 + cl] = s + INP(I_BADA)[l * 6144 + col0 + cl]; }
        __syncthreads();
    }
}

template <class Map> __device__ __forceinline__ void transpose_tile(const float* src, int ld, int k0, int n0, bf16_t* dst, int K, const Map& mp, LAS float* scr, int lane) {
    const int nn_l = lane & 31, kh = lane >> 5;
    float tv[32];
    { const float* sp = src + (size_t)(k0 + kh) * ld + mp.scol(n0 + nn_l);
#pragma unroll
      for (int i = 0; i < 32; ++i) tv[i] = sp[(size_t)(2 * i) * ld]; }
#pragma unroll
    for (int i = 0; i < 32; ++i) scr[(2 * i + kh) * 33 + nn_l] = tv[i];
    asm volatile("s_waitcnt vmcnt(0) lgkmcnt(0)" ::: "memory");
    const int kp = lane & 31;
#pragma unroll 4
    for (int j = 0; j < 16; ++j) { const int nn = 2 * j + kh; const float sc = mp.scale(n0 + nn);
        const float v0 = scr[(2 * kp) * 33 + nn] * sc, v1 = scr[(2 * kp + 1) * 33 + nn] * sc;
        *(unsigned*)(dst + (size_t)mp.drow(n0 + nn) * K + k0 + 2 * kp) = pk2(v0, v1); }
    asm volatile("s_waitcnt lgkmcnt(0)" ::: "memory");
}
struct MapWin {
    __device__ __forceinline__ int scol(int n) const { return n < 1280 ? n : n + 8; }
    __device__ __forceinline__ int drow(int n) const { return n; }
    __device__ __forceinline__ float scale(int n) const { return (n >= C_QC && n < C_QC + 512) ? 0.125f * 1.4426950408889634f : 1.0f; }
};
struct MapPlain { int roff;
    __device__ __forceinline__ int scol(int n) const { return n; }
    __device__ __forceinline__ int drow(int n) const { return roff + n; }
    __device__ __forceinline__ float scale(int) const { return 1.0f; }
};
struct MapGU { int roff, up;
    __device__ __forceinline__ int scol(int n) const { return n; }
    __device__ __forceinline__ int drow(int j) const { return roff + (j >> 7) * 256 + ((j & 127) >> 2) * 8 + (j & 3) + 4 * up; }
    __device__ __forceinline__ float scale(int) const { return 1.0f; }
};
__device__ __forceinline__ void convert_main(const Ctx& C, int l) {
    PH_IDS();
    LAS float* scr = (LAS float*)C.lds + wave * (64 * 33);
    const int gw = C.bid * NWAVES + wave, NGW = C.G * NWAVES;
    constexpr int I_A = 16 * (PLD / 32), I_B = 4 * 8 * 32, I_C2 = 16 * 32;
    bf16_t* WIN = (bf16_t*)(C.ws + WS_WIN); bf16_t* WMG = (bf16_t*)(C.ws + WS_WMG); bf16_t* WO = (bf16_t*)(C.ws + WS_WOUT);
    for (int it = gw; it < I_A + I_B + I_C2; it += NGW) {
        int r = it;
        if (r < I_A) { const int kt = r & 15, nt = r >> 4; transpose_tile(INP(I_WIN) + (size_t)l * 1024 * WIN_LD, WIN_LD, kt * 64, nt * 32, WIN, 1024, MapWin{}, scr, lane); continue; }
        r -= I_A;
        if (r < I_B) { const int n = r >> 8, q = r & 255, kt = q & 7, nt = q >> 3;
            transpose_tile(INP(I_WMG) + ((size_t)l * 4 + n) * 512 * 1024, 1024, kt * 64, nt * 32, WMG, 512, MapPlain{n * 1024}, scr, lane); continue; }
        r -= I_B;
        { const int kt = r & 15, nt = r >> 4; transpose_tile(INP(I_WOUT) + (size_t)l * 1024 * 1024, 1024, kt * 64, nt * 32, WO, 1024, MapPlain{0}, scr, lane); }
    }
}
__device__ __forceinline__ void convert_experts(const Ctx& C, int l) {
    PH_IDS();
    LAS float* scr = (LAS float*)C.lds + wave * (64 * 33);
    const int gw = C.bid * NWAVES + wave, NGW = C.G * NWAVES;
    bf16_t* E1 = (bf16_t*)(C.ws + WS_E1); bf16_t* E2 = (bf16_t*)(C.ws + WS_E2);
    for (int it = gw; it < 64 * 384; it += NGW) {
        const int e = it / 384, r = it % 384, m = r >> 7, q = r & 127;
        if (m < 2) { const int kt = q & 15, nt = q >> 4;
            transpose_tile(INP(m == 0 ? I_EG : I_EU) + ((size_t)l * 64 + e) * 1024 * 256, 256, kt * 64, nt * 32, E1, 1024, MapGU{e * 512, m}, scr, lane); }
        else { const int kt = q & 3, nt = q >> 2;
            transpose_tile(INP(I_ED) + ((size_t)l * 64 + e) * 256 * 1024, 1024, kt * 64, nt * 32, E2, 256, MapPlain{e * 1024}, scr, lane); }
    }
}

struct ConvItem { const float* src; bf16_t* dst; int ld, k0, n0, K, kind, roff, up; };
__device__ __forceinline__ bool conv_item(const Ctx& C, int l, int idx, bool with_main, ConvItem& it) {
    if (idx < 64 * 384) { const int e = idx / 384, r = idx % 384, m = r >> 7, q = r & 127;
        if (m < 2) { it.src = INP(m == 0 ? I_EG : I_EU) + ((size_t)l * 64 + e) * 1024 * 256; it.ld = 256; it.k0 = (q & 15) * 64; it.n0 = (q >> 4) * 32; it.dst = (bf16_t*)(C.ws + WS_E1); it.K = 1024; it.kind = 2; it.roff = e * 512; it.up = m; }
        else { it.src = INP(I_ED) + ((size_t)l * 64 + e) * 256 * 1024; it.ld = 1024; it.k0 = (q & 3) * 64; it.n0 = (q >> 2) * 32; it.dst = (bf16_t*)(C.ws + WS_E2); it.K = 256; it.kind = 1; it.roff = e * 1024; it.up = 0; }
        return true; }
    if (!with_main) return false;
    int r = idx - 64 * 384; constexpr int I_A = 16 * (PLD / 32), I_B = 4 * 8 * 32, I_C2 = 16 * 32;
    if (r >= I_A + I_B + I_C2) return false;
    it.up = 0;
    if (r < I_A) { it.src = INP(I_WIN) + (size_t)(l + 1) * 1024 * WIN_LD; it.ld = WIN_LD; it.k0 = (r & 15) * 64; it.n0 = (r >> 4) * 32; it.dst = (bf16_t*)(C.ws + WS_WIN); it.K = 1024; it.kind = 0; it.roff = 0; return true; }
    r -= I_A;
    if (r < I_B) { const int n = r >> 8, q = r & 255; it.src = INP(I_WMG) + ((size_t)(l + 1) * 4 + n) * 512 * 1024; it.ld = 1024; it.k0 = (q & 7) * 64; it.n0 = (q >> 3) * 32; it.dst = (bf16_t*)(C.ws + WS_WMG); it.K = 512; it.kind = 1; it.roff = n * 1024; return true; }
    r -= I_B;
    it.src = INP(I_WOUT) + (size_t)(l + 1) * 1024 * 1024; it.ld = 1024; it.k0 = (r & 15) * 64; it.n0 = (r >> 4) * 32; it.dst = (bf16_t*)(C.ws + WS_WOUT); it.K = 1024; it.kind = 1; it.roff = 0; return true;
}
__device__ __forceinline__ void conv_load(const ConvItem& it, float (&tv)[32], int lane) {
    const int nn = it.n0 + (lane & 31), kh = lane >> 5; const int scol = (it.kind == 0 && nn >= 1280) ? nn + 8 : nn;
    const float* sp = it.src + (size_t)(it.k0 + kh) * it.ld + scol;
#pragma unroll
    for (int i = 0; i < 32; ++i) tv[i] = sp[(size_t)(2 * i) * it.ld];
}
__device__ __forceinline__ void conv_store(const ConvItem& it, const float (&tv)[32], LAS float* scr, int lane) {
    const int nn_l = lane & 31, kh = lane >> 5, kp = lane & 31;
#pragma unroll
    for (int i = 0; i < 32; ++i) scr[(2 * i + kh) * 33 + nn_l] = tv[i];
    asm volatile("s_waitcnt lgkmcnt(0)" ::: "memory");
#pragma unroll 4
    for (int j = 0; j < 16; ++j) { const int n = it.n0 + 2 * j + kh;
        const float sc = (it.kind == 0 && n >= C_QC && n < C_QC + 512) ? 0.125f * 1.4426950408889634f : 1.0f;
        const int drow = (it.kind == 2) ? it.roff + (n >> 7) * 256 + ((n & 127) >> 2) * 8 + (n & 3) + 4 * it.up : it.roff + n;
        const float v0 = scr[(2 * kp) * 33 + 2 * j + kh] * sc, v1 = scr[(2 * kp + 1) * 33 + 2 * j + kh] * sc;
        *(unsigned*)(it.dst + (size_t)drow * it.K + it.k0 + 2 * kp) = pk2(v0, v1); }
    asm volatile("s_waitcnt lgkmcnt(0)" ::: "memory");
}

template <int MODE> __device__ __forceinline__ void phase_rows(const Ctx& C, int l, bool combine) {
    PH_IDS();
    LAS float* wdt = (LAS float*)C.lds;
    if (MODE == 0) {
        const float* w = INP(I_WIN) + (size_t)l * 1024 * WIN_LD + 1280;
        for (int i = tid; i < 8192; i += NTHR) { const int k = i >> 3, j = i & 7; wdt[j * 1024 + k] = w[(size_t)k * WIN_LD + j]; }
        __syncthreads();
    }
    const int gw = C.bid * NWAVES + wave, NGW = C.G * NWAVES;
    const float* mod = (const float*)(C.ws + WS_MOD);
    float* xres = C.out; bf16_t* hb = (bf16_t*)(C.ws + WS_H); float* dtraw = (float*)(C.ws + WS_DT);
    const int* pos = (const int*)(C.ws + WS_POS); const bf16_t* Y = (const bf16_t*)(C.ws + WS_Y);
    const float* rwt = (const float*)(C.ws + WS_RW);
    const float* xsrc = (l == 0 && MODE == 0) ? INP(I_X) : xres;
    constexpr int RB = 2;
    int p0n[RB], p1n[RB]; float rw0n[RB], rw1n[RB];
#define ROWS_LOAD1(R0) do { _Pragma("unroll") for (int q = 0; q < RB; ++q) { \
        if (combine) { p0n[q] = pos[((R0) + q) * 2]; p1n[q] = pos[((R0) + q) * 2 + 1]; rw0n[q] = rwt[((R0) + q) * 2]; rw1n[q] = rwt[((R0) + q) * 2 + 1]; } else { p0n[q] = 0; p1n[q] = 0; rw0n[q] = 0.f; rw1n[q] = 0.f; } } } while (0)
    ROWS_LOAD1(gw * RB);
    for (int r0 = gw * RB; r0 < T; r0 += NGW * RB) {
        const int b = r0 >> 12;
        f32x4 v[RB][4]; int p0[RB], p1[RB]; float rw0[RB], rw1[RB];
#pragma unroll
        for (int q = 0; q < RB; ++q) { p0[q] = p0n[q]; p1[q] = p1n[q]; rw0[q] = rw0n[q]; rw1[q] = rw1n[q];
#pragma unroll
            for (int j = 0; j < 4; ++j) v[q][j] = *(const f32x4*)(xsrc + (size_t)(r0 + q) * DM + 4 * lane + 256 * j); }
        { const int rn = (r0 + NGW * RB < T) ? r0 + NGW * RB : r0; ROWS_LOAD1(rn); }
        f32x4 nwv[4], scv[4], shv[4];
        if (MODE == 0) { const float* nw = INP(I_NMIX) + l * DM; const float* sh = mod + ((size_t)l * 4 + b) * 6144; const float* sc = sh + 1024;
#pragma unroll
            for (int j = 0; j < 4; ++j) { const int col = 4 * lane + 256 * j; nwv[j] = *(const f32x4*)(nw + col); scv[j] = *(const f32x4*)(sc + col); shv[j] = *(const f32x4*)(sh + col); } }
        if (combine) {
            const float* g2 = mod + ((size_t)(l - 1) * 4 + b) * 6144 + 5120;
            f32x4 g2v[4];
#pragma unroll
            for (int j = 0; j < 4; ++j) g2v[j] = *(const f32x4*)(g2 + 4 * lane + 256 * j);
            u32x2 ya[RB][4], yb[RB][4];
#pragma unroll
            for (int q = 0; q < RB; ++q)
#pragma unroll
                for (int j = 0; j < 4; ++j) { const int col = 4 * lane + 256 * j; ya[q][j] = *(const u32x2*)(Y + (size_t)p0[q] * DM + col); yb[q][j] = *(const u32x2*)(Y + (size_t)p1[q] * DM + col); }
#pragma unroll
            for (int j = 0; j < 4; ++j) { const int col = 4 * lane + 256 * j; const f32x4 g = g2v[j];
#pragma unroll
                for (int q = 0; q < RB; ++q) {
                    v[q][j].x += g.x * (rw0[q] * lo2f(ya[q][j].x) + rw1[q] * lo2f(yb[q][j].x)); v[q][j].y += g.y * (rw0[q] * hi2f(ya[q][j].x) + rw1[q] * hi2f(yb[q][j].x));
                    v[q][j].z += g.z * (rw0[q] * lo2f(ya[q][j].y) + rw1[q] * lo2f(yb[q][j].y)); v[q][j].w += g.w * (rw0[q] * hi2f(ya[q][j].y) + rw1[q] * hi2f(yb[q][j].y));
                    if (MODE == 0) *(f32x4*)(xres + (size_t)(r0 + q) * DM + col) = v[q][j]; } }
        }
        float rstd[RB];
#pragma unroll
        for (int q = 0; q < RB; ++q) { float ss = 0.f;
#pragma unroll
            for (int j = 0; j < 4; ++j) ss += (v[q][j].x * v[q][j].x + v[q][j].y * v[q][j].y) + (v[q][j].z * v[q][j].z + v[q][j].w * v[q][j].w);
            rstd[q] = rsqrtf(wave_sum(ss) * (1.0f / DM) + EPS); }
        if (MODE == 1) {
#pragma unroll
            for (int j = 0; j < 4; ++j) { const int col = 4 * lane + 256 * j; const f32x4 w = *(const f32x4*)(INP(I_FNW) + col);
#pragma unroll
                for (int q = 0; q < RB; ++q) *(f32x4*)(C.out + (size_t)(r0 + q) * DM + col) = v[q][j] * rstd[q] * w; }
        } else {
            float da[RB][8];
#pragma unroll
            for (int q = 0; q < RB; ++q)
#pragma unroll
                for (int i = 0; i < 8; ++i) da[q][i] = 0.f;
#pragma unroll
            for (int j = 0; j < 4; ++j) { const int col = 4 * lane + 256 * j;
                const f32x4 w = nwv[j], s1 = scv[j], s0 = shv[j];
                f32x4 hv[RB];
#pragma unroll
                for (int q = 0; q < RB; ++q) { hv[q] = v[q][j] * rstd[q] * w * (s1 + 1.0f) + s0;
                    u32x2 o; o.x = pk2(hv[q].x, hv[q].y); o.y = pk2(hv[q].z, hv[q].w);
                    *(u32x2*)(hb + (size_t)(r0 + q) * DM + col) = o; }
#pragma unroll
                for (int i = 0; i < 8; ++i) { const f32x4 wd = *(const LAS f32x4*)(wdt + i * 1024 + col);
#pragma unroll
                    for (int q = 0; q < RB; ++q) da[q][i] += (hv[q].x * wd.x + hv[q].y * wd.y) + (hv[q].z * wd.z + hv[q].w * wd.w); } }
#pragma unroll
            for (int q = 0; q < RB; ++q) {
#pragma unroll
                for (int i = 0; i < 8; ++i) da[q][i] = wave_sum(da[q][i]);
                if (lane == 0) { *(f32x4*)(dtraw + (size_t)(r0 + q) * 8) = (f32x4){da[q][0], da[q][1], da[q][2], da[q][3]}; *(f32x4*)(dtraw + (size_t)(r0 + q) * 8 + 4) = (f32x4){da[q][4], da[q][5], da[q][6], da[q][7]}; } }
        }
    }
}

typedef float n2_f32x16 __attribute__((ext_vector_type(16)));
__device__ __forceinline__ void phase_n2(const Ctx& C, int l, bool with_main) {
    PH_IDS();
    constexpr int HP = 129;
    LAS float* hsl = (LAS float*)C.lds;
    LAS float* wsl = hsl + 8320;
    LAS float* Pl = hsl;
    LAS float* cscr = (wave < 7) ? (LAS float*)(C.lds + 66048 + wave * 8448) : (LAS float*)(C.lds + MISC_OFF + 4096);
    const int cgw = C.bid * NWAVES + wave, CNGW = C.G * NWAVES;
    const int ctotal = 64 * 384 + (with_main ? (16 * (PLD / 32) + 4 * 8 * 32 + 16 * 32) : 0);
    int cj = 0;
    const float* mod = (const float*)(C.ws + WS_MOD);
    const float* xres = C.out; bf16_t* hb = (bf16_t*)(C.ws + WS_H);
    int* r_e = (int*)(C.ws + WS_RE); int* r_s = (int*)(C.ws + WS_RS); float* r_w = (float*)(C.ws + WS_RW);
    const float* wr = INP(I_WR); const float rbias = INP(I_RB)[lane];
    const float* nw = INP(I_NFFN) + l * DM;
    const int n32 = lane & 31, hi = lane >> 5, et = wave & 1, rt = (wave >> 1) & 1, kh = wave >> 2;
    for (int rb = C.bid; rb < T / 64; rb += C.G) {
        const int rbase = rb * 64 + wave * 8, b = (rb * 64) >> 12;
        const float* sh = mod + ((size_t)l * 4 + b) * 6144 + 3072; const float* sc = sh + 1024;
        float rstd[8];
#pragma unroll
        for (int r = 0; r < 8; ++r) { float ss = 0.f;
#pragma unroll
            for (int jj = 0; jj < 4; ++jj) { const f32x4 v = *(const f32x4*)(xres + (size_t)(rbase + r) * DM + 4 * lane + 256 * jj); ss += (v.x * v.x + v.y * v.y) + (v.z * v.z + v.w * v.w); }
            rstd[r] = rsqrtf(wave_sum(ss) * (1.0f / DM) + EPS); }
        const int sr = lane >> 3, c16 = lane & 7;
        float myrs = rstd[0];
#pragma unroll
        for (int r = 1; r < 8; ++r) myrs = (sr == r) ? rstd[r] : myrs;
        n2_f32x16 acc;
#pragma unroll
        for (int r = 0; r < 16; ++r) acc[r] = 0.f;
        f32x4 xv[4], nwv[4], scv[4], shv[4], wv4[4];
#define N2_LOAD(S8) do { const int col0_ = 128 * (S8) + 4 * c16; const size_t row_ = (size_t)(rbase + sr);     \
            _Pragma("unroll") for (int q = 0; q < 4; ++q) { xv[q] = *(const f32x4*)(xres + row_ * DM + col0_ + 32 * q); nwv[q] = *(const f32x4*)(nw + col0_ + 32 * q); scv[q] = *(const f32x4*)(sc + col0_ + 32 * q); shv[q] = *(const f32x4*)(sh + col0_ + 32 * q); \
                wv4[q] = *(const f32x4*)(wr + (size_t)128 * 64 * (S8) + 4 * (tid + 512 * q)); } } while (0)
        N2_LOAD(0);
        for (int s8 = 0; s8 < 8; ++s8) {
            __syncthreads();
            { const int col0 = 128 * s8 + 4 * c16; const size_t row = (size_t)(rbase + sr);
#pragma unroll
              for (int q = 0; q < 4; ++q) { const int col = col0 + 32 * q;
                  const f32x4 hv = xv[q] * myrs * nwv[q] * (scv[q] + 1.0f) + shv[q];
                  u32x2 o; o.x = pk2(hv.x, hv.y); o.y = pk2(hv.z, hv.w);
                  *(u32x2*)(hb + row * DM + col) = o;
                  LAS float* hp = hsl + (8 * wave + sr) * HP + 4 * c16 + 32 * q; hp[0] = hv.x; hp[1] = hv.y; hp[2] = hv.z; hp[3] = hv.w; } }
#pragma unroll
            for (int i = 0; i < 4; ++i) *(LAS f32x4*)(wsl + 4 * (tid + 512 * i)) = wv4[i];
            if (s8 + 1 < 8) N2_LOAD(s8 + 1);
            ConvItem ci0; float tv0[32];
            const bool cv0 = (cgw + cj * CNGW < ctotal) && conv_item(C, l, cgw + cj * CNGW, with_main, ci0); ++cj;
            if (cv0) conv_load(ci0, tv0, lane);
            __syncthreads();
            const LAS float* ap = wsl + (64 * kh + hi) * 64 + 32 * et + n32; const LAS float* bp = hsl + (32 * rt + n32) * HP + 64 * kh + hi;
#pragma unroll 8
            for (int ks = 0; ks < 32; ++ks) acc = __builtin_amdgcn_mfma_f32_32x32x2f32(ap[ks * 128], bp[ks * 2], acc, 0, 0, 0);
            if (cv0) conv_store(ci0, tv0, cscr, lane);
        }
#undef N2_LOAD
        __syncthreads();
#pragma unroll
        for (int r = 0; r < 16; ++r) Pl[(kh * 64 + 32 * rt + n32) * 64 + 32 * et + (r & 3) + 8 * (r >> 2) + 4 * hi] = acc[r];
        __syncthreads();
        LAS float* sw = wsl + wave * 1024; LAS int* pick = (LAS int*)(hsl + 8192);
#pragma unroll
        for (int r = 0; r < 8; ++r) { const float lg = Pl[(8 * wave + r) * 64 + lane] + Pl[(64 + 8 * wave + r) * 64 + lane]; const float sg = sigmoidf_(lg); sw[r * 64 + lane] = sg + rbias; sw[512 + r * 64 + lane] = sg; }
        asm volatile("s_waitcnt lgkmcnt(0)" ::: "memory");
        if (lane < 8) {
            const LAS float* sel = sw + lane * 64; const LAS float* sco = sw + 512 + lane * 64;
            int best = 0; float bestv = -3.0e38f;
            for (int g = 0; g < 8; ++g) { float m1 = -3.0e38f, m2 = -3.0e38f;
                for (int i = 0; i < 8; ++i) { const float x = sel[g * 8 + i]; if (x > m1) { m2 = m1; m1 = x; } else if (x > m2) m2 = x; }
                const float gs = m1 + m2; if (gs > bestv) { bestv = gs; best = g; } }
            int i0 = 0; float v0 = -3.0e38f;
            for (int i = 0; i < 8; ++i) { const float x = sel[best * 8 + i]; if (x > v0) { v0 = x; i0 = i; } }
            int i1 = 0; float v1 = -3.0e38f;
            for (int i = 0; i < 8; ++i) { if (i == i0) continue; const float x = sel[best * 8 + i]; if (x > v1) { v1 = x; i1 = i; } }
            const int e0 = best * 8 + i0, e1 = best * 8 + i1; const float s0 = sco[e0], s1 = sco[e1], inv = 1.0f / (s0 + s1);
            const int row = rbase + lane;
            r_e[row * 2] = e0; r_e[row * 2 + 1] = e1; r_w[row * 2] = s0 * inv; r_w[row * 2 + 1] = s1 * inv;
            pick[(wave * 8 + lane) * 2] = e0; pick[(wave * 8 + lane) * 2 + 1] = e1;
        }
        __syncthreads();
        if (tid < 64) { int cnt = 0;
            for (int i = 0; i < 128; ++i) if (pick[i] == tid) { r_s[rb * 128 + i] = cnt; ++cnt; }
            ((int*)(C.ws + WS_CNT))[rb * 64 + tid] = cnt; }
    }
    { ConvItem ca; float ta[32]; bool va = (cgw + cj * CNGW < ctotal) && conv_item(C, l, cgw + cj * CNGW, with_main, ca); if (va) conv_load(ca, ta, lane);
      while (va) { ++cj;
          ConvItem cb; float tb[32]; const bool vb = (cgw + cj * CNGW < ctotal) && conv_item(C, l, cgw + cj * CNGW, with_main, cb); if (vb) conv_load(cb, tb, lane);
          conv_store(ca, ta, cscr, lane);
          ca = cb; va = vb;
#pragma unroll
          for (int i = 0; i < 32; ++i) ta[i] = tb[i]; } }
}

__device__ __forceinline__ void phase_scatter(const Ctx& C, int l) {
    PH_IDS();
    LAS unsigned char* blk_e = C.lds + MISC_OFF + 64; LAS int* blk0 = (LAS int*)(C.lds + MISC_OFF + 512);
    LAS int* basel = (LAS int*)C.lds; LAS int* totl = basel + 64; LAS int* parts = basel + 128;
    const int* CNT = (const int*)(C.ws + WS_CNT);
    const int* r_e = (const int*)(C.ws + WS_RE); const int* r_s = (const int*)(C.ws + WS_RS);
    int* pos = (int*)(C.ws + WS_POS); int* ROWTOK = (int*)(C.ws + WS_ROWTOK);
    bool first = true;
    for (int rb = C.bid; rb < T / 64 || first; rb += C.G) {
        __syncthreads();
        { const int e = tid & 63, part = tid >> 6; int base = 0, tot = 0; int cv[32];
#pragma unroll
          for (int w = 0; w < 32; ++w) cv[w] = CNT[(part * 32 + w) * 64 + e];
#pragma unroll
          for (int w = 0; w < 32; ++w) { base += (part * 32 + w < rb) ? cv[w] : 0; tot += cv[w]; }
          parts[part * 64 + e] = base; parts[512 + part * 64 + e] = tot; }
        __syncthreads();
        if (tid < 64) { int base = 0, tot = 0;
#pragma unroll
            for (int p = 0; p < 8; ++p) { base += parts[p * 64 + tid]; tot += parts[512 + p * 64 + tid]; }
            basel[tid] = base; totl[tid] = tot; }
        __syncthreads();
        if (first && tid == 0) { int nb = 0;
            for (int e = 0; e < 64; ++e) { const int k = (totl[e] + 255) >> 8; blk0[e] = nb;
                for (int i = 0; i < k && nb + i < 192; ++i) blk_e[nb + i] = (unsigned char)e; nb += k; }
            blk0[64] = nb; MISCW(C)[5] = (unsigned)(nb > 192 ? 192 : nb);
            LAS int* m1 = (LAS int*)(C.lds + MISC_OFF + 2048); LAS int* m2 = m1 + 64;
            const int x8 = C.bid & 7, y = C.bid >> 3, ny = (C.G + 7 - x8) >> 3;
            int r1 = 0, r2 = 0, c1 = 0, c2 = 0;
            for (int e = x8; e < 64; e += 8) for (int pb = blk0[e]; pb < blk0[e + 1] && pb < 192; ++pb) {
                for (int jj = 0; jj < 2; ++jj) { if (r1 == y && c1 < 12) m1[1 + c1++] = (pb << 8) | (2 * e + jj); if (++r1 == ny) r1 = 0; }
                for (int jj = 0; jj < 4; ++jj) { if (r2 == y && c2 < 62) m2[1 + c2++] = (pb << 8) | (4 * e + jj); if (++r2 == ny) r2 = 0; } }
            m1[0] = c1; m2[0] = c2; }
        __syncthreads();
        if (first && C.bid < 64 && tid < 256) { const int e = C.bid; const int r = blk0[e] * 256 + totl[e] + tid; if (r < blk0[e + 1] * 256 && r < MAXROWS) ROWTOK[r] = 0; }
        first = false;
        if (rb < T / 64) {
            if (lane < 16) { const int it = rb * 128 + wave * 16 + lane; const int e = r_e[it]; const int row = blk0[e] * 256 + basel[e] + r_s[it];
                pos[it] = row; ROWTOK[row] = it >> 1; }
        }
    }
}

typedef short ch_bf16x8 __attribute__((ext_vector_type(8)));
typedef short ch_s16x4 __attribute__((ext_vector_type(4)));
constexpr int IMG_P = 144;
__device__ __forceinline__ int kperm(int k) { const int kt = k >> 4; return 32 * (kt >> 1) + 8 * ((k >> 2) & 3) + 4 * (kt & 1) + (k & 3); }
__device__ __forceinline__ ch_bf16x8 tr_pair(const LAS unsigned char* a0, const LAS unsigned char* a1) {
    const ch_s16x4 lo = __builtin_bit_cast(ch_s16x4, __builtin_amdgcn_ds_read_tr16_b64_v4i16((LAS ch_s16x4*)a0));
    const ch_s16x4 hi = __builtin_bit_cast(ch_s16x4, __builtin_amdgcn_ds_read_tr16_b64_v4i16((LAS ch_s16x4*)a1));
    return (ch_bf16x8){lo[0], lo[1], lo[2], lo[3], hi[0], hi[1], hi[2], hi[3]};
}
__device__ __forceinline__ ch_bf16x8 pack8(const pg8::f32x4& a, const pg8::f32x4& b) { u32x4 w; w.x = pk2(a[0], a[1]); w.y = pk2(a[2], a[3]); w.z = pk2(b[0], b[1]); w.w = pk2(b[2], b[3]); return __builtin_bit_cast(ch_bf16x8, w); }

struct SsdPre { u32x4 raw[11]; float d0, d1, w[2], alog, dtb, dsk; };
__device__ __forceinline__ int ssd_ch0(int cg, int head) { const int grp = head >> 2; return (cg < 8) ? head * 64 + 8 * cg : (cg < 16 ? 512 + grp * 64 + 8 * (cg - 8) : 640 + grp * 64 + 8 * (cg - 16)); }
__device__ __forceinline__ void ssd_pre_load(const Ctx& C, int l, int unit, SsdPre& p) {
    PH_IDS();
    const int c = unit & 31, head = (unit >> 5) & 7, b = unit >> 8;
    const size_t row0 = (size_t)b * SEQ + (size_t)c * 128;
    const bf16_t* P = (const bf16_t*)(C.ws + WS_P);
    if (tid < 384) { const int cg = tid % 24, rb = tid / 24; const int ch0 = ssd_ch0(cg, head);
#pragma unroll
        for (int j = 0; j < 11; ++j) { const int t = c * 128 + 8 * rb - 3 + j;
            p.raw[j] = (t >= 0) ? *(const u32x4*)(P + ((size_t)b * SEQ + t) * PLD + C_X + ch0) : (u32x4){0u, 0u, 0u, 0u}; } }
    p.d0 = 0.f; p.d1 = 0.f;
    if (wave < 2) { const float* dtraw = (const float*)(C.ws + WS_DT); p.d0 = dtraw[(row0 + lane) * 8 + head]; p.d1 = dtraw[(row0 + 64 + lane) * 8 + head]; }
    { const float* cw = INP(I_CONVW) + (size_t)l * 4 * 768; const float* cb = INP(I_CONVB) + l * 768;
#pragma unroll
      for (int i = 0; i < 2; ++i) { const int idx = tid + 512 * i; p.w[i] = 0.f;
          if (idx < 960) { const int cgx = idx / 40, r = idx % 40, j = r >> 3, e = r & 7; const int chx = ssd_ch0(cgx, head) + e; p.w[i] = (j < 4) ? cw[j * 768 + chx] : cb[chx]; } } }
    p.alog = INP(I_ALOG)[l * 8 + head]; p.dtb = INP(I_DTB)[l * 8 + head]; p.dsk = INP(I_SSDD)[l * 8 + head];
    asm volatile("" ::: "memory");
}
__device__ __forceinline__ void ssd_pass1(const Ctx& C, int l, int unit, SsdPre& pre, int next_unit) {
    PH_IDS();
    const int c = unit & 31, head = (unit >> 5) & 7, b = unit >> 8;
    const size_t row0 = (size_t)b * SEQ + (size_t)c * 128;
    LAS unsigned char* XD = C.lds; LAS unsigned char* BW = XD + 128 * IMG_P; LAS unsigned char* BB = BW + 128 * IMG_P; LAS unsigned char* CC = BB + 128 * IMG_P;
    LAS float* acs = (LAS float*)(CC + 128 * IMG_P); LAS float* dtv = acs + 128; LAS float* WT = dtv + 128;
    const float a_h = -__expf(pre.alog);
    const float dsk = pre.dsk;
    if (wave < 2) {
        const float dtb = pre.dtb;
        const float d0 = softplusf_(pre.d0 + dtb);
        float dmine = d0, pre_s = 0.f;
        if (wave == 1) { dmine = softplusf_(pre.d1 + dtb); pre_s = wave_sum(d0 * a_h); }
        float sc = dmine * a_h;
#pragma unroll
        for (int o = 1; o < 64; o <<= 1) { const float t = __int_as_float(__builtin_amdgcn_ds_bpermute((lane - o) << 2, __float_as_int(sc))); if (lane >= o) sc += t; }
        acs[wave * 64 + lane] = sc + pre_s; dtv[wave * 64 + lane] = dmine;
    }
#pragma unroll
    for (int i = 0; i < 2; ++i) { const int idx = tid + 512 * i; if (idx < 960) WT[idx] = pre.w[i]; }
    const int cg = tid % 24, rb = tid / 24;
    __syncthreads();
    if (tid < 384) {
        float wj[4][8], bs[8];
        { const LAS f32x4* wt = (const LAS f32x4*)(WT + cg * 40);
#pragma unroll
          for (int j = 0; j < 4; ++j) { const f32x4 a = wt[2 * j], bq = wt[2 * j + 1]; wj[j][0] = a.x; wj[j][1] = a.y; wj[j][2] = a.z; wj[j][3] = a.w; wj[j][4] = bq.x; wj[j][5] = bq.y; wj[j][6] = bq.z; wj[j][7] = bq.w; }
          const f32x4 a = wt[8], bq = wt[9]; bs[0] = a.x; bs[1] = a.y; bs[2] = a.z; bs[3] = a.w; bs[4] = bq.x; bs[5] = bq.y; bs[6] = bq.z; bs[7] = bq.w; }
        const float acl = acs[127];
        bf16_t* CT = (bf16_t*)(C.ws + WS_CT);
#pragma unroll
        for (int r = 0; r < 8; ++r) {
            const int lr = 8 * rb + r;
            float v[8];
#pragma unroll
            for (int e = 0; e < 8; ++e) v[e] = bs[e];
#pragma unroll
            for (int j = 0; j < 4; ++j) { const u32x4 q = pre.raw[r + j];
                v[0] += wj[j][0] * lo2f(q.x); v[1] += wj[j][1] * hi2f(q.x); v[2] += wj[j][2] * lo2f(q.y); v[3] += wj[j][3] * hi2f(q.y);
                v[4] += wj[j][4] * lo2f(q.z); v[5] += wj[j][5] * hi2f(q.z); v[6] += wj[j][6] * lo2f(q.w); v[7] += wj[j][7] * hi2f(q.w); }
#pragma unroll
            for (int e = 0; e < 8; ++e) v[e] = siluf_(v[e]);
            if (cg < 8) { const float d = dtv[lr];
                u32x4 w; w.x = pk2(v[0] * d, v[1] * d); w.y = pk2(v[2] * d, v[3] * d); w.z = pk2(v[4] * d, v[5] * d); w.w = pk2(v[6] * d, v[7] * d);
                *(LAS u32x4*)(XD + lr * IMG_P + 16 * cg) = w;
            } else if (cg < 16) { const float wd = __expf(acl - acs[lr]);
                u32x4 w; w.x = pk2(v[0], v[1]); w.y = pk2(v[2], v[3]); w.z = pk2(v[4], v[5]); w.w = pk2(v[6], v[7]);
                *(LAS u32x4*)(BB + lr * IMG_P + 16 * (cg - 8)) = w;
                w.x = pk2(v[0] * wd, v[1] * wd); w.y = pk2(v[2] * wd, v[3] * wd); w.z = pk2(v[4] * wd, v[5] * wd); w.w = pk2(v[6] * wd, v[7] * wd);
                *(LAS u32x4*)(BW + lr * IMG_P + 16 * (cg - 8)) = w;
            } else { const float ea = __expf(acs[lr]); const int n0 = 8 * (cg - 16);
                u32x4 w; w.x = pk2(v[0], v[1]); w.y = pk2(v[2], v[3]); w.z = pk2(v[4], v[5]); w.w = pk2(v[6], v[7]);
                *(LAS u32x4*)(CC + lr * IMG_P + 16 * (cg - 16)) = w;
                bf16_t* cp = CT + (row0 + lr) * 512 + head * 64;
                u32x2 wa; wa.x = pk2(v[0] * ea, v[1] * ea); wa.y = pk2(v[2] * ea, v[3] * ea); *(u32x2*)(cp + kperm(n0)) = wa;
                u32x2 wb; wb.x = pk2(v[4] * ea, v[5] * ea); wb.y = pk2(v[6] * ea, v[7] * ea); *(u32x2*)(cp + kperm(n0 + 4)) = wb;
            }
        }
    }
    __syncthreads();
    if (next_unit >= 0) ssd_pre_load(C, l, next_unit, pre);
    const int n16 = lane & 15, kq = lane >> 4, q4 = n16 >> 2, p4 = lane & 3;
    ch_bf16x8 cf[2];
#pragma unroll
    for (int ks = 0; ks < 2; ++ks) cf[ks] = *(const LAS ch_bf16x8*)(CC + (16 * wave + n16) * IMG_P + 64 * ks + 16 * kq);
    const float acl_l = acs[16 * wave + n16];
    const float dskd = dsk / dtv[16 * wave + n16];
    ch_bf16x8 pa[4];
#pragma unroll
    for (int kp = 0; kp < 4; ++kp) {
        pg8::f32x4 g2[2];
#pragma unroll
        for (int h2 = 0; h2 < 2; ++h2) {
            const int ts = 2 * kp + h2;
            pg8::f32x4 a = {0.f, 0.f, 0.f, 0.f};
            if (ts <= wave) {
#pragma unroll
                for (int ks = 0; ks < 2; ++ks) { const ch_bf16x8 bf = *(const LAS ch_bf16x8*)(BB + (16 * ts + n16) * IMG_P + 64 * ks + 16 * kq); a = __builtin_amdgcn_mfma_f32_16x16x32_bf16(bf, cf[ks], a, 0, 0, 0); }
                const f32x4 as4 = *(const LAS f32x4*)(acs + 16 * ts + 4 * kq);
                const int ll = 16 * wave + n16, s0 = 16 * ts + 4 * kq;
                a[0] = (s0 + 0 <= ll) ? a[0] * __expf(acl_l - as4.x) : 0.f; a[1] = (s0 + 1 <= ll) ? a[1] * __expf(acl_l - as4.y) : 0.f;
                a[2] = (s0 + 2 <= ll) ? a[2] * __expf(acl_l - as4.z) : 0.f; a[3] = (s0 + 3 <= ll) ? a[3] * __expf(acl_l - as4.w) : 0.f;
                if (s0 + 0 == ll) a[0] += dskd; if (s0 + 1 == ll) a[1] += dskd; if (s0 + 2 == ll) a[2] += dskd; if (s0 + 3 == ll) a[3] += dskd;
            }
            g2[h2] = a;
        }
        pa[kp] = pack8(g2[0], g2[1]);
    }
    pg8::f32x4 o[4];
#pragma unroll
    for (int pt = 0; pt < 4; ++pt) o[pt] = (pg8::f32x4){0.f, 0.f, 0.f, 0.f};
#pragma unroll
    for (int kp = 0; kp < 4; ++kp) if (2 * kp <= wave) {
        const LAS unsigned char* xb = XD + (32 * kp + 4 * kq + q4) * IMG_P + 8 * p4;
#pragma unroll
        for (int pt = 0; pt < 4; ++pt) o[pt] = __builtin_amdgcn_mfma_f32_16x16x32_bf16(tr_pair(xb + 32 * pt, xb + 16 * IMG_P + 32 * pt), pa[kp], o[pt], 0, 0, 0);
    }
    { bf16_t* yb = (bf16_t*)(C.ws + WS_BR) + (row0 + 16 * wave + n16) * 512 + head * 64 + 4 * kq;
#pragma unroll
      for (int pt = 0; pt < 4; ++pt) { u32x2 w; w.x = pk2(o[pt][0], o[pt][1]); w.y = pk2(o[pt][2], o[pt][3]); *(u32x2*)(yb + 16 * pt) = w; } }
    { f32x4* HL = (f32x4*)(C.ws + WS_HL) + (size_t)unit * 16 * 64;
#pragma unroll
      for (int h2 = 0; h2 < 2; ++h2) { const int id = 2 * wave + h2, nt = id >> 2, pt = id & 3;
          pg8::f32x4 a = {0.f, 0.f, 0.f, 0.f};
#pragma unroll
          for (int ks = 0; ks < 4; ++ks) { const int rowa = 32 * ks + 8 * kq + q4;
              const ch_bf16x8 af = tr_pair(BW + rowa * IMG_P + 32 * nt + 8 * p4, BW + (rowa + 4) * IMG_P + 32 * nt + 8 * p4);
              const ch_bf16x8 bf = tr_pair(XD + rowa * IMG_P + 32 * pt + 8 * p4, XD + (rowa + 4) * IMG_P + 32 * pt + 8 * p4);
              a = __builtin_amdgcn_mfma_f32_16x16x32_bf16(af, bf, a, 0, 0, 0); }
          HL[id * 64 + lane] = (f32x4){a[0], a[1], a[2], a[3]}; } }
    if (tid == 0) ((float*)(C.ws + WS_DEC))[unit] = __expf(acs[127]);
    __syncthreads();
}
struct Ssd2Ops { f32x4 hl[4]; float dec; ch_bf16x8 cf[2][2]; u32x2 yv[2]; };
__device__ __forceinline__ void ssd2_load(Ssd2Ops& o, const bf16_t* CT, const f32x4* HL, const float* DEC, const bf16_t* Y, int chain, int c, int wv, int lq, int head, int b, int lane) {
    const int n16 = lane & 15, kq = lane >> 4;
    const int unit = chain * 32 + c; const size_t row0 = (size_t)b * SEQ + (size_t)c * 128 + 32 * lq;
#pragma unroll
    for (int nt = 0; nt < 4; ++nt) o.hl[nt] = HL[((size_t)unit * 16 + nt * 4 + wv) * 64 + lane];
    o.dec = DEC[unit];
#pragma unroll
    for (int lt = 0; lt < 2; ++lt) { const bf16_t* cp = CT + (row0 + 16 * lt + n16) * 512 + head * 64 + 8 * kq; o.cf[lt][0] = *(const ch_bf16x8*)cp; o.cf[lt][1] = *(const ch_bf16x8*)(cp + 32);
        o.yv[lt] = *(const u32x2*)(Y + (row0 + 16 * lt + n16) * 512 + head * 64 + 16 * wv + 4 * kq); }
}
__device__ __forceinline__ void ssd_pass2(const Ctx& C, int chain, int wv, int lq) {
    PH_IDS();
    const int n16 = lane & 15, kq = lane >> 4;
    const int head = chain & 7, b = chain >> 3;
    const bf16_t* CT = (const bf16_t*)(C.ws + WS_CT); const f32x4* HL = (const f32x4*)(C.ws + WS_HL); const float* DEC = (const float*)(C.ws + WS_DEC);
    bf16_t* Y = (bf16_t*)(C.ws + WS_BR);
    pg8::f32x4 H[4];
#pragma unroll
    for (int nt = 0; nt < 4; ++nt) H[nt] = (pg8::f32x4){0.f, 0.f, 0.f, 0.f};
    Ssd2Ops cur, nx1; ssd2_load(cur, CT, HL, DEC, Y, chain, 0, wv, lq, head, b, lane); ssd2_load(nx1, CT, HL, DEC, Y, chain, 1, wv, lq, head, b, lane);
    for (int c = 0; c < 32; ++c) {
        Ssd2Ops nxt; ssd2_load(nxt, CT, HL, DEC, Y, chain, c + 2 < 32 ? c + 2 : 31, wv, lq, head, b, lane);
        if (c > 0) {
            const ch_bf16x8 hb0 = pack8(H[0], H[1]), hb1 = pack8(H[2], H[3]);
            const size_t row0 = (size_t)b * SEQ + (size_t)c * 128 + 32 * lq;
#pragma unroll
            for (int lt = 0; lt < 2; ++lt) {
                pg8::f32x4 a = {0.f, 0.f, 0.f, 0.f};
                a = __builtin_amdgcn_mfma_f32_16x16x32_bf16(hb0, cur.cf[lt][0], a, 0, 0, 0);
                a = __builtin_amdgcn_mfma_f32_16x16x32_bf16(hb1, cur.cf[lt][1], a, 0, 0, 0);
                u32x2 w; w.x = pk2(lo2f(cur.yv[lt].x) + a[0], hi2f(cur.yv[lt].x) + a[1]); w.y = pk2(lo2f(cur.yv[lt].y) + a[2], hi2f(cur.yv[lt].y) + a[3]);
                *(u32x2*)(Y + (row0 + 16 * lt + n16) * 512 + head * 64 + 16 * wv + 4 * kq) = w;
            }
        }
#pragma unroll
        for (int nt = 0; nt < 4; ++nt) { H[nt][0] = cur.dec * H[nt][0] + cur.hl[nt].x; H[nt][1] = cur.dec * H[nt][1] + cur.hl[nt].y; H[nt][2] = cur.dec * H[nt][2] + cur.hl[nt].z; H[nt][3] = cur.dec * H[nt][3] + cur.hl[nt].w; }
        cur = nx1; nx1 = nxt;
    }
}
struct HgPre { u32x4 rq[2], rf[2], rv[2]; float lbd; };
__device__ __forceinline__ void hg_pre_load(const Ctx& C, int l, int unit, HgPre& p) {
    PH_IDS();
    const int blk = unit & 31, head = (unit >> 5) & 7, b = unit >> 8;
    const size_t row0 = (size_t)b * SEQ + (size_t)blk * 128;
    const bf16_t* P = (const bf16_t*)(C.ws + WS_P);
#pragma unroll
    for (int h2 = 0; h2 < 2; ++h2) { const int r = (tid >> 3) + 64 * h2, ch = tid & 7; const bf16_t* pr = P + (row0 + r) * PLD + head * 64 + ch * 8;
        p.rq[h2] = *(const u32x4*)(pr + C_QD); p.rf[h2] = *(const u32x4*)(pr + C_FD); p.rv[h2] = *(const u32x4*)(pr + C_ID); }
    p.lbd = 0.f; if (l > 0) p.lbd = INP(I_LBL)[512 + head * 64 + lane] - INP(I_LBL)[head * 64 + lane];
    asm volatile("" ::: "memory");
}
__device__ __forceinline__ void hgrn_pass1(const Ctx& C, int l, int unit, HgPre& pre, int next_unit) {
    PH_IDS();
    const int blk = unit & 31, head = (unit >> 5) & 7, b = unit >> 8;
    const size_t row0 = (size_t)b * SEQ + (size_t)blk * 128;
    LAS unsigned char* QT = C.lds; LAS unsigned char* KT = QT + 128 * IMG_P; LAS unsigned char* VV = KT + 128 * IMG_P;
#pragma unroll
    for (int h2 = 0; h2 < 2; ++h2) { const int r = (tid >> 3) + 64 * h2, ch = tid & 7;
        *(LAS u32x4*)(QT + r * IMG_P + 16 * ch) = pre.rq[h2]; *(LAS u32x4*)(KT + r * IMG_P + 16 * ch) = pre.rf[h2]; *(LAS u32x4*)(VV + r * IMG_P + 16 * ch) = pre.rv[h2]; }
    const float lbd = pre.lbd;
    __syncthreads();
    if (next_unit >= 0) hg_pre_load(C, l, next_unit, pre);
    const int c4 = wave & 3, hh = wave >> 2;
    const size_t cgi = ((size_t)(b * 8 + head) * 128 + blk * 4 + c4);
    LAS float* XP = (LAS float*)(VV + 128 * IMG_P);
    { const int k = lane;
      float lb = 0.f; if (l > 0) lb = sigmoidf_(lbd);
      float fv[16], qv[16], Pl = 1.0f;
#pragma unroll
      for (int t = 0; t < 16; ++t) { const int tt = 32 * c4 + 16 * hh + t;
          const float f = lb + (1.0f - lb) * sigmoidf_(bf2f(*(const LAS bf16_t*)(KT + tt * IMG_P + 2 * k))); const float q = siluf_(bf2f(*(const LAS bf16_t*)(QT + tt * IMG_P + 2 * k)));
          fv[t] = f; qv[t] = q; Pl *= f; }
      XP[(hh * 4 + c4) * 64 + k] = Pl;
      __syncthreads();
      const float P0 = XP[c4 * 64 + k], P1 = XP[(4 + c4) * 64 + k], eg = P0 * P1;
      float Pr = hh ? P0 : 1.0f; float kt[16];
#pragma unroll
      for (int t = 0; t < 16; ++t) { const int tt = 32 * c4 + 16 * hh + t;
          Pr *= fv[t];
          const float qt = qv[t] * Pr, ktv = (1.0f - fv[t]) * __builtin_amdgcn_rcpf(fmaxf(Pr, 1.8e-35f));
          kt[t] = ktv;
          *(LAS bf16_t*)(QT + tt * IMG_P + 2 * k) = (bf16_t)f2bf(qt); *(LAS bf16_t*)(KT + tt * IMG_P + 2 * k) = (bf16_t)f2bf(ktv); }
      if (hh == 0) ((float*)(C.ws + WS_DG))[cgi * 64 + k] = eg;
      u32x4* kh = (u32x4*)((bf16_t*)(C.ws + WS_KHT) + (cgi * 64 + k) * 32);
#pragma unroll
      for (int q = 0; q < 2; ++q) { u32x4 w; w.x = pk2(kt[8 * q] * eg, kt[8 * q + 1] * eg); w.y = pk2(kt[8 * q + 2] * eg, kt[8 * q + 3] * eg); w.z = pk2(kt[8 * q + 4] * eg, kt[8 * q + 5] * eg); w.w = pk2(kt[8 * q + 6] * eg, kt[8 * q + 7] * eg); kh[2 * hh + q] = w; }
      const int v = lane;
      unsigned short vv[16];
#pragma unroll
      for (int t = 0; t < 16; ++t) vv[t] = *(const LAS bf16_t*)(VV + (32 * c4 + 16 * hh + t) * IMG_P + 2 * v);
      u32x4* vt = (u32x4*)((bf16_t*)(C.ws + WS_VT) + (cgi * 64 + v) * 32);
#pragma unroll
      for (int q = 0; q < 2; ++q) { u32x4 w; w.x = vv[8 * q] | ((unsigned)vv[8 * q + 1] << 16); w.y = vv[8 * q + 2] | ((unsigned)vv[8 * q + 3] << 16); w.z = vv[8 * q + 4] | ((unsigned)vv[8 * q + 5] << 16); w.w = vv[8 * q + 6] | ((unsigned)vv[8 * q + 7] << 16); vt[2 * hh + q] = w; }
    }
    __syncthreads();
    { bf16_t* QG = (bf16_t*)(C.ws + WS_QG);
#pragma unroll
      for (int i = 0; i < 4; ++i) { const int idx = tid + 512 * i, r = idx >> 4, g4 = idx & 15;
          const u32x2 w = *(const LAS u32x2*)(QT + r * IMG_P + 8 * g4);
          *(u32x2*)(QG + (row0 + r) * 512 + head * 64 + kperm(4 * g4)) = w; } }
    { const int n16 = lane & 15, kq = lane >> 4, q4 = n16 >> 2, p4 = lane & 3;
      const int cw = wave >> 1, it = wave & 1;
      ch_bf16x8 qf[2];
#pragma unroll
      for (int ks = 0; ks < 2; ++ks) qf[ks] = *(const LAS ch_bf16x8*)(QT + (32 * cw + 16 * it + n16) * IMG_P + 64 * ks + 16 * kq);
      pg8::f32x4 at[2];
#pragma unroll
      for (int jt = 0; jt < 2; ++jt) { pg8::f32x4 a = {0.f, 0.f, 0.f, 0.f};
          if (jt <= it) {
#pragma unroll
              for (int ks = 0; ks < 2; ++ks) { const ch_bf16x8 kf = *(const LAS ch_bf16x8*)(KT + (32 * cw + 16 * jt + n16) * IMG_P + 64 * ks + 16 * kq); a = __builtin_amdgcn_mfma_f32_16x16x32_bf16(kf, qf[ks], a, 0, 0, 0); }
              const int ii = 16 * it + n16, j0 = 16 * jt + 4 * kq;
              a[0] = (j0 + 0 <= ii) ? a[0] : 0.f; a[1] = (j0 + 1 <= ii) ? a[1] : 0.f; a[2] = (j0 + 2 <= ii) ? a[2] : 0.f; a[3] = (j0 + 3 <= ii) ? a[3] : 0.f; }
          at[jt] = a; }
      const ch_bf16x8 pa = pack8(at[0], at[1]);
      const LAS unsigned char* vb = VV + (32 * cw + 4 * kq + q4) * IMG_P + 8 * p4;
      bf16_t* ob = (bf16_t*)(C.ws + WS_BR) + (size_t)3 * T * 512 + (row0 + 32 * cw + 16 * it + n16) * 512 + head * 64 + 4 * kq;
#pragma unroll
      for (int vt = 0; vt < 4; ++vt) { pg8::f32x4 o = {0.f, 0.f, 0.f, 0.f};
          o = __builtin_amdgcn_mfma_f32_16x16x32_bf16(tr_pair(vb + 32 * vt, vb + 16 * IMG_P + 32 * vt), pa, o, 0, 0, 0);
          u32x2 w; w.x = pk2(o[0], o[1]); w.y = pk2(o[2], o[3]); *(u32x2*)(ob + 16 * vt) = w; } }
    __syncthreads();
}
struct Hg2A { ch_bf16x8 vtf; ch_bf16x8 khf[4]; f32x4 dd[4]; };
__device__ __forceinline__ void hg2a_load(Hg2A& o, const bf16_t* KHT, const bf16_t* VT, const float* DG, size_t cgi, int wv, int lane) {
    const int n16 = lane & 15, kq = lane >> 4;
    o.vtf = *(const ch_bf16x8*)(VT + (cgi * 64 + 16 * wv + n16) * 32 + 8 * kq);
#pragma unroll
    for (int kt = 0; kt < 4; ++kt) { o.khf[kt] = *(const ch_bf16x8*)(KHT + (cgi * 64 + 16 * kt + n16) * 32 + 8 * kq); o.dd[kt] = *(const f32x4*)(DG + cgi * 64 + 16 * kt + 4 * kq); }
}
struct Hg2B { ch_bf16x8 qf[2][2]; u32x2 ov[2]; };
__device__ __forceinline__ void hg2b_load(Hg2B& o, const bf16_t* QG, const bf16_t* O, size_t crow, int wv, int head, int lane) {
    const int n16 = lane & 15, kq = lane >> 4;
#pragma unroll
    for (int it = 0; it < 2; ++it) { const bf16_t* qp = QG + (crow + 16 * it + n16) * 512 + head * 64 + 8 * kq; o.qf[it][0] = *(const ch_bf16x8*)qp; o.qf[it][1] = *(const ch_bf16x8*)(qp + 32);
        o.ov[it] = *(const u32x2*)(O + (crow + 16 * it + n16) * 512 + head * 64 + 16 * wv + 4 * kq); }
}
__device__ __forceinline__ void hgrn_pass2(const Ctx& C, int chain, int wv) {
    PH_IDS();
    const int n16 = lane & 15, kq = lane >> 4;
    const int head = chain & 7, b = chain >> 3, grp = wave;
    const bf16_t* QG = (const bf16_t*)(C.ws + WS_QG); const bf16_t* KHT = (const bf16_t*)(C.ws + WS_KHT); const bf16_t* VT = (const bf16_t*)(C.ws + WS_VT); const float* DG = (const float*)(C.ws + WS_DG);
    bf16_t* O = (bf16_t*)(C.ws + WS_BR) + (size_t)3 * T * 512;
    LAS f32x4* X = (LAS f32x4*)C.lds;
    pg8::f32x4 S[4], Dp[4];
#pragma unroll
    for (int kt = 0; kt < 4; ++kt) { S[kt] = (pg8::f32x4){0.f, 0.f, 0.f, 0.f}; Dp[kt] = (pg8::f32x4){1.f, 1.f, 1.f, 1.f}; }
    const size_t cg0 = (size_t)chain * 128 + 16 * grp;
    { Hg2A cur, nx1; hg2a_load(cur, KHT, VT, DG, cg0, wv, lane); hg2a_load(nx1, KHT, VT, DG, cg0 + 1, wv, lane);
      for (int c = 0; c < 16; ++c) {
          Hg2A nxt; hg2a_load(nxt, KHT, VT, DG, cg0 + (c + 2 < 16 ? c + 2 : 15), wv, lane);
#pragma unroll
          for (int kt = 0; kt < 4; ++kt) { pg8::f32x4 sl = {0.f, 0.f, 0.f, 0.f};
              sl = __builtin_amdgcn_mfma_f32_16x16x32_bf16(cur.khf[kt], cur.vtf, sl, 0, 0, 0);
              S[kt][0] = cur.dd[kt].x * S[kt][0] + sl[0]; S[kt][1] = cur.dd[kt].y * S[kt][1] + sl[1]; S[kt][2] = cur.dd[kt].z * S[kt][2] + sl[2]; S[kt][3] = cur.dd[kt].w * S[kt][3] + sl[3];
              Dp[kt][0] *= cur.dd[kt].x; Dp[kt][1] *= cur.dd[kt].y; Dp[kt][2] *= cur.dd[kt].z; Dp[kt][3] *= cur.dd[kt].w; }
          cur = nx1; nx1 = nxt;
      } }
#pragma unroll
    for (int kt = 0; kt < 4; ++kt) { X[(grp * 8 + kt) * 64 + lane] = (f32x4){Dp[kt][0], Dp[kt][1], Dp[kt][2], Dp[kt][3]}; X[(grp * 8 + 4 + kt) * 64 + lane] = (f32x4){S[kt][0], S[kt][1], S[kt][2], S[kt][3]}; }
    __syncthreads();
#pragma unroll
    for (int kt = 0; kt < 4; ++kt) S[kt] = (pg8::f32x4){0.f, 0.f, 0.f, 0.f};
    for (int g = 0; g < grp; ++g) {
#pragma unroll
        for (int kt = 0; kt < 4; ++kt) { const f32x4 d = X[(g * 8 + kt) * 64 + lane], lq = X[(g * 8 + 4 + kt) * 64 + lane];
            S[kt][0] = d.x * S[kt][0] + lq.x; S[kt][1] = d.y * S[kt][1] + lq.y; S[kt][2] = d.z * S[kt][2] + lq.z; S[kt][3] = d.w * S[kt][3] + lq.w; }
    }
    { Hg2A cur, na1; hg2a_load(cur, KHT, VT, DG, cg0, wv, lane); hg2a_load(na1, KHT, VT, DG, cg0 + 1, wv, lane);
      Hg2B cub, nb1; hg2b_load(cub, QG, O, (size_t)b * SEQ + (size_t)(16 * grp) * 32, wv, head, lane); hg2b_load(nb1, QG, O, (size_t)b * SEQ + (size_t)(16 * grp + 1) * 32, wv, head, lane);
      for (int c = 0; c < 16; ++c) {
          const int cn = (c + 2 < 16 ? c + 2 : 15);
          Hg2A nxt; hg2a_load(nxt, KHT, VT, DG, cg0 + cn, wv, lane);
          Hg2B nxb; hg2b_load(nxb, QG, O, (size_t)b * SEQ + (size_t)(16 * grp + cn) * 32, wv, head, lane);
          if (grp > 0 || c > 0) {
              const ch_bf16x8 sb0 = pack8(S[0], S[1]), sb1 = pack8(S[2], S[3]);
              const size_t crow = (size_t)b * SEQ + (size_t)(16 * grp + c) * 32;
#pragma unroll
              for (int it = 0; it < 2; ++it) {
                  pg8::f32x4 a = {0.f, 0.f, 0.f, 0.f};
                  a = __builtin_amdgcn_mfma_f32_16x16x32_bf16(sb0, cub.qf[it][0], a, 0, 0, 0);
                  a = __builtin_amdgcn_mfma_f32_16x16x32_bf16(sb1, cub.qf[it][1], a, 0, 0, 0);
                  u32x2 w; w.x = pk2(lo2f(cub.ov[it].x) + a[0], hi2f(cub.ov[it].x) + a[1]); w.y = pk2(lo2f(cub.ov[it].y) + a[2], hi2f(cub.ov[it].y) + a[3]);
                  *(u32x2*)(O + (crow + 16 * it + n16) * 512 + head * 64 + 16 * wv + 4 * kq) = w;
              }
          }
#pragma unroll
          for (int kt = 0; kt < 4; ++kt) { pg8::f32x4 sl = {0.f, 0.f, 0.f, 0.f};
              sl = __builtin_amdgcn_mfma_f32_16x16x32_bf16(cur.khf[kt], cur.vtf, sl, 0, 0, 0);
              S[kt][0] = cur.dd[kt].x * S[kt][0] + sl[0]; S[kt][1] = cur.dd[kt].y * S[kt][1] + sl[1]; S[kt][2] = cur.dd[kt].z * S[kt][2] + sl[2]; S[kt][3] = cur.dd[kt].w * S[kt][3] + sl[3]; }
          cur = na1; na1 = nxt; cub = nb1; nb1 = nxb;
      } }
}

#ifndef PROBE_MASK
#define PROBE_MASK 0
#endif
#ifndef PROBE_AMP
#define PROBE_AMP 1
#endif
#ifndef PROBE_BLOCK
#define PROBE_BLOCK 0
#endif
#if PROBE_MASK
#define PROBE_INIT() do { if (C.bid == PROBE_BLOCK && threadIdx.x == 0) { const unsigned long long t0_ = __builtin_amdgcn_s_memrealtime(); MISCW(C)[10] = (unsigned)t0_; MISCW(C)[11] = (unsigned)(t0_ >> 32); MISCW(C)[12] = 0u; MISCW(C)[13] = 0u; } } while (0)
#define PROBE_MARK(k) do { if (C.bid == PROBE_BLOCK && threadIdx.x == 0) { const unsigned long long n_ = __builtin_amdgcn_s_memrealtime(); const unsigned long long p_ = ((unsigned long long)MISCW(C)[11] << 32) | MISCW(C)[10]; \
    if ((PROBE_MASK >> (k)) & 1) { unsigned long long a_ = ((unsigned long long)MISCW(C)[13] << 32) | MISCW(C)[12]; a_ += n_ - p_; MISCW(C)[12] = (unsigned)a_; MISCW(C)[13] = (unsigned)(a_ >> 32); } \
    MISCW(C)[10] = (unsigned)n_; MISCW(C)[11] = (unsigned)(n_ >> 32); } } while (0)
#define PROBE_FINISH() do { if (C.bid == PROBE_BLOCK && threadIdx.x == 0) { const unsigned long long a_ = (((unsigned long long)MISCW(C)[13] << 32) | MISCW(C)[12]) * PROBE_AMP; const unsigned long long s_ = __builtin_amdgcn_s_memrealtime(); \
    while (__builtin_amdgcn_s_memrealtime() - s_ < a_) __builtin_amdgcn_s_sleep(16); } } while (0)
#else
#define PROBE_INIT() do {} while (0)
#define PROBE_MARK(k) do {} while (0)
#define PROBE_FINISH() do {} while (0)
#endif
typedef short dl_bf16x8 __attribute__((ext_vector_type(8)));
typedef short dl_s16x4 __attribute__((ext_vector_type(4)));
__device__ __forceinline__ void dilated_unit(const Ctx& C, int u, unsigned* wq) {
    PH_IDS();
    unsigned nextv = 0u; if (tid == 0) nextv = atomicAdd(wq, 1u);
    constexpr int VP = 288;
    const int g = 2 - (u >> 8), v = u & 255;
    int b, r, j, qblk, dil;
    if (g == 0) { dil = 1; b = v >> 6; r = 0; j = (v >> 4) & 3; qblk = v & 15; }
    else if (g == 1) { dil = 4; b = v >> 6; r = (v >> 4) & 3; j = (v >> 2) & 3; qblk = v & 3; }
    else { dil = 16; b = v >> 6; r = (v >> 2) & 15; j = v & 3; qblk = 0; }
    const int hh = g * 4 + j;
    const size_t rstride = (size_t)dil * PLD;
    const bf16_t* base = (const bf16_t*)(C.ws + WS_P) + ((size_t)b * SEQ + r) * PLD;
    const int qs = qblk * 256, ks0 = qs - 128;
    LAS unsigned char* Vs = C.lds;
    const int n16 = lane & 15, kq = lane >> 4;
    const int q0 = qs + 32 * wave;
    dl_bf16x8 qf[2][4];
#pragma unroll
    for (int qt = 0; qt < 2; ++qt) { const bf16_t* qp = base + (size_t)(q0 + 16 * qt + n16) * rstride + C_QB + hh * 128 + kq * 8;
#pragma unroll
        for (int s4 = 0; s4 < 4; ++s4) qf[qt][s4] = *(const dl_bf16x8*)(qp + s4 * 32); }
    pg8::f32x4 st[2][9];
    u32x4 vv[12];
#pragma unroll
    for (int k = 0; k < 12; ++k) { const int c = tid + 512 * k, i = c >> 4, ch = c & 15; int li = ks0 + i; li = li < 0 ? 0 : li;
        vv[k] = *(const u32x4*)(base + (size_t)li * rstride + C_VB + hh * 128 + ch * 8); }
    asm volatile("" ::: "memory");
    LAS unsigned char* Ks = C.lds;
#pragma unroll
    for (int k = 0; k < 12; ++k) { const int d = 12 * wave + k; const int i = 4 * d + (lane >> 4), p = (lane & 15) ^ (i & 15); int key = ks0 + i; key = key < 0 ? 0 : key;
        __builtin_amdgcn_global_load_lds((const unsigned*)(base + (size_t)key * rstride + C_KB + hh * 128 + p * 8), (LAS unsigned*)(Ks + __builtin_amdgcn_readfirstlane(1024 * d)), 16, 0, 0); }
    asm volatile("s_waitcnt vmcnt(0)\n\ts_barrier" ::: "memory");
    { const LAS unsigned char* kr = Ks + (32 * wave + n16) * 256;
#define DIL_KFR(tl_, s4_) (*(const LAS dl_bf16x8*)(kr + (tl_) * 4096 + (((4 * (s4_) + kq) ^ n16) << 4)))
#pragma unroll
      for (int tl = 0; tl < 10; ++tl) {
          dl_bf16x8 kf[4];
#pragma unroll
          for (int s4 = 0; s4 < 4; ++s4) kf[s4] = DIL_KFR(tl, s4);
          if (tl <= 8) { pg8::f32x4 a_ = {0.f, 0.f, 0.f, 0.f};
#pragma unroll
              for (int s4 = 0; s4 < 4; ++s4) a_ = __builtin_amdgcn_mfma_f32_16x16x32_bf16(kf[s4], qf[0][s4], a_, 0, 0, 0);
              st[0][tl <= 8 ? tl : 0] = a_; }
          if (tl >= 1) { pg8::f32x4 a_ = {0.f, 0.f, 0.f, 0.f};
#pragma unroll
              for (int s4 = 0; s4 < 4; ++s4) a_ = __builtin_amdgcn_mfma_f32_16x16x32_bf16(kf[s4], qf[1][s4], a_, 0, 0, 0);
              st[1][tl >= 1 ? tl - 1 : 0] = a_; }
      }
#undef DIL_KFR
    }
    __syncthreads();
#pragma unroll
    for (int k = 0; k < 12; ++k) { const int c = tid + 512 * k, i = c >> 4, ch = c & 15; *(LAS u32x4*)(Vs + i * VP + ch * 16) = vv[k]; }
    const float sc2 = 0.08838834764831845f * 1.4426950408889634f;
    float mxq[2], lsq[2];
#pragma unroll
    for (int qt = 0; qt < 2; ++qt) {
        const int q0t = q0 + 16 * qt;
        float mx = -3.0e38f;
        if (q0t >= 128) {
#pragma unroll
            for (int i = 0; i < 4; ++i) { st[qt][0][i] = (4 * kq + i >= n16) ? st[qt][0][i] : -3.0e38f; st[qt][8][i] = (4 * kq + i <= n16) ? st[qt][8][i] : -3.0e38f; }
        } else {
#pragma unroll
            for (int tt = 0; tt < 9; ++tt)
#pragma unroll
                for (int i = 0; i < 4; ++i) { const int dist = 128 + n16 - 16 * tt - 4 * kq - i; const int kidx = q0t - 128 + 16 * tt + 4 * kq + i;
                    const bool valid = (dist >= 0) && (dist <= 128) && (kidx >= 0);
                    st[qt][tt][i] = valid ? st[qt][tt][i] : -3.0e38f; }
        }
#pragma unroll
        for (int tt = 0; tt < 9; ++tt)
#pragma unroll
            for (int i = 0; i < 4; ++i) mx = fmaxf(mx, st[qt][tt][i]);
        mx = fmaxf(mx, __int_as_float(__builtin_amdgcn_ds_bpermute((lane ^ 16) << 2, __float_as_int(mx))));
        mx = fmaxf(mx, __int_as_float(__builtin_amdgcn_ds_bpermute((lane ^ 32) << 2, __float_as_int(mx))));
        float lsum = 0.f;
#pragma unroll
        for (int tt = 0; tt < 9; ++tt)
#pragma unroll
            for (int i = 0; i < 4; ++i) { const float p = (st[qt][tt][i] > -1.0e38f) ? __builtin_amdgcn_exp2f((st[qt][tt][i] - mx) * sc2) : 0.f; st[qt][tt][i] = p; lsum += p; }
        lsum += __int_as_float(__builtin_amdgcn_ds_bpermute((lane ^ 16) << 2, __float_as_int(lsum)));
        lsum += __int_as_float(__builtin_amdgcn_ds_bpermute((lane ^ 32) << 2, __float_as_int(lsum)));
        mxq[qt] = mx; lsq[qt] = lsum;
    }
    const pg8::f32x4 zero4 = {0.f, 0.f, 0.f, 0.f};
    dl_bf16x8 pa[2][5];
#pragma unroll
    for (int ks = 0; ks < 5; ++ks) {
        pa[0][ks] = pack8(st[0][2 * ks], (2 * ks + 1 <= 8) ? st[0][(2 * ks + 1 <= 8) ? 2 * ks + 1 : 8] : zero4);
        pa[1][ks] = pack8((ks > 0) ? st[1][(ks > 0) ? 2 * ks - 1 : 0] : zero4, st[1][2 * ks]);
    }
    __syncthreads();
    pg8::f32x4 o[2][8];
#pragma unroll
    for (int qt = 0; qt < 2; ++qt)
#pragma unroll
        for (int c = 0; c < 8; ++c) o[qt][c] = zero4;
    const int q4 = (lane & 15) >> 2, p4 = lane & 3;
    const LAS unsigned char* vb = Vs + (32 * wave + 4 * kq + q4) * VP + 8 * p4;
#pragma unroll
    for (int ks = 0; ks < 5; ++ks) {
#pragma unroll
        for (int c = 0; c < 8; ++c) {
            const dl_bf16x8 bfr = tr_pair(vb + (32 * ks) * VP + 32 * c, vb + (32 * ks + 16) * VP + 32 * c);
            o[0][c] = __builtin_amdgcn_mfma_f32_16x16x32_bf16(bfr, pa[0][ks], o[0][c], 0, 0, 0);
            o[1][c] = __builtin_amdgcn_mfma_f32_16x16x32_bf16(bfr, pa[1][ks], o[1][c], 0, 0, 0);
        }
    }
    bf16_t* OG = (g == 2) ? (bf16_t*)(C.ws + WS_BR) + (size_t)T * 512 : (bf16_t*)(C.ws + WS_MIXS) + (size_t)g * T * 512;
    float* LSE = (float*)(C.ws + WS_LSE) + (size_t)g * T * 4;
    const size_t trow0 = (size_t)b * SEQ + r;
    __syncthreads();
    { LAS unsigned char* Ot = C.lds + wave * 8704;
#pragma unroll
      for (int qt = 0; qt < 2; ++qt) {
          const float inv = __builtin_amdgcn_rcpf(lsq[qt]);
#pragma unroll
          for (int c = 0; c < 8; ++c) { u32x2 w; w.x = pk2(o[qt][c][0] * inv, o[qt][c][1] * inv); w.y = pk2(o[qt][c][2] * inv, o[qt][c][3] * inv); *(LAS u32x2*)(Ot + (16 * qt + n16) * 272 + 32 * c + 8 * kq) = w; }
          if (kq == 0) LSE[(trow0 + (size_t)(q0 + 16 * qt + n16) * dil) * 4 + j] = mxq[qt] * 0.08838834764831845f + __logf(lsq[qt]);
      }
      asm volatile("s_waitcnt lgkmcnt(0)" ::: "memory");
      const int rr = lane >> 4, pc = lane & 15;
#pragma unroll
      for (int i = 0; i < 8; ++i) { const int row = 4 * i + rr; const u32x4 v = *(const LAS u32x4*)(Ot + row * 272 + pc * 16);
          *(u32x4*)(OG + (trow0 + (size_t)(q0 + row) * dil) * 512 + j * 128 + pc * 8) = v; } }
    if (tid == 0) MISCW(C)[4] = nextv;
}

__device__ __forceinline__ void phase_mix_a(const Ctx& C, int l) {
    { PH_IDS();
      bf16_t* P = (bf16_t*)(C.ws + WS_P); const bf16_t* PB = (const bf16_t*)(C.ws + WS_BR) + (size_t)T * 512;
      for (int i = C.bid * NTHR + tid; i < T * 32; i += C.G * NTHR) { const int row = i >> 5, c8 = (i & 31) * 8;
          bf16_t* dp = P + (size_t)row * PLD + (PLD - 256) + c8;
          const u32x4 a = *(const u32x4*)dp, b0 = *(const u32x4*)(PB + (size_t)row * 256 + c8), b1 = *(const u32x4*)(PB + ((size_t)T + row) * 256 + c8), b2 = *(const u32x4*)(PB + ((size_t)2 * T + row) * 256 + c8);
          u32x4 w;
          w.x = pk2(lo2f(a.x) + lo2f(b0.x) + lo2f(b1.x) + lo2f(b2.x), hi2f(a.x) + hi2f(b0.x) + hi2f(b1.x) + hi2f(b2.x));
          w.y = pk2(lo2f(a.y) + lo2f(b0.y) + lo2f(b1.y) + lo2f(b2.y), hi2f(a.y) + hi2f(b0.y) + hi2f(b1.y) + hi2f(b2.y));
          w.z = pk2(lo2f(a.z) + lo2f(b0.z) + lo2f(b1.z) + lo2f(b2.z), hi2f(a.z) + hi2f(b0.z) + hi2f(b1.z) + hi2f(b2.z));
          w.w = pk2(lo2f(a.w) + lo2f(b0.w) + lo2f(b1.w) + lo2f(b2.w), hi2f(a.w) + hi2f(b0.w) + hi2f(b1.w) + hi2f(b2.w));
          *(u32x4*)dp = w; } }
#ifndef NO_CHAIN
    { SsdPre pre; if ((int)C.bid < 1024) ssd_pre_load(C, l, C.bid, pre);
      for (int u = C.bid; u < 1024; u += C.G) ssd_pass1(C, l, u, pre, u + C.G < 1024 ? u + C.G : -1); }
    PROBE_MARK(18);
    { HgPre pre; if ((int)C.bid < 1024) hg_pre_load(C, l, C.bid, pre);
      for (int u = C.bid; u < 1024; u += C.G) hgrn_pass1(C, l, u, pre, u + C.G < 1024 ? u + C.G : -1); }
    PROBE_MARK(19);
#endif
}
__device__ __forceinline__ void phase_mix_b(const Ctx& C, int l) {
    PH_IDS();
    unsigned* wq = (unsigned*)(C.ws + WS_CTL) + CW_WQ + 64 * (2 * l);
    unsigned* p2done = (unsigned*)(C.ws + WS_CTL) + CW_P2 + 64 * l;
#ifndef NO_CHAIN
    if (C.bid < 64) ssd_pass2(C, C.bid >> 1, wave & 3, ((C.bid & 1) << 1) | (wave >> 2));
    else if (C.bid < 192) hgrn_pass2(C, (C.bid - 64) >> 2, (C.bid - 64) & 3);
    if (C.bid < 192) { asm volatile("s_waitcnt vmcnt(0)" ::: "memory"); __syncthreads(); if (tid == 0) __hip_atomic_fetch_add(p2done, 1u, __ATOMIC_RELAXED, __HIP_MEMORY_SCOPE_AGENT); }
#endif
    PROBE_MARK(12);
    const attn_body::bf16* P = (const attn_body::bf16*)(C.ws + WS_P); attn_body::bf16* O16 = (attn_body::bf16*)(C.ws + WS_O16);
#ifndef NO_ATTN
    for (;;) {
        __syncthreads();
        if (tid == 0) MISCW(C)[4] = atomicAdd(wq, 1u);
        __syncthreads();
        const int u = (int)MISCW(C)[4]; if (u >= 512) break;
        const int qb = 15 - (u >> 5), bh = u & 31, b = bh >> 3, i = bh & 7;
        const size_t r0 = (size_t)b * SEQ;
        attn_body::attn_unit128<8, PLD, 1024>(qb, P + r0 * PLD + C_QC + i * 64, P + r0 * PLD + C_KC + i * 64, P + r0 * PLD + C_VC + (i >> 1) * 128, O16 + r0 * 1024 + i * 128, (char*)C.lds);
    }
#endif
    PROBE_MARK(13);
#ifndef NO_DIL
    if (tid == 0) { unsigned sp = 0; while (__hip_atomic_load(p2done, __ATOMIC_RELAXED, __HIP_MEMORY_SCOPE_AGENT) < 192u) { __builtin_amdgcn_s_sleep(8); if (++sp > (1u << 22)) break; } }
    __syncthreads();
    if (tid == 0) MISCW(C)[4] = atomicAdd(wq + 64, 1u);
    __syncthreads();
    for (;;) {
        const int u = (int)MISCW(C)[4];
        __syncthreads();
        if (u >= 768) break;
        dilated_unit(C, u, wq + 64);
        __syncthreads();
    }
#endif
    PROBE_MARK(14);
}

__device__ __forceinline__ void phase_comb(const Ctx& C, int l) {
    PH_IDS();
    if (tid < 64) {
        const float* dl = INP(I_DLAM) + l * 256;
        const float s1 = wave_sum(dl[lane] * dl[64 + lane]), s2 = wave_sum(dl[128 + lane] * dl[192 + lane]);
        const float lam_init = (l == 0) ? 0.2f : 0.35550907f;
        if (tid == 0) { MISCW(C)[6] = __float_as_uint(expf(s1) - expf(s2) + lam_init); MISCW(C)[7] = __float_as_uint(1.0f - lam_init); }
    }
    __syncthreads();
    const float lam = __uint_as_float(MISCW(C)[6]), oml = __uint_as_float(MISCW(C)[7]);
    const int gw = C.bid * NWAVES + wave, NGW = C.G * NWAVES;
    const bf16_t* O16 = (const bf16_t*)(C.ws + WS_O16); bf16_t* BR = (bf16_t*)(C.ws + WS_BR) + (size_t)2 * T * 512;
    float swl[8];
    { const float* sp = INP(I_SUBLN) + l * 128 + 8 * (lane & 15);
#pragma unroll
      for (int e = 0; e < 8; ++e) swl[e] = sp[e]; }
    const bf16_t* OG0 = (const bf16_t*)(C.ws + WS_MIXS); const bf16_t* OG1 = OG0 + (size_t)T * 512; bf16_t* OG2 = (bf16_t*)(C.ws + WS_BR) + (size_t)T * 512;
    const float* LSE = (const float*)(C.ws + WS_LSE);
    bf16_t* BR0 = (bf16_t*)(C.ws + WS_BR); bf16_t* BR3 = BR0 + (size_t)3 * T * 512; const bf16_t* Pp = (const bf16_t*)(C.ws + WS_P);
    float nwa[8], nwd[8];
    { const float* a = INP(I_SSDNW) + l * 512 + 8 * lane; const float* d = INP(I_HGNW) + l * 64 + 8 * (lane & 7);
#pragma unroll
      for (int e = 0; e < 8; ++e) { nwa[e] = a[e]; nwd[e] = d[e]; } }
    struct CombIn { u32x4 yv, zv, ov, gv, a, bb, cc, av, bv; float l0, l1, l2; };
    const int jj = lane >> 4, hq = lane >> 4, e0 = 8 * (lane & 15), half = e0 >> 6, ee = e0 & 63;
#define COMB_LOAD(I, row_) do { const size_t r_ = (size_t)(row_); \
        (I).yv = *(const u32x4*)(BR0 + r_ * 512 + 8 * lane); (I).zv = *(const u32x4*)(Pp + r_ * PLD + C_Z + 8 * lane); \
        (I).ov = *(const u32x4*)(BR3 + r_ * 512 + 8 * lane); (I).gv = *(const u32x4*)(Pp + r_ * PLD + C_GD + 8 * lane); \
        (I).a = *(const u32x4*)(OG0 + r_ * 512 + 8 * lane); (I).bb = *(const u32x4*)(OG1 + r_ * 512 + 8 * lane); (I).cc = *(const u32x4*)(OG2 + r_ * 512 + 8 * lane); \
        (I).av = *(const u32x4*)(O16 + r_ * 1024 + (4 * hq + half) * 64 + ee); (I).bv = *(const u32x4*)(O16 + r_ * 1024 + (4 * hq + 2 + half) * 64 + ee); \
        (I).l0 = LSE[r_ * 4 + jj]; (I).l1 = LSE[((size_t)T + r_) * 4 + jj]; (I).l2 = LSE[((size_t)2 * T + r_) * 4 + jj]; } while (0)
    CombIn cur; COMB_LOAD(cur, gw);
    for (int row = gw; row < T; row += NGW) {
        CombIn nxt; COMB_LOAD(nxt, (row + NGW < T) ? row + NGW : row);
        {
            const u32x4 yv = cur.yv, zv = cur.zv;
            float u[8];
            u[0] = lo2f(yv.x) * siluf_(lo2f(zv.x)); u[1] = hi2f(yv.x) * siluf_(hi2f(zv.x)); u[2] = lo2f(yv.y) * siluf_(lo2f(zv.y)); u[3] = hi2f(yv.y) * siluf_(hi2f(zv.y));
            u[4] = lo2f(yv.z) * siluf_(lo2f(zv.z)); u[5] = hi2f(yv.z) * siluf_(hi2f(zv.z)); u[6] = lo2f(yv.w) * siluf_(lo2f(zv.w)); u[7] = hi2f(yv.w) * siluf_(hi2f(zv.w));
            float ss = 0.f;
#pragma unroll
            for (int e = 0; e < 8; ++e) ss += u[e] * u[e];
            const float rstd = rsqrtf(wave_sum(ss) * (1.0f / 512.0f) + EPS);
            u32x4 w; w.x = pk2(u[0] * rstd * nwa[0], u[1] * rstd * nwa[1]); w.y = pk2(u[2] * rstd * nwa[2], u[3] * rstd * nwa[3]); w.z = pk2(u[4] * rstd * nwa[4], u[5] * rstd * nwa[5]); w.w = pk2(u[6] * rstd * nwa[6], u[7] * rstd * nwa[7]);
            *(u32x4*)(BR0 + (size_t)row * 512 + 8 * lane) = w;
        }
        {
            const u32x4 ov = cur.ov, gv = cur.gv;
            float o[8]; o[0] = lo2f(ov.x); o[1] = hi2f(ov.x); o[2] = lo2f(ov.y); o[3] = hi2f(ov.y); o[4] = lo2f(ov.z); o[5] = hi2f(ov.z); o[6] = lo2f(ov.w); o[7] = hi2f(ov.w);
            float ss = 0.f;
#pragma unroll
            for (int e = 0; e < 8; ++e) ss += o[e] * o[e];
            ss += __int_as_float(__builtin_amdgcn_ds_bpermute((lane ^ 1) << 2, __float_as_int(ss)));
            ss += __int_as_float(__builtin_amdgcn_ds_bpermute((lane ^ 2) << 2, __float_as_int(ss)));
            ss += __int_as_float(__builtin_amdgcn_ds_bpermute((lane ^ 4) << 2, __float_as_int(ss)));
            const float rstd = rsqrtf(ss * (1.0f / 64.0f) + EPS);
            u32x4 w;
            w.x = pk2(o[0] * rstd * nwd[0] * siluf_(lo2f(gv.x)), o[1] * rstd * nwd[1] * siluf_(hi2f(gv.x))); w.y = pk2(o[2] * rstd * nwd[2] * siluf_(lo2f(gv.y)), o[3] * rstd * nwd[3] * siluf_(hi2f(gv.y)));
            w.z = pk2(o[4] * rstd * nwd[4] * siluf_(lo2f(gv.z)), o[5] * rstd * nwd[5] * siluf_(hi2f(gv.z))); w.w = pk2(o[6] * rstd * nwd[6] * siluf_(lo2f(gv.w)), o[7] * rstd * nwd[7] * siluf_(hi2f(gv.w)));
            *(u32x4*)(BR3 + (size_t)row * 512 + 8 * lane) = w;
        }
        {
            const float l0 = cur.l0, l1 = cur.l1, l2 = cur.l2;
            const float M = fmaxf(fmaxf(l0, l1), l2); const float x0 = __expf(l0 - M), x1 = __expf(l1 - M), x2 = __expf(l2 - M); const float inv = __builtin_amdgcn_rcpf(x0 + x1 + x2);
            const float c0 = x0 * inv, c1 = x1 * inv, c2 = x2 * inv;
            const u32x4 a = cur.a, bb = cur.bb, cc = cur.cc;
            u32x4 w;
            w.x = pk2(c0 * lo2f(a.x) + c1 * lo2f(bb.x) + c2 * lo2f(cc.x), c0 * hi2f(a.x) + c1 * hi2f(bb.x) + c2 * hi2f(cc.x));
            w.y = pk2(c0 * lo2f(a.y) + c1 * lo2f(bb.y) + c2 * lo2f(cc.y), c0 * hi2f(a.y) + c1 * hi2f(bb.y) + c2 * hi2f(cc.y));
            w.z = pk2(c0 * lo2f(a.z) + c1 * lo2f(bb.z) + c2 * lo2f(cc.z), c0 * hi2f(a.z) + c1 * hi2f(bb.z) + c2 * hi2f(cc.z));
            w.w = pk2(c0 * lo2f(a.w) + c1 * lo2f(bb.w) + c2 * lo2f(cc.w), c0 * hi2f(a.w) + c1 * hi2f(bb.w) + c2 * hi2f(cc.w));
            *(u32x4*)(OG2 + (size_t)row * 512 + 8 * lane) = w;
        }
        {
            const u32x4 av = cur.av, bv = cur.bv;
            float d[8];
            d[0] = lo2f(av.x) - lam * lo2f(bv.x); d[1] = hi2f(av.x) - lam * hi2f(bv.x); d[2] = lo2f(av.y) - lam * lo2f(bv.y); d[3] = hi2f(av.y) - lam * hi2f(bv.y);
            d[4] = lo2f(av.z) - lam * lo2f(bv.z); d[5] = hi2f(av.z) - lam * hi2f(bv.z); d[6] = lo2f(av.w) - lam * lo2f(bv.w); d[7] = hi2f(av.w) - lam * hi2f(bv.w);
            float ss = 0.f;
#pragma unroll
            for (int e = 0; e < 8; ++e) ss += d[e] * d[e];
            ss += __int_as_float(__builtin_amdgcn_ds_bpermute((lane ^ 1) << 2, __float_as_int(ss)));
            ss += __int_as_float(__builtin_amdgcn_ds_bpermute((lane ^ 2) << 2, __float_as_int(ss)));
            ss += __int_as_float(__builtin_amdgcn_ds_bpermute((lane ^ 4) << 2, __float_as_int(ss)));
            ss += __int_as_float(__builtin_amdgcn_ds_bpermute((lane ^ 8) << 2, __float_as_int(ss)));
            const float rstd = rsqrtf(ss * (1.0f / 128.0f) + EPS) * oml;
            u32x4 w; w.x = pk2(d[0] * rstd * swl[0], d[1] * rstd * swl[1]); w.y = pk2(d[2] * rstd * swl[2], d[3] * rstd * swl[3]); w.z = pk2(d[4] * rstd * swl[4], d[5] * rstd * swl[5]); w.w = pk2(d[6] * rstd * swl[6], d[7] * rstd * swl[7]);
            *(u32x4*)(BR + (size_t)row * 512 + hq * 128 + e0) = w;
        }
        cur = nxt;
    }
#undef COMB_LOAD
}

using pg8::Unit; using pg8::HALF; using pg8::BM;
struct EpiMerge {
    static constexpr bool PERM = false, AFTER_DRAIN = false, NT = true; static constexpr int BHALF = 2;
    __host__ __device__ static int brow(int R) { return pg8::nt_brow(R); }
    const bf16_t* P; bf16_t* MS;
    __device__ __forceinline__ void operator()(const pg8::f32x4 (&acc)[2][2][4][2], const Unit& u, int wr, int wc, int fr, int fq) const {
        const int n = u.pn >> 2, pn = u.pn & 3, pm = u.pm & 63;
        const int row0 = pm * BM + wr * 64 + 4 * fq, col0 = pn * BM + wc * 64 + 4 * fr;
        u32x2 gl[2][2][4], pv[2][2][4];
#define MERGE_LOAD(B, Q) do { _Pragma("unroll") for (int m2 = 0; m2 < 2; ++m2) _Pragma("unroll") for (int e = 0; e < 4; ++e) { \
            const unsigned row_ = (unsigned)(row0 + ((Q) >> 1) * HALF + (((Q) & 1) * 2 + m2) * 16 + e); \
            gl[B][m2][e] = *(const u32x2*)(P + (row_ * (unsigned)PLD + C_GATE + n * 1024 + col0)); \
            pv[B][m2][e] = (n > 0) ? *(const u32x2*)(MS + (row_ * DM + col0)) : (u32x2){0u, 0u}; } } while (0)
#define MERGE_CALC(B, Q) do { _Pragma("unroll") for (int m2 = 0; m2 < 2; ++m2) _Pragma("unroll") for (int e = 0; e < 4; ++e) { \
            const int ai_ = (Q) >> 1, m_ = ((Q) & 1) * 2 + m2; const unsigned row_ = (unsigned)(row0 + ai_ * HALF + m_ * 16 + e); \
            const u32x2 g = gl[B][m2][e], p = pv[B][m2][e]; \
            u32x2 w; w.x = pk2(sigmoidf_(lo2f(g.x)) * acc[ai_][0][m_][0][e] + lo2f(p.x), sigmoidf_(hi2f(g.x)) * acc[ai_][0][m_][1][e] + hi2f(p.x)); \
            w.y = pk2(sigmoidf_(lo2f(g.y)) * acc[ai_][1][m_][0][e] + lo2f(p.y), sigmoidf_(hi2f(g.y)) * acc[ai_][1][m_][1][e] + hi2f(p.y)); \
            *(u32x2*)(MS + (row_ * DM + col0)) = w; } } while (0)
        MERGE_LOAD(0, 0); MERGE_LOAD(1, 1);
        MERGE_CALC(0, 0); MERGE_LOAD(0, 2);
        MERGE_CALC(1, 1); MERGE_LOAD(1, 3);
        MERGE_CALC(0, 2);
        MERGE_CALC(1, 3);
#undef MERGE_LOAD
#undef MERGE_CALC
    }
};
#ifndef MERGE_ORDER
#define MERGE_ORDER 2
#endif
struct OrderMerge { int G, c;
    __device__ __forceinline__ bool next(int i, Unit& u) const { const int L = (i >> 2) * G + c; if (L >= 256) return false; const int n = i & 3;
#if MERGE_ORDER == 1
        const int x_ = L & 7, j_ = L >> 3; const int r_ = (j_ >> 2) * 8 + x_, p_ = j_ & 3;
#elif MERGE_ORDER == 2
        const int x_ = L & 7, j_ = L >> 3; const int r_ = 8 * x_ + (j_ >> 2), p_ = j_ & 3;
#elif MERGE_ORDER == 3
        const int x_ = L & 7, j_ = L >> 3; const int r_ = 8 * x_ + (j_ & 7), p_ = j_ >> 3;
#else
        const int r_ = L >> 2, p_ = L & 3;
#endif
        u.pm = n * 64 + r_; u.pn = n * 4 + p_; return true; }
    __device__ __forceinline__ void a_ready(const Unit&) const {}
    __device__ __forceinline__ void done(const Unit&) const {}
};
struct EpiWout {
    static constexpr bool PERM = false, AFTER_DRAIN = false, NT = true; static constexpr int BHALF = 2;
    __host__ __device__ static int brow(int R) { return pg8::nt_brow(R); }
    const float* xin; float* xout; const float* g1;
    __device__ __forceinline__ void operator()(const pg8::f32x4 (&acc)[2][2][4][2], const Unit& u, int wr, int wc, int fr, int fq) const {
        const int row0 = u.pm * BM + wr * 64 + 4 * fq, col0 = u.pn * BM + wc * 64 + 4 * fr;
        const pg8::f32x4 gv = *(const pg8::f32x4*)(g1 + (size_t)(row0 >> 12) * 6144 + col0);
#pragma unroll
        for (int am = 0; am < 4; ++am) { const int ai = am >> 1, m0 = (am & 1) * 2;
            pg8::f32x4 xv[2][4];
#pragma unroll
            for (int m = 0; m < 2; ++m)
#pragma unroll
                for (int e = 0; e < 4; ++e) xv[m][e] = *(const pg8::f32x4*)(xin + ((unsigned)(row0 + ai * HALF + (m0 + m) * 16 + e) * DM + col0));
#pragma unroll
            for (int m = 0; m < 2; ++m)
#pragma unroll
                for (int e = 0; e < 4; ++e) { const pg8::f32x4 a = {acc[ai][0][m0 + m][0][e], acc[ai][0][m0 + m][1][e], acc[ai][1][m0 + m][0][e], acc[ai][1][m0 + m][1][e]};
                    *(pg8::f32x4*)(xout + ((unsigned)(row0 + ai * HALF + (m0 + m) * 16 + e) * DM + col0)) = xv[m][e] + gv * a; }
        }
    }
};
struct EpiMoe1 {
    static constexpr bool PERM = false, AFTER_DRAIN = false, NT = true; static constexpr int BHALF = 1;
    __host__ __device__ static int brow(int R) { return 64 * (R >> 5) + 8 * ((R & 15) >> 1) + 4 * ((R >> 4) & 1) + 2 * (R & 1); }
    bf16_t* HID;
    __device__ __forceinline__ void operator()(const pg8::f32x4 (&acc)[2][2][4][2], const Unit& u, int wr, int wc, int fr, int fq) const {
        const int j = u.pn & 1, row0 = u.pm * BM + wr * 64 + 4 * fq, c0 = 128 * j + 32 * wc + 2 * fr;
#pragma unroll
        for (int ai = 0; ai < 2; ++ai)
#pragma unroll
            for (int m = 0; m < 4; ++m)
#pragma unroll
                for (int e = 0; e < 4; ++e)
                    *(unsigned*)(HID + ((unsigned)(row0 + ai * HALF + m * 16 + e) * 256u + c0)) = pk2(siluf_(acc[ai][0][m][0][e]) * acc[ai][0][m][1][e], siluf_(acc[ai][1][m][0][e]) * acc[ai][1][m][1][e]);
    }
};
struct EpiMoe2 {
    static constexpr bool PERM = false, AFTER_DRAIN = false, NT = true; static constexpr int BHALF = 2;
    __host__ __device__ static int brow(int R) { return pg8::nt_brow(R); }
    bf16_t* Y;
    __device__ __forceinline__ void operator()(const pg8::f32x4 (&acc)[2][2][4][2], const Unit& u, int wr, int wc, int fr, int fq) const {
        const int j = u.pn & 3, row0 = u.pm * BM + wr * 64 + 4 * fq, c0 = 256 * j + 64 * wc + 4 * fr;
#pragma unroll
        for (int ai = 0; ai < 2; ++ai)
#pragma unroll
            for (int m = 0; m < 4; ++m)
#pragma unroll
                for (int e = 0; e < 4; ++e) { u32x2 w; w.x = pk2(acc[ai][0][m][0][e], acc[ai][0][m][1][e]); w.y = pk2(acc[ai][1][m][0][e], acc[ai][1][m][1][e]);
                    __builtin_nontemporal_store(w, (u32x2*)(Y + ((unsigned)(row0 + ai * HALF + m * 16 + e) * DM + c0))); }
    }
};
struct OrderList { const LAS int* lst;
    __device__ __forceinline__ bool next(int i, Unit& u) const { if (i >= lst[0]) return false; const int v = lst[1 + i]; u.pm = v >> 8; u.pn = v & 255; return true; }
    __device__ __forceinline__ void a_ready(const Unit&) const {}
    __device__ __forceinline__ void done(const Unit&) const {}
};
template <int SH> struct OrderMoe { int G, c, nunits; const LAS unsigned char* blk_e;
    __device__ __forceinline__ bool next(int i, Unit& u) const { const int L = i * G + c; if (L >= nunits) return false; u.pm = L >> SH; u.pn = ((int)blk_e[L >> SH] << SH) + (L & ((1 << SH) - 1)); return true; }
    __device__ __forceinline__ void a_ready(const Unit&) const {}
    __device__ __forceinline__ void done(const Unit&) const {}
};

struct Args { const float* in[25]; float* out; unsigned char* ws; };
__global__ void __launch_bounds__(NTHR, 2) mega_fwd(Args args) {
    extern __shared__ __attribute__((aligned(16))) unsigned char lds_raw[];
    Ctx C;
    C.out = args.out; C.ws = args.ws;
    C.lds = (LAS unsigned char*)lds_raw; C.G = gridDim.x; C.bid = blockIdx.x;
    { const int tid0 = threadIdx.x;
      for (int i = tid0; i < (LDS_BYTES - MISC_OFF) / 4; i += NTHR) MISCW(C)[i] = 0u;
      __syncthreads();
      if (tid0 < 25) { const unsigned long long p = (unsigned long long)args.in[tid0]; LAS unsigned* t = (LAS unsigned*)(C.lds + MISC_OFF + 1024) + 2 * tid0; t[0] = (unsigned)p; t[1] = (unsigned)(p >> 32); }
      __syncthreads(); }
    XcdBarrier bar = xcd_barrier_post((unsigned*)(C.ws + WS_CTL) + CW_BAR, MISCW(C));
    LAS unsigned char* stage = C.lds;
#define WSP(T_, off) ((T_*)(C.ws + (off)))

    PROBE_INIT();
#ifndef NO_PRO
    pro_mods(C);
    convert_main(C, 0);
#endif
    xcd_barrier(bar);
    PROBE_MARK(0);
    for (int l = 0; l < DEPTH; ++l) {
#ifndef NO_N1
        phase_rows<0>(C, l, l > 0);
#endif
        xcd_barrier(bar); PROBE_MARK(1);
#ifndef NO_G1
        { pg8::Gemm g{WSP(const bf16_t, WS_H), WSP(const bf16_t, WS_WIN), T, PLD, 1024}; pg8::StaticOrder S; S.init(T, PLD - 256, C.G, C.bid);
          pg8::EpiBf16NT E{WSP(bf16_t, WS_P), PLD};
          pg8::gemm_phase<pg8::EpiBf16NT, pg8::StaticOrder, false>(stage, g, S, E, nullptr); }
        { pg8::Gemm g{WSP(const bf16_t, WS_H), WSP(const bf16_t, WS_WIN), T, PLD, 1024, 256}; pg8::SplitKOrder S{C.G, C.bid, PLD / 256 - 1};
          pg8::EpiSplitK E{WSP(bf16_t, WS_P), PLD, WSP(bf16_t, WS_BR) + (size_t)T * 512, T};
          pg8::gemm_phase<pg8::EpiSplitK, pg8::SplitKOrder, false>(stage, g, S, E, nullptr); }
#endif
        xcd_barrier(bar); PROBE_MARK(2);
#ifndef NO_MIX
        phase_mix_a(C, l);
        xcd_barrier(bar); PROBE_MARK(15);
        phase_mix_b(C, l);
#endif
        xcd_barrier(bar); PROBE_MARK(3);
#ifndef NO_COMB
        phase_comb(C, l);
#endif
        xcd_barrier(bar); PROBE_MARK(4);
#ifndef NO_MERGE
        { pg8::Gemm g{WSP(const bf16_t, WS_BR), WSP(const bf16_t, WS_WMG), 4 * T, 4096, 512}; OrderMerge S{C.G, C.bid};
          EpiMerge E{WSP(const bf16_t, WS_P), WSP(bf16_t, WS_MIXS)};
          pg8::gemm_phase<EpiMerge, OrderMerge, false>(stage, g, S, E, nullptr); }
#endif
        xcd_barrier(bar); PROBE_MARK(5);
#ifndef NO_WOUT
        { pg8::Gemm g{WSP(const bf16_t, WS_MIXS), WSP(const bf16_t, WS_WOUT), T, 1024, 1024}; pg8::StaticOrder S; S.init(T, 1024, C.G, C.bid);
          EpiWout E{l == 0 ? INP(I_X) : (const float*)C.out, C.out, WSP(const float, WS_MOD) + (size_t)l * 4 * 6144 + 2048};
          pg8::gemm_phase<EpiWout, pg8::StaticOrder, false>(stage, g, S, E, nullptr); }
#endif
        xcd_barrier(bar); PROBE_MARK(6);
#ifndef NO_N2
        phase_n2(C, l, l + 1 < DEPTH); PROBE_MARK(16);
#endif
        xcd_barrier(bar); PROBE_MARK(7);
#ifndef NO_SCAT
        phase_scatter(C, l);
#endif
        xcd_barrier(bar); PROBE_MARK(8);
#ifndef NO_MOE1
        { const int nblk = (int)MISCW(C)[5];
          const LAS int* m1 = (const LAS int*)(C.lds + MISC_OFF + 2048); LAS int* rowl = (LAS int*)(C.lds + MISC_OFF + 4096);
          { const int* ROWTOK = (const int*)(C.ws + WS_ROWTOK); const int nu = m1[0] < 12 ? m1[0] : 12; int t0 = threadIdx.x; asm volatile("" : "+v"(t0));
            for (int i = 0; i < nu; ++i) if (t0 < 256) rowl[i * 256 + t0] = ROWTOK[(m1[1 + i] >> 8) * 256 + t0];
            __syncthreads(); }
          pg8::Gemm g{(const bf16_t*)(C.ws + WS_H), (const bf16_t*)(C.ws + WS_E1), MAXROWS, 64 * 512, 1024}; OrderList S{m1}; (void)nblk;
          EpiMoe1 E{(bf16_t*)(C.ws + WS_HID)};
          pg8::gemm_phase<EpiMoe1, OrderList, false, true>(stage, g, S, E, nullptr, rowl); }
#endif
        xcd_barrier(bar); PROBE_MARK(9);
#ifndef NO_MOE2
        { const int nblk = (int)MISCW(C)[5];
          pg8::Gemm g{(const bf16_t*)(C.ws + WS_HID), (const bf16_t*)(C.ws + WS_E2), MAXROWS, 64 * 1024, 256}; OrderList S{(const LAS int*)(C.lds + MISC_OFF + 2048) + 64}; (void)nblk;
          EpiMoe2 E{(bf16_t*)(C.ws + WS_Y)};
          pg8::gemm_phase<EpiMoe2, OrderList, false>(stage, g, S, E, nullptr); }
#endif
        xcd_barrier(bar); PROBE_MARK(10);
    }
#ifndef NO_FIN
    phase_rows<1>(C, DEPTH, true);
#endif
    PROBE_MARK(11);
    PROBE_FINISH();
}

extern "C" void kernel_launch(void* const* d_in, const int* in_sizes, int n_in, void* d_out, int out_size, void* d_ws, size_t ws_size, hipStream_t stream) {
    static int grid = 0;
    if (grid == 0) {
        if (n_in != 25 || out_size != T * DM || ws_size < WS_END) { fprintf(stderr, "kernel_launch: unexpected sizes (n_in %d out %d ws %zu need %zu)\n", n_in, out_size, ws_size, (size_t)WS_END); grid = -1; return; }
        int dev = 0, cus = 0, per_cu = 0;
        if (hipGetDevice(&dev) != hipSuccess || hipDeviceGetAttribute(&cus, hipDeviceAttributeMultiprocessorCount, dev) != hipSuccess) { grid = -1; return; }
        if (hipFuncSetAttribute((const void*)mega_fwd, hipFuncAttributeMaxDynamicSharedMemorySize, LDS_BYTES) != hipSuccess) { fprintf(stderr, "kernel_launch: hipFuncSetAttribute failed\n"); grid = -1; return; }
        if (hipOccupancyMaxActiveBlocksPerMultiprocessor(&per_cu, (const void*)mega_fwd, NTHR, LDS_BYTES) != hipSuccess || per_cu < 1) { fprintf(stderr, "kernel_launch: occupancy query says %d\n", per_cu); (void)hipGetLastError(); grid = -1; return; }
        grid = cus;
    }
    if (grid < 0) return;
    if (hipMemsetAsync((char*)d_ws + WS_CTL, 0, CTL_ZERO_BYTES, stream) != hipSuccess) return;
    Args a{};
    for (int i = 0; i < 25; ++i) a.in[i] = (const float*)d_in[i];
    a.out = (float*)d_out; a.ws = (unsigned char*)d_ws;
    hipLaunchKernelGGL(mega_fwd, dim3(grid), dim3(NTHR), LDS_BYTES, stream, a);
}
```
